# Optimizing an MI355X kernel written in HIP

```python
import math
import jax, jax.numpy as jnp
from jax import lax
import numpy as np

D_MODEL = 1024
BATCH = 16
SEQ = 4096
DEPTH = 1

CHUNK = 64
D_MIX = D_MODEL
D_CONV = D_MIX // 2
CONV_K = 3
D_SSM = D_MIX - D_CONV
SSM_HEADDIM = 64
SSM_HEADS = D_SSM // SSM_HEADDIM
SSM_GROUPS = 2
SSM_STATE = 128
SSM_CONV_K = 4
D_XBC = D_SSM + 2 * SSM_GROUPS * SSM_STATE
D_IN_PROJ = 3 * D_CONV + D_SSM + D_XBC + SSM_HEADS
N_EXPERTS = 64
TOP_K = 8
N_EXPERT_GROUPS = 8
TOPK_GROUPS = 4
D_EXPERT = 256
D_SHARED = 256
ROUTED_SCALE = 2.5
EPS = 1e-6

kernel_name = "hybrid_conv_ssd_moe_adaln_block"


def rms_norm(x, g):
    xf = x.astype(jnp.float32)
    y = xf * lax.rsqrt(jnp.mean(xf * xf, axis=-1, keepdims=True) + EPS)
    return (y * g.astype(jnp.float32)).astype(x.dtype)


def modulate(h, shift, scale):
    return h * (1 + scale[:, None, :]) + shift[:, None, :]


def causal_dwconv(u, w):
    k, ch = w.shape
    return lax.conv_general_dilated(
        u, w[:, None, :].astype(u.dtype), window_strides=(1,), padding=[(k - 1, 0)],
        dimension_numbers=("NWC", "WIO", "NWC"), feature_group_count=ch)


def segsum(a):
    cs = jnp.cumsum(a, axis=-1)
    n = a.shape[-1]
    diff = cs[..., :, None] - cs[..., None, :]
    return jnp.where(jnp.tril(jnp.ones((n, n), dtype=bool)), diff, -jnp.inf)


def ssd_chunked(xh, dt, A, Bm, Cm):
    b, s, h, p = xh.shape
    g, n = Bm.shape[-2:]
    r = h // g
    nc = s // CHUNK
    x = xh.reshape(b, nc, CHUNK, g, r, p)
    dtc = dt.reshape(b, nc, CHUNK, g, r)
    Bc = Bm.reshape(b, nc, CHUNK, g, n)
    Cc = Cm.reshape(b, nc, CHUNK, g, n)
    a = jnp.moveaxis(dtc * A.reshape(g, r), 2, -1)
    a_cs = jnp.cumsum(a, axis=-1)
    dtx = x * dtc[..., None]
    cb = jnp.einsum("bclgn,bcsgn->bcgls", Cc, Bc)
    wts = cb[:, :, :, None] * jnp.exp(segsum(a))
    y_diag = jnp.einsum("bcgrls,bcsgrp->bclgrp", wts, dtx)
    decay_l = jnp.moveaxis(jnp.exp(a_cs[..., -1:] - a_cs), -1, 2)
    states = jnp.einsum("bclgn,bclgrp->bcgrpn", Bc, dtx * decay_l[..., None])
    chunk_decay = jnp.exp(a_cs[..., -1])

    def step(prev, inp):
        st, dec = inp
        return prev * dec[..., None, None] + st, prev

    init = jnp.zeros((b, g, r, p, n), jnp.float32)
    _, prev_states = lax.scan(step, init, (jnp.moveaxis(states, 1, 0), jnp.moveaxis(chunk_decay, 1, 0)))
    prev_states = jnp.moveaxis(prev_states, 0, 1)
    out_decay = jnp.moveaxis(jnp.exp(a_cs), -1, 2)
    y_off = jnp.einsum("bclgn,bcgrpn->bclgrp", Cc, prev_states) * out_decay[..., None]
    return (y_diag + y_off).reshape(b, s, h, p)


def short_conv_mixer(gate_b, gate_c, u, w):
    return gate_b * causal_dwconv(gate_c * u, w)


def ssd_mixer(z, xbc, dt_raw, conv_w, conv_b, dt_bias, a_log, d_skip, norm_g):
    b, s, _ = z.shape
    xbc = jax.nn.silu(causal_dwconv(xbc, conv_w) + conv_b.astype(xbc.dtype))
    gn = SSM_GROUPS * SSM_STATE
    xs, Bm, Cm = jnp.split(xbc.astype(jnp.float32), [D_SSM, D_SSM + gn], axis=-1)
    dt = jax.nn.softplus(dt_raw.astype(jnp.float32) + dt_bias.astype(jnp.float32))
    A = -jnp.exp(a_log.astype(jnp.float32))
    xh = xs.reshape(b, s, SSM_HEADS, SSM_HEADDIM)
    y = ssd_chunked(xh, dt, A, Bm.reshape(b, s, SSM_GROUPS, SSM_STATE), Cm.reshape(b, s, SSM_GROUPS, SSM_STATE))
    y = y + d_skip.astype(jnp.float32)[:, None] * xh
    y = y.reshape(b, s, D_SSM) * jax.nn.silu(z.astype(jnp.float32))
    return rms_norm(y, norm_g).astype(z.dtype)


def moe_ffn(h, w_router, router_bias, we_gate, we_up, we_down, ws_gate, ws_up, ws_down):
    b, s, d = h.shape
    t = h.reshape(b * s, d)
    scores = jax.nn.sigmoid(jnp.dot(t.astype(jnp.float32), w_router.astype(jnp.float32)))
    sel = scores + router_bias.astype(jnp.float32)
    grp = sel.reshape(-1, N_EXPERT_GROUPS, N_EXPERTS // N_EXPERT_GROUPS)
    grp_score = jnp.sum(lax.top_k(grp, 2)[0], axis=-1)
    _, grp_idx = lax.top_k(grp_score, TOPK_GROUPS)
    grp_mask = jnp.any(grp_idx[..., None] == jnp.arange(N_EXPERT_GROUPS), axis=-2)
    exp_mask = jnp.repeat(grp_mask, N_EXPERTS // N_EXPERT_GROUPS, axis=-1)
    _, idx = lax.top_k(jnp.where(exp_mask, sel, -jnp.inf), TOP_K)
    w = jnp.take_along_axis(scores, idx, axis=-1)
    w = w / jnp.sum(w, axis=-1, keepdims=True) * ROUTED_SCALE
    gates = jnp.sum(jax.nn.one_hot(idx, N_EXPERTS, dtype=jnp.float32) * w[..., None], axis=1).astype(t.dtype)
    out = (jax.nn.silu(t @ ws_gate) * (t @ ws_up)) @ ws_down
    for e in range(N_EXPERTS):
        hid = jax.nn.silu(t @ we_gate[e]) * (t @ we_up[e])
        out = out + gates[:, e:e + 1] * (hid @ we_down[e])
    return out.reshape(b, s, d)


def setup_inputs(seed: int = 0) -> dict:
    key = jax.random.key(seed)
    ks = iter(jax.random.split(key, 32))
    L = DEPTH

    def nrm(shape, scale):
        return jax.random.normal(next(ks), shape, jnp.float32) * scale

    x = nrm((BATCH, SEQ, D_MODEL), 1.0)
    c = nrm((BATCH, D_MODEL), 1.0)
    w_ada = nrm((L, D_MODEL, 6 * D_MODEL), 0.5 * D_MODEL ** -0.5)
    b_ada = nrm((L, 6 * D_MODEL), 0.02)
    norm_mix_g = 1.0 + nrm((L, D_MODEL), 0.02)
    w_in = nrm((L, D_MODEL, D_IN_PROJ), D_MODEL ** -0.5)
    conv_a_w = nrm((L, CONV_K, D_CONV), CONV_K ** -0.5)
    ssm_conv_w = nrm((L, SSM_CONV_K, D_XBC), SSM_CONV_K ** -0.5)
    ssm_conv_b = nrm((L, D_XBC), 0.02)
    dt0 = jnp.exp(jax.random.uniform(next(ks), (L, SSM_HEADS), jnp.float32, math.log(1e-3), math.log(1e-1)))
    ssm_dt_bias = dt0 + jnp.log(-jnp.expm1(-dt0))
    ssm_a_log = jnp.log(jax.random.uniform(next(ks), (L, SSM_HEADS), jnp.float32, 1.0, 16.0))
    ssm_d = 1.0 + nrm((L, SSM_HEADS), 0.1)
    ssm_norm_g = 1.0 + nrm((L, D_SSM), 0.02)
    w_out = nrm((L, D_MIX, D_MODEL), D_MIX ** -0.5)
    norm_ffn_g = 1.0 + nrm((L, D_MODEL), 0.02)
    w_router = nrm((L, D_MODEL, N_EXPERTS), D_MODEL ** -0.5)
    router_bias = nrm((L, N_EXPERTS), 0.01)
    we_gate = nrm((L, N_EXPERTS, D_MODEL, D_EXPERT), D_MODEL ** -0.5)
    we_up = nrm((L, N_EXPERTS, D_MODEL, D_EXPERT), D_MODEL ** -0.5)
    we_down = nrm((L, N_EXPERTS, D_EXPERT, D_MODEL), D_EXPERT ** -0.5)
    ws_gate = nrm((L, D_MODEL, D_SHARED), D_MODEL ** -0.5)
    ws_up = nrm((L, D_MODEL, D_SHARED), D_MODEL ** -0.5)
    ws_down = nrm((L, D_SHARED, D_MODEL), D_SHARED ** -0.5)
    norm_final_g = 1.0 + nrm((D_MODEL,), 0.02)
    return {"x": x, "c": c, "w_ada": w_ada, "b_ada": b_ada, "norm_mix_g": norm_mix_g,
            "w_in": w_in, "conv_a_w": conv_a_w, "ssm_conv_w": ssm_conv_w, "ssm_conv_b": ssm_conv_b,
            "ssm_dt_bias": ssm_dt_bias, "ssm_a_log": ssm_a_log, "ssm_d": ssm_d, "ssm_norm_g": ssm_norm_g,
            "w_out": w_out, "norm_ffn_g": norm_ffn_g, "w_router": w_router, "router_bias": router_bias,
            "we_gate": we_gate, "we_up": we_up, "we_down": we_down,
            "ws_gate": ws_gate, "ws_up": ws_up, "ws_down": ws_down, "norm_final_g": norm_final_g}


def reference(x, c, w_ada, b_ada, norm_mix_g, w_in, conv_a_w, ssm_conv_w, ssm_conv_b,
              ssm_dt_bias, ssm_a_log, ssm_d, ssm_norm_g, w_out, norm_ffn_g, w_router, router_bias,
              we_gate, we_up, we_down, ws_gate, ws_up, ws_down, norm_final_g):
    gn = SSM_GROUPS * SSM_STATE
    cuts = [D_CONV, 2 * D_CONV, 3 * D_CONV, 3 * D_CONV + D_SSM, 3 * D_CONV + D_SSM + D_XBC]
    for l in range(DEPTH):
        mod = (jnp.dot(c.astype(jnp.float32), w_ada[l].astype(jnp.float32)) + b_ada[l].astype(jnp.float32)).astype(x.dtype)
        sh1, sc1, g1, sh2, sc2, g2 = jnp.split(mod, 6, axis=-1)
        h = modulate(rms_norm(x, norm_mix_g[l]), sh1, sc1)
        proj = h @ w_in[l]
        cb, cc, cu, z, xbc, dt_raw = jnp.split(proj, cuts, axis=-1)
        y_a = short_conv_mixer(cb, cc, cu, conv_a_w[l])
        y_b = ssd_mixer(z, xbc, dt_raw, ssm_conv_w[l], ssm_conv_b[l], ssm_dt_bias[l],
                        ssm_a_log[l], ssm_d[l], ssm_norm_g[l])
        x = x + g1[:, None, :] * (jnp.concatenate([y_a, y_b], axis=-1) @ w_out[l])
        h = modulate(rms_norm(x, norm_ffn_g[l]), sh2, sc2)
        x = x + g2[:, None, :] * moe_ffn(h, w_router[l], router_bias[l], we_gate[l], we_up[l], we_down[l],
                                         ws_gate[l], ws_up[l], ws_down[l])
    return rms_norm(x, norm_final_g)
```

```cpp
#include <hip/hip_runtime.h>
#include <cstdio>
#include <cstdint>

#define LAS __attribute__((address_space(3)))
#define GAS __attribute__((address_space(1)))
typedef unsigned short bf16;
typedef short bf16x8 __attribute__((ext_vector_type(8)));
typedef float f32x4 __attribute__((ext_vector_type(4)));
typedef float f32x2 __attribute__((ext_vector_type(2)));
typedef unsigned u32x4 __attribute__((ext_vector_type(4)));
typedef unsigned u32x2 __attribute__((ext_vector_type(2)));

#define STG_P2 0
#define STG_P5 0
#define STG_G 0
#define STG_D 0
#ifndef MK_PER_PHASE
#define MK_PER_PHASE 0
#endif

constexpr int T = 65536, D = 1024, SEQ = 4096, NB = 16;
constexpr int NPROJ = 3072, LDWIN = 3080;
constexpr int C_CB = 0, C_CC = 512, C_CU = 1024, C_Z = 1536, C_XBC = 2048;
constexpr int NE = 64, NEX = 65, TOPK = 8;
constexpr int S_SB = 1, TS = T / S_SB;
constexpr int MAXT = (TS * 9) / 256 + 64;
constexpr int MAXROWS = MAXT * 256;
constexpr float EPS = 1e-6f;

constexpr size_t MiB = 1u << 20;
constexpr size_t WS_CTL = 0, CTL_ZERO_BYTES = 1 * MiB;
constexpr size_t WS_MOD = 128 * 1024;
constexpr size_t WS_WDT = 1 * MiB;
constexpr size_t WS_WIN = 2 * MiB, WS_WOUT = 8 * MiB, WS_WR = 10 * MiB;
constexpr size_t WS_RB = 1 * MiB + 64 * 1024;
constexpr size_t WS_WGU = 12 * MiB;
constexpr size_t WS_WD = 45 * MiB;
constexpr size_t WS_DT = 62 * MiB;
constexpr size_t WS_IDX = 64 * MiB, WS_WGT = 66 * MiB, WS_APOS = 68 * MiB, WS_ROWOF = 70 * MiB;
constexpr size_t WS_R2T = 72 * MiB;
constexpr size_t WS_HB = 76 * MiB;
constexpr size_t WS_HID = 76 * MiB;
constexpr size_t WS_A = 232 * MiB;
constexpr size_t WS_XC = 616 * MiB;
constexpr size_t WS_SSQ = 744 * MiB;
constexpr size_t WS_LOG = 752 * MiB;
constexpr size_t WS_H8 = 768 * MiB;
constexpr size_t WS_X1 = 832 * MiB;
constexpr size_t WS_LIST = 960 * MiB;
constexpr size_t WS_END = 976 * MiB;
static_assert(WS_WGU + (size_t)NEX * 512 * 1024 <= WS_WD && WS_WD + (size_t)NEX * 1024 * 256 <= WS_DT && WS_R2T + (size_t)S_SB * MAXROWS * 4 <= WS_HB && WS_HID + (size_t)MAXROWS * 256 <= WS_A && WS_HB + (size_t)T * D * 2 <= WS_A
              && WS_A + (size_t)T * NPROJ * 2 <= WS_XC && WS_A + (size_t)MAXROWS * 1024 <= WS_X1 && WS_XC + (size_t)T * D * 2 <= WS_SSQ && WS_SSQ + (size_t)32 * T * 4 <= WS_LOG && WS_LOG + (size_t)T * 64 * 4 <= WS_H8
              && WS_H8 + (size_t)T * D <= WS_X1 && WS_X1 + (size_t)T * D * 2 <= WS_LIST && WS_LIST + (size_t)NE * T * 4 <= WS_END, "ws map");
constexpr int CW_BAR = 4096;
constexpr int CW_CNT = 8192;

constexpr int RING_BYTES = 131072;
constexpr int TAB_SLOTS = 20;
constexpr int TAB_OFF = RING_BYTES, TAB_BYTES = TAB_SLOTS * 1024;
constexpr int TE_OFF = TAB_OFF + TAB_BYTES;
constexpr int EO_OFF = TE_OFF + ((MAXT + 63) / 64) * 64;
constexpr int EC_OFF = EO_OFF + S_SB * 72 * 4;
constexpr int MISC_OFF = EC_OFF + S_SB * 72 * 4;
constexpr int LDS_BYTES = ((MISC_OFF + 256 + 1023) / 1024) * 1024;
static_assert(LDS_BYTES <= 160 * 1024 && (2 * MAXT + 255) / 256 <= TAB_SLOTS, "LDS");

#define RLX_AGENT __ATOMIC_RELAXED, __HIP_MEMORY_SCOPE_AGENT
#define LDS_WAIT() asm volatile("s_waitcnt lgkmcnt(0)" ::: "memory")
#define WG_BAR() do { asm volatile("s_waitcnt lgkmcnt(0)" ::: "memory"); __builtin_amdgcn_s_barrier(); asm volatile("" ::: "memory"); } while (0)
__device__ __forceinline__ unsigned cvt_pk_bf16(float lo, float hi) { unsigned r; asm volatile("v_cvt_pk_bf16_f32 %0, %1, %2" : "=v"(r) : "v"(lo), "v"(hi)); return r; }
__device__ __forceinline__ float bflo(unsigned w) { return __uint_as_float(w << 16); }
__device__ __forceinline__ float bfhi(unsigned w) { return __uint_as_float(w & 0xffff0000u); }
__device__ __forceinline__ float bf2f(unsigned short h) { return __uint_as_float(((unsigned)h) << 16); }
__device__ __forceinline__ unsigned short f2bf(float f) { return (unsigned short)(cvt_pk_bf16(f, 0.f) & 0xffffu); }
__device__ __forceinline__ float silu_f(float x) { return x * __builtin_amdgcn_rcpf(1.0f + __expf(-x)); }
#define DPP_F(v, ctrl) __int_as_float(__builtin_amdgcn_update_dpp(0, __float_as_int(v), (ctrl), 0xf, 0xf, false))
__device__ __forceinline__ float wave_sum(float v) {
    v += DPP_F(v, 0xB1); v += DPP_F(v, 0x4E); v += DPP_F(v, 0x141); v += DPP_F(v, 0x140);
    const float r0 = __int_as_float(__builtin_amdgcn_readlane(__float_as_int(v), 0)), r1 = __int_as_float(__builtin_amdgcn_readlane(__float_as_int(v), 16)),
                r2 = __int_as_float(__builtin_amdgcn_readlane(__float_as_int(v), 32)), r3 = __int_as_float(__builtin_amdgcn_readlane(__float_as_int(v), 48));
    return (r0 + r1) + (r2 + r3);
}
__device__ __forceinline__ float max8(float v) {
    v = fmaxf(v, DPP_F(v, 0xB1)); v = fmaxf(v, DPP_F(v, 0x4E)); v = fmaxf(v, DPP_F(v, 0x141)); return v;
}
__device__ __forceinline__ unsigned f32_key(float f) { const unsigned b = __float_as_uint(f); return b ^ ((b >> 31) ? 0xffffffffu : 0x80000000u); }
__device__ __forceinline__ void unpack8(const u32x4 w, float (&f)[8]) {
    f[0] = bflo(w.x); f[1] = bfhi(w.x); f[2] = bflo(w.y); f[3] = bfhi(w.y); f[4] = bflo(w.z); f[5] = bfhi(w.z); f[6] = bflo(w.w); f[7] = bfhi(w.w);
}
__device__ __forceinline__ u32x4 pack8(const float (&f)[8]) {
    u32x4 w; w.x = cvt_pk_bf16(f[0], f[1]); w.y = cvt_pk_bf16(f[2], f[3]); w.z = cvt_pk_bf16(f[4], f[5]); w.w = cvt_pk_bf16(f[6], f[7]); return w;
}

__device__ __forceinline__ int lane_id_asm() { int l; asm volatile("v_mbcnt_lo_u32_b32 %0, -1, 0\n\tv_mbcnt_hi_u32_b32 %0, -1, %0" : "=v"(l)); return l; }

__device__ __forceinline__ size_t pj(size_t row, int col) { return ((row >> 8) * (NPROJ / 256) + (size_t)(col >> 8)) * 65536 + (row & 255) * 256 + (size_t)(col & 255); }

#define XB_TMO      128
#define XB_XCNT(j)  (256  + 64 * (j))
#define XB_XSUB(j)  (1280 + 64 * (j))
#define XB_XGEN(j)  (2304 + 64 * (j))
#define XB_TOP      3328
#define XB_TOPGEN   3392
#define XCD_BAR_WORDS 3456
#define XB_SPIN_CAP (1u << 18)
__device__ __forceinline__ unsigned xb_ld(unsigned* p)              { return __hip_atomic_load(p, __ATOMIC_RELAXED, __HIP_MEMORY_SCOPE_AGENT); }
__device__ __forceinline__ unsigned xb_add(unsigned* p, unsigned v) { return __hip_atomic_fetch_add(p, v, __ATOMIC_RELAXED, __HIP_MEMORY_SCOPE_AGENT); }
__device__ __forceinline__ unsigned xb_xcc_id() { return (unsigned)__builtin_amdgcn_s_getreg((3 << 11) | 20) & 0xFu; }
#define XB_SPIN(cond, bar) do { unsigned _sp = 0; while (cond) { __builtin_amdgcn_s_sleep(1); \
    if ((++_sp & 255u) == 0u) { if (xb_ld(&(bar)[XB_TMO])) break; if (_sp > XB_SPIN_CAP) { atomicAdd(&(bar)[XB_TMO], 1u); break; } } } } while (0)
struct XcdBarrier { unsigned* bar; unsigned x; volatile LAS unsigned* st; };
__device__ __forceinline__ XcdBarrier xcd_barrier_post(unsigned* bar, volatile LAS unsigned* st) {
    XcdBarrier b; b.bar = bar; b.x = xb_xcc_id(); b.st = st;
    if (threadIdx.x == 0) (void)xb_add(&bar[XB_XCNT(b.x)], 1u);
    return b;
}
__device__ __forceinline__ void xcd_barrier_complete(unsigned* bar, unsigned x, unsigned& nloc, unsigned& nx) {
    const unsigned G = gridDim.x * gridDim.y * gridDim.z;
    unsigned sum, cnt, mine, sp = 0u;
    for (;;) {
        sum = 0u; cnt = 0u; mine = 0u;
#pragma unroll
        for (unsigned j = 0; j < 16; ++j) { const unsigned c = xb_ld(&bar[XB_XCNT(j)]); sum += c; cnt += (c > 0u) ? 1u : 0u; mine = (j == x) ? c : mine; }
        if (sum == G) break;
        __builtin_amdgcn_s_sleep(1);
        if ((++sp & 255u) == 0u) { if (xb_ld(&bar[XB_TMO])) break; if (sp > XB_SPIN_CAP) { atomicAdd(&bar[XB_TMO], 1u); break; } }
    }
    nloc = mine > 0u ? mine : 1u; nx = cnt > 0u ? cnt : 1u;
}
__device__ __forceinline__ void xcd_barrier(const XcdBarrier& b, const int wave) {
    asm volatile("s_waitcnt vmcnt(0)" ::: "memory");
    __syncthreads();
    if (wave == 0 && lane_id_asm() == 0) {
        unsigned* bar = b.bar;
        __builtin_amdgcn_s_waitcnt(0);
        unsigned nloc = b.st[0], nx = b.st[1];
        if (nloc == 0u) { xcd_barrier_complete(bar, b.x, nloc, nx); b.st[0] = nloc; b.st[1] = nx; }
        const unsigned old = xb_add(&bar[XB_XSUB(b.x)], 1u);
        const unsigned gen = old / nloc;
        if (old + 1u == (gen + 1u) * nloc) {
            __builtin_amdgcn_fence(__ATOMIC_RELEASE, "agent");
            asm volatile("s_waitcnt vmcnt(0)" ::: "memory");
            const unsigned og = xb_add(&bar[XB_TOP], 1u);
            const unsigned tg = og / nx;
            if (og + 1u == (tg + 1u) * nx) xb_add(&bar[XB_TOPGEN], 1u);
            else XB_SPIN(xb_ld(&bar[XB_TOPGEN]) == tg, bar);
            __builtin_amdgcn_fence(__ATOMIC_ACQUIRE, "agent");
            xb_add(&bar[XB_XGEN(b.x)], 1u);
            asm volatile("s_waitcnt vmcnt(0)" ::: "memory");
        } else {
            XB_SPIN(xb_ld(&bar[XB_XGEN(b.x)]) == gen, bar);
            __builtin_amdgcn_fence(__ATOMIC_ACQUIRE, "agent");
            asm volatile("s_waitcnt vmcnt(0)" ::: "memory");
        }
    }
    __syncthreads();
}

namespace pg8 {
constexpr int BM = 256, BK = 64, HALF = 128, HTB = HALF * BK * 2, STAGE_BYTES = 8 * HTB, NXCD = 8, WGM = 8;
__host__ __device__ __forceinline__ int lds_byte(int r, int c) { const int st = (r >> 4) * 2 + (c >> 5), rr = r & 15, cc = c & 31, ob = rr * 64 + cc * 2; return st * 1024 + (ob ^ (((ob >> 9) & 1) << 5)); }
__host__ __device__ __forceinline__ void stage_rc(int b, int& R, int& C) { const int st = b / 1024, sb = b % 1024, swz = sb ^ (((sb >> 9) & 1) << 5); R = (st >> 1) * 16 + swz / 64; C = (st & 1) * 32 + (swz % 64) / 2; }
__host__ __device__ __forceinline__ int perm32(int rho) { const int n = rho >> 4, i = rho & 15; return 8 * (i >> 2) + 4 * n + (i & 3); }

struct Unit { int pm, pn, ord; const char* a; const char* b; };

struct PlainOrder {
    static constexpr bool GATHER = false;
    int nM, nN, nwg, G, c; const char* A; const char* Bt; size_t tstep;
    __device__ void init(const void* A_, const void* Bt_, int M, int N, int K, int G_, int c_) { nM = M / BM; nN = N / BM; nwg = nM * nN; G = G_; c = c_; A = (const char*)A_; Bt = (const char*)Bt_; tstep = (size_t)BM * K * 2; }
    __device__ bool next(int i, Unit& u) const {
#if defined(PROBE_PK)
        const long L = (long)(i >> 1) * G + c; if (L >= nwg) return false;
#else
        const long L = (long)i * G + c; if (L >= nwg) return false;
#endif
        int wgid = (int)L; { const int q = nwg / NXCD, r = nwg % NXCD, xcd = wgid % NXCD, off = wgid / NXCD; wgid = (xcd < r ? xcd * (q + 1) : r * (q + 1) + (xcd - r) * q) + off; }
        const int nig = WGM * nN, gid = wgid / nig, fm = gid * WGM, gsz = (nM - fm) < WGM ? (nM - fm) : WGM;
        u.pm = fm + ((wgid % nig) % gsz); u.pn = (wgid % nig) / gsz; u.ord = i; u.a = A + (size_t)u.pm * tstep; u.b = Bt + (size_t)u.pn * tstep; return true;
    }
    __device__ __forceinline__ unsigned aoff(int, int) const { return 0u; }
};
template <int SH, bool TAB> struct MoeOrder {
    static constexpr bool GATHER = true;
    int NT, G, c; const char* A; const char* W; unsigned rowb; size_t w_exp, w_tile; const LAS unsigned char* te; const LAS unsigned* tab;
    __device__ bool next(int i, Unit& u) const {
#if defined(PROBE_GK)
        const int L = (SH == 1 ? (i >> 1) : i) * G + c; const int rt = L >> SH; if (rt >= NT) return false;
#elif defined(PROBE_DK)
        const int L = (SH == 2 ? (i >> 1) : i) * G + c; const int rt = L >> SH; if (rt >= NT) return false;
#else
        const int L = i * G + c; const int rt = L >> SH; if (rt >= NT) return false;
#endif
        u.pm = rt; u.pn = L & ((1 << SH) - 1); u.ord = i; const int e = te[rt];
        u.a = A; u.b = W + (size_t)e * w_exp + (size_t)u.pn * w_tile; return true;
    }
    __device__ __forceinline__ unsigned aoff(int ord, int r) const { if constexpr (TAB) {
#if defined(PROBE_GK)
            return tab[(ord >> 1) * 256 + r];
#else
            return tab[ord * 256 + r];
#endif
        } else return (unsigned)((((ord * G + c) >> SH) << 8) + r) * rowb; }
};

template <class Epi, class Sched, bool ALIGN_EPI, bool F8 = false>
__device__ __forceinline__ void gemm_phase(LAS unsigned char* lds, const int wid, const int K, const Sched& S, const Epi& E) {
    const int lane = lane_id_asm(), tid = wid * 64 + lane,
        wr = wid >> 2, wc = wid & 3, fr = lane & 15, fq = lane >> 4;
    const int nt = F8 ? K / 128 : K / BK; const int RB = F8 ? K : 2 * K;
    unsigned voffA[2], voffB[2];
#pragma unroll
    for (int i = 0; i < 2; ++i) { int R, C; stage_rc(tid * 16 + i * 8192, R, C); const int Rb = (int)Epi::PERM == 2 ? (64 * (R >> 5) + 16 * ((R >> 2) & 3) + 4 * ((R >> 4) & 1) + (R & 3)) : (Epi::PERM ? ((R & ~31) + perm32(R & 31)) : R);
        voffA[i] = (unsigned)(R * RB + C * 2); voffB[i] = (unsigned)(Rb * RB + C * 2); }
    const size_t kstep = (size_t)(BK * 2);
    const size_t hstep = (size_t)HALF * RB;
    const size_t hstepB = (int)Epi::PERM == 2 ? (size_t)8 * RB : hstep;
    const unsigned ldsw = (unsigned)wid * 1024u;
    const int aoff = lds_byte(wr * 64 + fr, fq * 8), boff = lds_byte(wc * 32 + fr, fq * 8);
#define PG8_SA(b, h) (((b) * 2 + (h)) * HTB)
#define PG8_SB(b, h) ((4 + (b) * 2 + (h)) * HTB)
#define PG8_STAGE(bufoff, gbase, voff) do { _Pragma("unroll") for (int _i = 0; _i < 2; ++_i) \
        __builtin_amdgcn_global_load_lds((const unsigned*)((const char*)(gbase) + (voff)[_i]), (LAS unsigned*)(lds + (bufoff) + ldsw + _i * 8192), 16, 0, 0); } while (0)
#define PG8_STAGE_A(bufoff, kb, h, GO) do { if constexpr (Sched::GATHER) { PG8_STAGE(bufoff, kb, GO[h]); } else { PG8_STAGE(bufoff, (kb) + (h) * hstep, voffA); } } while (0)
#define PG8_STAGE_A2(bufoff, kb, h) do { if constexpr (Sched::GATHER) { if (last) { PG8_STAGE(bufoff, kb, gN[h]); } else { PG8_STAGE(bufoff, kb, gC[h]); } } else { PG8_STAGE(bufoff, (kb) + (h) * hstep, voffA); } } while (0)
#define PG8_FR(p) (*(const LAS v4i_*)(p))
#define PG8_LDA(dst, b, h) do { _Pragma("unroll") for (int m = 0; m < 4; ++m) { if constexpr (F8) { dst##8[m] = __builtin_shufflevector(PG8_FR(lds + PG8_SA(b, h) + aoff + m * 2048), PG8_FR(lds + PG8_SA(b, h) + aoff + m * 2048 + 1024), 0, 1, 2, 3, 4, 5, 6, 7); } \
        else { _Pragma("unroll") for (int k = 0; k < 2; ++k) dst[m][k] = *(const LAS bf16x8*)(lds + PG8_SA(b, h) + aoff + m * 2048 + k * 1024); } } } while (0)
#define PG8_LDB(dst, b, h) do { _Pragma("unroll") for (int n = 0; n < 2; ++n) { if constexpr (F8) { dst##8[n] = __builtin_shufflevector(PG8_FR(lds + PG8_SB(b, h) + boff + n * 2048), PG8_FR(lds + PG8_SB(b, h) + boff + n * 2048 + 1024), 0, 1, 2, 3, 4, 5, 6, 7); } \
        else { _Pragma("unroll") for (int k = 0; k < 2; ++k) dst[n][k] = *(const LAS bf16x8*)(lds + PG8_SB(b, h) + boff + n * 2048 + k * 1024); } } } while (0)
#define PG8_MMA(ai, bj, At, Bt) do { __builtin_amdgcn_s_setprio(1); _Pragma("unroll") for (int m = 0; m < 4; ++m) _Pragma("unroll") for (int n = 0; n < 2; ++n) { \
        if constexpr (F8) { acc[ai][bj][m][n] = __builtin_amdgcn_mfma_scale_f32_16x16x128_f8f6f4(Bt##8[n], At##8[m], acc[ai][bj][m][n], 0, 0, 0, 0x7f7f7f7f, 0, Epi::MXSCALE); } \
        else { _Pragma("unroll") for (int k = 0; k < 2; ++k) acc[ai][bj][m][n] = __builtin_amdgcn_mfma_f32_16x16x32_bf16(Bt[n][k], At[m][k], acc[ai][bj][m][n], 0, 0, 0); } } \
        if constexpr (F8) { _Pragma("unroll") for (int m = 0; m < 4; ++m) asm volatile("" : "+v"(acc[ai][bj][m][0]), "+v"(acc[ai][bj][m][1])); }     \
        __builtin_amdgcn_s_setprio(0); } while (0)
#define PG8_WAIT_V(n) asm volatile("s_waitcnt vmcnt(" #n ")" ::: "memory")
#define PG8_WAIT_L(n) asm volatile("s_waitcnt lgkmcnt(" #n ")" ::: "memory")
#define PG8_WAIT_VR(relax) do { if (relax) asm volatile("s_waitcnt vmcnt(%0)" :: "n"(8 + Epi::NSTORE) : "memory"); else asm volatile("s_waitcnt vmcnt(8)" ::: "memory"); } while (0)
#define PG8_BAR do { __builtin_amdgcn_s_barrier(); if constexpr (F8) asm volatile("" ::: "memory"); } while (0)
#define PG8_SCHED __builtin_amdgcn_sched_barrier(0)
#define PG8_GLOAD(G_, u_) do { if constexpr (Sched::GATHER) { _Pragma("unroll") for (int _i = 0; _i < 2; ++_i) { int R_, C_; stage_rc(tid * 16 + _i * 8192, R_, C_); _Pragma("unroll") for (int _h = 0; _h < 2; ++_h) G_[_h][_i] = S.aoff((u_).ord, _h * HALF + R_) + (unsigned)C_ * 2u; } } } while (0)
    Unit cur, nxt;
    if (!S.next(0, cur)) return;
    f32x4 acc[2][2][4][2];
#pragma unroll
    for (int a = 0; a < 2; ++a)
#pragma unroll
        for (int b = 0; b < 2; ++b)
#pragma unroll
            for (int m = 0; m < 4; ++m)
#pragma unroll
                for (int n = 0; n < 2; ++n) acc[a][b][m][n] = (f32x4){0.f, 0.f, 0.f, 0.f};
    typedef int v4i_ __attribute__((ext_vector_type(4))); typedef int v8i_ __attribute__((ext_vector_type(8)));
    bf16x8 At[4][2], B0[2][2], B1[2][2];
    v8i_ At8[4], B08[2], B18[2];
    unsigned gC[2][2] = {{0u, 0u}, {0u, 0u}}, gN[2][2] = {{0u, 0u}, {0u, 0u}};
    PG8_GLOAD(gC, cur);
    const char* cA = cur.a; const char* cB = cur.b;
    PG8_STAGE(PG8_SB(0, 0), cB, voffB); PG8_STAGE(PG8_SB(0, 1), cB + hstepB, voffB); PG8_STAGE_A(PG8_SA(0, 0), cA, 0, gC); PG8_STAGE_A(PG8_SA(0, 1), cA, 1, gC);
    if (wr == 1) PG8_BAR;
    PG8_WAIT_V(2); PG8_BAR;
    PG8_STAGE(PG8_SB(1, 0), cB + kstep, voffB); PG8_STAGE_A(PG8_SA(1, 0), cA + kstep, 0, gC); PG8_STAGE(PG8_SB(1, 1), cB + hstepB + kstep, voffB);
    PG8_WAIT_V(6); PG8_BAR;
    int ui = 0;
    for (;;) {
        const bool has_next = S.next(ui + 1, nxt);
        const char* nA = has_next ? nxt.a : cA; const char* nB = has_next ? nxt.b : cB;
        if constexpr (Sched::GATHER) { if (has_next) { PG8_GLOAD(gN, nxt); } else {
#pragma unroll
            for (int _h = 0; _h < 2; ++_h)
#pragma unroll
                for (int _i = 0; _i < 2; ++_i) gN[_h][_i] = gC[_h][_i]; } }
#pragma unroll 1
        for (int t = 0; t < nt; t += 2) {
            const bool last = (t == nt - 2);
            const char* a1 = cA + (size_t)(t + 1) * kstep;
            const char* a2 = last ? nA : cA + (size_t)(t + 2) * kstep; const char* b2 = last ? nB : cB + (size_t)(t + 2) * kstep;
            const char* a3 = a2 + kstep; const char* b3 = b2 + kstep;
            if constexpr (Epi::HAS_MID) { if (t == nt / 2) E.mid(acc, cur, wr, fr); }
            const bool relax = Epi::NSTORE > 0 && t == 0 && ui > 0;
            PG8_LDB(B0, 0, 0); PG8_LDB(B1, 0, 1); PG8_SCHED; PG8_LDA(At, 0, 0); if (!relax) PG8_STAGE_A(PG8_SA(1, 1), a1, 1, gC);
            PG8_WAIT_VR(relax); PG8_WAIT_L(0); PG8_BAR; PG8_MMA(0, 0, At, B0); PG8_MMA(0, 1, At, B1); PG8_BAR; PG8_SCHED;
            PG8_LDA(At, 0, 1); PG8_STAGE(PG8_SB(0, 0), b2, voffB); PG8_STAGE(PG8_SB(0, 1), b2 + hstepB, voffB); PG8_STAGE_A2(PG8_SA(0, 0), a2, 0);
            PG8_WAIT_VR(relax); PG8_WAIT_L(0); PG8_BAR; PG8_MMA(1, 0, At, B0); PG8_MMA(1, 1, At, B1); PG8_BAR; PG8_SCHED;
            PG8_LDB(B0, 1, 0); PG8_LDB(B1, 1, 1); PG8_SCHED; PG8_LDA(At, 1, 0); PG8_STAGE_A2(PG8_SA(0, 1), a2, 1);
            PG8_WAIT_VR(relax); PG8_WAIT_L(0); PG8_BAR; PG8_MMA(0, 0, At, B0); PG8_MMA(0, 1, At, B1); PG8_BAR; PG8_SCHED;
            PG8_LDA(At, 1, 1); PG8_STAGE(PG8_SB(1, 0), b3, voffB); PG8_STAGE(PG8_SB(1, 1), b3 + hstepB, voffB); PG8_STAGE_A2(PG8_SA(1, 0), a3, 0);
            PG8_WAIT_V(8); PG8_WAIT_L(0); PG8_BAR; PG8_MMA(1, 0, At, B0); PG8_MMA(1, 1, At, B1); PG8_BAR; PG8_SCHED;
        }
        if constexpr (Epi::NSTORE > 0) { if (has_next) PG8_STAGE_A(PG8_SA(1, 1), nA + kstep, 1, gN); }
        if constexpr (ALIGN_EPI) { if (wr == 0) PG8_BAR; }
        E(acc, cur, wr, wc, fr, fq);
        if (!has_next) break;
#pragma unroll
        for (int a = 0; a < 2; ++a)
#pragma unroll
            for (int b = 0; b < 2; ++b)
#pragma unroll
                for (int m = 0; m < 4; ++m)
#pragma unroll
                    for (int n = 0; n < 2; ++n) acc[a][b][m][n] = (f32x4){0.f, 0.f, 0.f, 0.f};
        cur = nxt; cA = nA; cB = nB; ++ui;
#pragma unroll
        for (int _h = 0; _h < 2; ++_h)
#pragma unroll
            for (int _i = 0; _i < 2; ++_i) gC[_h][_i] = gN[_h][_i];
        if constexpr (ALIGN_EPI) { if (wr == 1) PG8_BAR; }
    }
    PG8_WAIT_V(0);
    if constexpr (!ALIGN_EPI) { if (wr == 0) PG8_BAR; }
    PG8_BAR;
#undef PG8_SA
#undef PG8_SB
#undef PG8_STAGE
#undef PG8_STAGE_A
#undef PG8_STAGE_A2
#undef PG8_LDA
#undef PG8_FR
#undef PG8_LDB
#undef PG8_MMA
#undef PG8_WAIT_V
#undef PG8_WAIT_L
#undef PG8_WAIT_VR
#undef PG8_BAR
#undef PG8_SCHED
#undef PG8_GLOAD
}

struct EpiBf16 {
    static constexpr bool PERM = true, HAS_MID = false; static constexpr int NSTORE = 16;
    static constexpr int MXSCALE = 0x7f7f7f7f;
    bf16* O; int ldc;
    __device__ __forceinline__ void operator()(const f32x4 (&acc)[2][2][4][2], const Unit& u, int wr, int wc, int fr, int fq) const {
#if defined(PROBE_PK)
        if ((u.ord & 1) == 0) return;
#endif
        const int row0 = u.pm * BM + wr * 64 + fr, col0 = u.pn * BM + wc * 32 + 8 * fq;
#pragma unroll
        for (int ai = 0; ai < 2; ++ai)
#pragma unroll
            for (int m = 0; m < 4; ++m) { bf16* rowp = O + (size_t)(row0 + ai * HALF + m * 16) * ldc + col0;
#pragma unroll
                for (int bj = 0; bj < 2; ++bj) { const f32x4 v0 = acc[ai][bj][m][0], v1 = acc[ai][bj][m][1];
                    u32x4 w; w.x = cvt_pk_bf16(v0[0], v0[1]); w.y = cvt_pk_bf16(v0[2], v0[3]); w.z = cvt_pk_bf16(v1[0], v1[1]); w.w = cvt_pk_bf16(v1[2], v1[3]);
                    *(u32x4*)(rowp + bj * HALF) = w; } }
    }
};
struct EpiBf16T {
    static constexpr bool PERM = true, HAS_MID = false; static constexpr int NSTORE = 16;
    static constexpr int MXSCALE = 0x7f7f7f7f;
    bf16* O; int ntn;
    __device__ __forceinline__ void operator()(const f32x4 (&acc)[2][2][4][2], const Unit& u, int wr, int wc, int fr, int fq) const {
        bf16* tile = O + ((size_t)u.pm * ntn + u.pn) * 65536 + (wr * 64 + fr) * 256 + wc * 32 + 8 * fq;
#pragma unroll
        for (int ai = 0; ai < 2; ++ai)
#pragma unroll
            for (int m = 0; m < 4; ++m) { bf16* rowp = tile + (ai * HALF + m * 16) * 256;
#pragma unroll
                for (int bj = 0; bj < 2; ++bj) { const f32x4 v0 = acc[ai][bj][m][0], v1 = acc[ai][bj][m][1];
                    u32x4 w; w.x = cvt_pk_bf16(v0[0], v0[1]); w.y = cvt_pk_bf16(v0[2], v0[3]); w.z = cvt_pk_bf16(v1[0], v1[1]); w.w = cvt_pk_bf16(v1[2], v1[3]);
                    *(u32x4*)(rowp + bj * HALF) = w; } }
    }
};
struct EpiGU {
    static constexpr bool PERM = true, HAS_MID = false; static constexpr int NSTORE = 8;
    static constexpr int MXSCALE = 0x7f7f7f7f;
    unsigned char* H;
    __device__ __forceinline__ void operator()(const f32x4 (&acc)[2][2][4][2], const Unit& u, int wr, int wc, int fr, int fq) const {
#if defined(PROBE_GK)
        if ((u.ord & 1) == 0) return;
#endif
        const int row0 = u.pm * BM + wr * 64 + fr, col0 = u.pn * HALF + wc * 32 + 8 * fq;
#pragma unroll
        for (int ai = 0; ai < 2; ++ai)
#pragma unroll
            for (int m = 0; m < 4; ++m) { unsigned char* rowp = H + (size_t)(row0 + ai * HALF + m * 16) * 256 + col0;
                float h[8];
#pragma unroll
                for (int n = 0; n < 2; ++n)
#pragma unroll
                    for (int i = 0; i < 4; i += 2) {
                        const f32x2 g = (f32x2){acc[ai][0][m][n][i], acc[ai][0][m][n][i + 1]}, u = (f32x2){acc[ai][1][m][n][i], acc[ai][1][m][n][i + 1]};
                        const f32x2 t = g * (-1.4426950408889634f / 64.0f); const f32x2 e = (f32x2){__builtin_amdgcn_exp2f(t.x), __builtin_amdgcn_exp2f(t.y)};
                        const f32x2 d = e * 1024.0f + 1024.0f;
                        const f32x2 r = (f32x2){__builtin_amdgcn_rcpf(d.x), __builtin_amdgcn_rcpf(d.y)}; const f32x2 hh = (g * u) * r;
                        h[4 * n + i] = hh.x; h[4 * n + i + 1] = hh.y; }
                int lo = __builtin_amdgcn_cvt_pk_fp8_f32(h[0], h[1], 0, false); lo = __builtin_amdgcn_cvt_pk_fp8_f32(h[2], h[3], lo, true);
                int hi = __builtin_amdgcn_cvt_pk_fp8_f32(h[4], h[5], 0, false); hi = __builtin_amdgcn_cvt_pk_fp8_f32(h[6], h[7], hi, true);
                *(u32x2*)rowp = (u32x2){(unsigned)lo, (unsigned)hi}; }
    }
};
struct EpiFp8 {
    static constexpr int PERM = 2; static constexpr bool HAS_MID = false; static constexpr int NSTORE = 8;
    static constexpr int MXSCALE = 0x7b7b7b7b;
    unsigned char* O; int ldc; float sc;
    __device__ __forceinline__ void operator()(const f32x4 (&acc)[2][2][4][2], const Unit& u, int wr, int wc, int fr, int fq) const {
        unsigned char* tile = O + ((size_t)u.pm * 4 + u.pn) * 65536 + (size_t)(wr * 64 + fr) * 256 + wc * 64 + 16 * fq;
#pragma unroll
        for (int ai = 0; ai < 2; ++ai)
#pragma unroll
            for (int m = 0; m < 4; ++m) { u32x4 w;
#pragma unroll
                for (int bj = 0; bj < 2; ++bj) { const f32x4 v0 = acc[ai][bj][m][0], v1 = acc[ai][bj][m][1];
                    int lo = __builtin_amdgcn_cvt_pk_fp8_f32(v0[0], v0[1], 0, false); lo = __builtin_amdgcn_cvt_pk_fp8_f32(v0[2], v0[3], lo, true);
                    int hi = __builtin_amdgcn_cvt_pk_fp8_f32(v1[0], v1[1], 0, false); hi = __builtin_amdgcn_cvt_pk_fp8_f32(v1[2], v1[3], hi, true);
                    if (bj == 0) { w.x = (unsigned)lo; w.y = (unsigned)hi; } else { w.z = (unsigned)lo; w.w = (unsigned)hi; } }
                *(u32x4*)(tile + (ai * HALF + m * 16) * 256) = w; }
    }
};
struct EpiX1 {
    static constexpr bool PERM = true, HAS_MID = true; static constexpr int NSTORE = 0;
    static constexpr int MXSCALE = 0x7f7f7f7f;
    const float* x; bf16* o; const float* g1; const LAS float* rstab;
    __device__ __forceinline__ void mid(f32x4 (&acc)[2][2][4][2], const Unit& u, int wr, int fr) const {
#pragma unroll
        for (int ai = 0; ai < 2; ++ai)
#pragma unroll
            for (int m = 0; m < 4; ++m) { const float rs = rstab[u.ord * 256 + ai * HALF + wr * 64 + m * 16 + fr];
#pragma unroll
                for (int bj = 0; bj < 2; ++bj)
#pragma unroll
                    for (int n = 0; n < 2; ++n) acc[ai][bj][m][n] = acc[ai][bj][m][n] * rs; }
    }
    __device__ __forceinline__ void operator()(const f32x4 (&acc)[2][2][4][2], const Unit& u, int wr, int wc, int fr, int fq) const {
        const int row0 = u.pm * BM + wr * 64 + fr, col0 = u.pn * BM + wc * 32 + 8 * fq; const int b = (u.pm * BM) / SEQ;
        f32x4 gv[2][2];
#pragma unroll
        for (int bj = 0; bj < 2; ++bj)
#pragma unroll
            for (int n = 0; n < 2; ++n) gv[bj][n] = *(const f32x4*)(g1 + (size_t)b * 6144 + col0 + bj * HALF + 4 * n);
#pragma unroll
        for (int ai = 0; ai < 2; ++ai) {
            f32x4 xv[4][2][2];
#pragma unroll
            for (int m = 0; m < 4; ++m)
#pragma unroll
                for (int bj = 0; bj < 2; ++bj)
#pragma unroll
                    for (int n = 0; n < 2; ++n) xv[m][bj][n] = *(const f32x4*)(x + (size_t)(row0 + ai * HALF + m * 16) * D + col0 + bj * HALF + 4 * n);
#pragma unroll
            for (int m = 0; m < 4; ++m)
#pragma unroll
                for (int bj = 0; bj < 2; ++bj) { const f32x4 v0 = xv[m][bj][0] + gv[bj][0] * acc[ai][bj][m][0], v1 = xv[m][bj][1] + gv[bj][1] * acc[ai][bj][m][1];
                    u32x4 w; w.x = cvt_pk_bf16(v0[0], v0[1]); w.y = cvt_pk_bf16(v0[2], v0[3]); w.z = cvt_pk_bf16(v1[0], v1[1]); w.w = cvt_pk_bf16(v1[2], v1[3]);
                    *(u32x4*)(o + (size_t)(row0 + ai * HALF + m * 16) * D + col0 + bj * HALF) = w; }
            asm volatile("" ::: "memory"); }
    }
};
struct EpiLogits {
    static constexpr bool PERM = false, HAS_MID = false; static constexpr int NSTORE = 0;
    static constexpr int MXSCALE = 0x7f7f7f7f;
    float* L;
    __device__ __forceinline__ void operator()(const f32x4 (&acc)[2][2][4][2], const Unit& u, int wr, int wc, int fr, int fq) const {
        if (wc < 2 && u.pn == 0) {
            const int row0 = u.pm * BM + wr * 64 + fr, col0 = wc * 32 + 4 * fq;
#pragma unroll
            for (int ai = 0; ai < 2; ++ai)
#pragma unroll
                for (int m = 0; m < 4; ++m)
#pragma unroll
                    for (int n = 0; n < 2; ++n) *(f32x4*)(L + (size_t)(row0 + ai * HALF + m * 16) * 64 + col0 + n * 16) = acc[ai][0][m][n];
        }
    }
};
}

struct Args { const float* in[24]; float* out; unsigned char* ws; int ph_lo, ph_hi; };
typedef const Args __attribute__((address_space(4))) CArgs;
#define ARGS_LAUNDER(src_) CArgs* ap_ = &(src_); asm volatile("" : "+s"(ap_)); CArgs& args = *ap_
struct Frame {
    LAS unsigned char* lds; volatile LAS unsigned* MISC; unsigned* ctl;
    int tid, lane, wave, vcu, G;
};

struct TrIt { const float* src; unsigned char* dst; const float* ks; int ldw, ldk, useks, f8; };
__device__ __forceinline__ void tr_load(const TrIt& t, f32x4 (&tv)[8], float (&tk)[8], int lane) {
#pragma unroll
    for (int i = 0; i < 8; ++i) { const int kk = 8 * i + (lane >> 3), n4 = 4 * (lane & 7); tv[i] = *(const f32x4*)(t.src + (size_t)kk * t.ldw + n4); tk[i] = t.ks[kk]; }
}
__device__ __forceinline__ void tr_store(const TrIt& t, const f32x4 (&tv)[8], const float (&tk)[8], LAS float* scr, int lane) {
#pragma unroll
    for (int i = 0; i < 8; ++i) { const int kk = 8 * i + (lane >> 3), n4 = 4 * (lane & 7); const f32x4 v = tv[i] * (t.useks ? tk[i] : 1.0f);
        LAS float* d = scr + kk * 33 + n4; d[0] = v.x; d[1] = v.y; d[2] = v.z; d[3] = v.w; }
    LDS_WAIT(); asm volatile("" ::: "memory");
    const int c = lane & 7;
#pragma unroll
    for (int j = 0; j < 4; ++j) { const int n = (lane >> 3) + 8 * j; const LAS float* s = scr + (8 * c) * 33 + n;
        if (t.f8) {
            int lo = __builtin_amdgcn_cvt_pk_fp8_f32(s[0 * 33] * 64.f, s[1 * 33] * 64.f, 0, false); lo = __builtin_amdgcn_cvt_pk_fp8_f32(s[2 * 33] * 64.f, s[3 * 33] * 64.f, lo, true);
            int hi = __builtin_amdgcn_cvt_pk_fp8_f32(s[4 * 33] * 64.f, s[5 * 33] * 64.f, 0, false); hi = __builtin_amdgcn_cvt_pk_fp8_f32(s[6 * 33] * 64.f, s[7 * 33] * 64.f, hi, true);
            *(u32x2*)(t.dst + (size_t)n * t.ldk + 8 * c) = (u32x2){(unsigned)lo, (unsigned)hi};
        } else {
            u32x4 o; o.x = cvt_pk_bf16(s[0 * 33], s[1 * 33]); o.y = cvt_pk_bf16(s[2 * 33], s[3 * 33]); o.z = cvt_pk_bf16(s[4 * 33], s[5 * 33]); o.w = cvt_pk_bf16(s[6 * 33], s[7 * 33]);
            *(u32x4*)(t.dst + ((size_t)n * t.ldk + 8 * c) * 2) = o; } }
    LDS_WAIT(); asm volatile("" ::: "memory");
}
__device__ __forceinline__ void p0_prologue(const Frame& F_, CArgs& args_) {
    Frame F = F_; F.lane = lane_id_asm(); F.tid = F.wave * 64 + F.lane;
    ARGS_LAUNDER(args_);
    const int gw = F.vcu * 8 + F.wave, NGW = F.G * 8, lane = F.lane;
    for (int cg = F.vcu; cg < 96; cg += F.G) {
        const int j = cg * 64 + lane, k0 = F.wave * 128;
        float acc[16];
#pragma unroll
        for (int b = 0; b < 16; ++b) acc[b] = 0.f;
#pragma unroll 8
        for (int kk = 0; kk < 128; ++kk) { const float w = (args.in[2])[(size_t)(k0 + kk) * 6144 + j];
#pragma unroll
            for (int b = 0; b < 16; ++b) acc[b] += (args.in[1])[b * 1024 + k0 + kk] * w; }
        LAS float* part = (LAS float*)F.lds;
#pragma unroll
        for (int b = 0; b < 16; ++b) part[(F.wave * 16 + b) * 64 + lane] = acc[b];
        WG_BAR();
        for (int o = F.tid; o < 1024; o += 512) { const int b = o >> 6, jj = o & 63; float s = (args.in[3])[cg * 64 + jj];
#pragma unroll
            for (int w = 0; w < 8; ++w) s += part[(w * 16 + b) * 64 + jj];
            ((float*)(args.ws + WS_MOD))[b * 6144 + cg * 64 + jj] = s; }
        WG_BAR();
    }
    LAS float* scr = (LAS float*)(F.lds + F.wave * 16384);
    constexpr int I_IN = 16 * 96, I_OUT = 16 * 32, I_E = NEX * 128;
    constexpr int NITEMS = I_IN + I_OUT + 3 * I_E;
    auto decode = [&](int it) -> TrIt { TrIt t; t.useks = 0; t.ks = (args.in[12]); t.f8 = 0; int r = it;
        if (r < I_IN) { const int kb = r / 96, nb = r % 96; t.src = (args.in[5]) + (size_t)(kb * 64) * LDWIN + nb * 32; t.ldw = LDWIN; t.dst = (unsigned char*)(((bf16*)(args.ws + WS_WIN)) + (size_t)(nb * 32) * 1024 + kb * 64); t.ldk = 1024; return t; } r -= I_IN;
        if (r < I_OUT) { const int kb = r / 32, nb = r % 32, k0 = kb * 64; const int dc = k0 < 512 ? k0 + 512 : k0 - 512;
            t.src = (args.in[13]) + (size_t)k0 * 1024 + nb * 32; t.ldw = 1024; t.dst = (unsigned char*)(((bf16*)(args.ws + WS_WOUT)) + (size_t)(nb * 32) * 1024 + dc); t.ldk = 1024; if (k0 >= 512) { t.useks = 1; t.ks = (args.in[12]) + (k0 - 512); } return t; } r -= I_OUT;
        t.f8 = 1;
        if (r < 2 * I_E) { const int up = r >= I_E; if (up) r -= I_E; const int e = r / 128, q = r % 128, kb = q / 8, nb = q % 8, n0 = nb * 32;
            const float* W = up ? (e < NE ? (args.in[18]) + (size_t)e * 262144 : (args.in[21])) : (e < NE ? (args.in[17]) + (size_t)e * 262144 : (args.in[20]));
            const int drow = (n0 / 128) * 256 + up * 128 + (n0 % 128);
            t.src = W + (size_t)(kb * 64) * 256 + n0; t.ldw = 256; t.dst = (unsigned char*)(args.ws + WS_WGU) + ((size_t)e * 512 + drow) * 1024 + kb * 64; t.ldk = 1024; return t; } r -= 2 * I_E;
        { const int e = r / 128, q = r % 128, kb = q / 32, nb = q % 32; const float* W = e < NE ? (args.in[19]) + (size_t)e * 262144 : (args.in[22]);
            t.src = W + (size_t)(kb * 64) * 1024 + nb * 32; t.ldw = 1024; t.dst = (unsigned char*)(args.ws + WS_WD) + ((size_t)e * 1024 + nb * 32) * 256 + kb * 64; t.ldk = 256; return t; } };
    if (gw < NITEMS) {
        TrIt nxt = decode(gw); f32x4 nv[8]; float nk[8];
        tr_load(nxt, nv, nk, lane);
#pragma unroll 1
        for (int it = gw; it < NITEMS; it += NGW) {
            const TrIt cur = nxt; f32x4 cv[8]; float ck[8];
#pragma unroll
            for (int i = 0; i < 8; ++i) { cv[i] = nv[i]; ck[i] = nk[i]; }
            nxt = decode(it + NGW < NITEMS ? it + NGW : it);
            tr_load(nxt, nv, nk, lane);
            tr_store(cur, cv, ck, scr, lane);
        }
    }
    for (int e = blockIdx.x * 512 + F.tid; e < 4096; e += F.G * 512) { const int p = e >> 3, hh = e & 7;
        ((unsigned*)(args.ws + WS_WDT))[e] = cvt_pk_bf16((args.in[5])[(size_t)(2 * p) * LDWIN + NPROJ + hh], (args.in[5])[(size_t)(2 * p + 1) * LDWIN + NPROJ + hh]); }
}

template <bool WITH_DT, bool XBF>
__device__ __forceinline__ void p_norm_mod(const Frame& F_, CArgs& args_, const void* xin_, const float* gain, int shift_off, int scale_off, bf16* hout, unsigned char* h8out) {
    Frame F = F_; F.lane = lane_id_asm(); F.tid = F.wave * 64 + F.lane;
    ARGS_LAUNDER(args_);
    const int gw = F.vcu * 8 + F.wave, NGW = F.G * 8, lane = F.lane;
    for (int blk = gw; blk < T / 32; blk += NGW) {
        const int row0 = blk * 32, b = row0 / SEQ;
        f32x4 sc[4], sh[4];
#pragma unroll
        for (int j = 0; j < 4; ++j) { const int col = 4 * lane + 256 * j; const f32x4 g = *(const f32x4*)(gain + col); const f32x4 s1 = *(const f32x4*)(((float*)(args.ws + WS_MOD)) + b * 6144 + scale_off + col);
            sc[j] = g * (s1 + 1.0f); sh[j] = *(const f32x4*)(((float*)(args.ws + WS_MOD)) + b * 6144 + shift_off + col); }
        unsigned wdt[WITH_DT ? 4 : 1][2][WITH_DT ? 8 : 1];
        if constexpr (WITH_DT) {
#pragma unroll
            for (int j = 0; j < 4; ++j)
#pragma unroll
                for (int pr = 0; pr < 2; ++pr) { const u32x4* wp = (const u32x4*)(args.ws + WS_WDT) + (size_t)(2 * lane + 128 * j + pr) * 2; const u32x4 a = wp[0], c = wp[1];
                    wdt[j][pr][0] = a.x; wdt[j][pr][1] = a.y; wdt[j][pr][2] = a.z; wdt[j][pr][3] = a.w; wdt[j][pr][4] = c.x; wdt[j][pr][5] = c.y; wdt[j][pr][6] = c.z; wdt[j][pr][7] = c.w; }
        }
        float dtb = 0.f; if constexpr (WITH_DT) dtb = (args.in[9])[lane & 7];
        f32x4 nx[2][4];
#pragma unroll
        for (int p = 0; p < 2; ++p)
#pragma unroll
            for (int j = 0; j < 4; ++j) {
                if constexpr (XBF) { const u32x2 w = ((const u32x2*)((const bf16*)xin_ + (size_t)(row0 + p) * D) + lane)[64 * j]; nx[p][j] = (f32x4){bflo(w.x), bfhi(w.x), bflo(w.y), bfhi(w.y)}; }
                else nx[p][j] = ((const f32x4*)((const float*)xin_ + (size_t)(row0 + p) * D) + lane)[64 * j]; }
#pragma unroll 2
        for (int r = 0; r < 32; ++r) {
            const int row = row0 + r;
            f32x4 v[4]; float s = 0.f;
#pragma unroll
            for (int j = 0; j < 4; ++j) v[j] = nx[r & 1][j];
            { const int rn = row0 + (r + 2 < 32 ? r + 2 : 31);
#pragma unroll
                for (int j = 0; j < 4; ++j) {
                    if constexpr (XBF) { const u32x2 w = ((const u32x2*)((const bf16*)xin_ + (size_t)rn * D) + lane)[64 * j]; nx[r & 1][j] = (f32x4){bflo(w.x), bfhi(w.x), bflo(w.y), bfhi(w.y)}; }
                    else nx[r & 1][j] = ((const f32x4*)((const float*)xin_ + (size_t)rn * D) + lane)[64 * j]; } }
#pragma unroll
            for (int j = 0; j < 4; ++j) s += (v[j].x * v[j].x + v[j].y * v[j].y) + (v[j].z * v[j].z + v[j].w * v[j].w);
            const float rstd = rsqrtf(wave_sum(s) * (1.0f / D) + EPS);
            u32x2* o8 = (u32x2*)(hout + (size_t)row * D) + lane;
            float dv[8] = {0.f, 0.f, 0.f, 0.f, 0.f, 0.f, 0.f, 0.f};
#pragma unroll
            for (int j = 0; j < 4; ++j) { const f32x4 h = v[j] * rstd * sc[j] + sh[j];
                if constexpr (!WITH_DT) { int q8 = __builtin_amdgcn_cvt_pk_fp8_f32(h.x, h.y, 0, false); q8 = __builtin_amdgcn_cvt_pk_fp8_f32(h.z, h.w, q8, true); ((unsigned*)(h8out + (size_t)row * D))[lane + 64 * j] = (unsigned)q8; }
                const unsigned wx = cvt_pk_bf16(h.x, h.y), wy = cvt_pk_bf16(h.z, h.w); if (WITH_DT) o8[64 * j] = (u32x2){wx, wy};
                if constexpr (WITH_DT) {
                    typedef __bf16 bf2 __attribute__((ext_vector_type(2)));
#pragma unroll
                    for (int hh = 0; hh < 8; ++hh) { dv[hh] = __builtin_amdgcn_fdot2_f32_bf16(__builtin_bit_cast(bf2, wx), __builtin_bit_cast(bf2, wdt[j][0][hh]), dv[hh], false);
                        dv[hh] = __builtin_amdgcn_fdot2_f32_bf16(__builtin_bit_cast(bf2, wy), __builtin_bit_cast(bf2, wdt[j][1][hh]), dv[hh], false); } } }
            if constexpr (WITH_DT) {
#pragma unroll
                for (int hh = 0; hh < 8; ++hh) dv[hh] = wave_sum(dv[hh]);
                float mine = dv[0];
#pragma unroll
                for (int hh = 1; hh < 8; ++hh) mine = (lane == hh) ? dv[hh] : mine;
                if (lane < 8) { const float a = mine + dtb; ((float*)(args.ws + WS_DT))[(size_t)row * 8 + lane] = a > 20.f ? a : log1pf(__expf(a)); }
            }
        }
    }
}

__device__ __forceinline__ void p3_conv(const Frame& F_, CArgs& args_) {
    Frame F = F_; F.lane = lane_id_asm(); F.tid = F.wave * 64 + F.lane;
    ARGS_LAUNDER(args_);
    const int q = F.tid & 63, seg = F.tid >> 6;
    for (int tile = F.vcu; tile < T / 256; tile += F.G) {
        const int r0 = tile * 256 + seg * 32; const bool head = (r0 % SEQ) == 0;
        {
            float w0[8], w1[8], w2[8], pm2[8], pm1[8];
#pragma unroll
            for (int i = 0; i < 8; ++i) { w0[i] = (args.in[6])[0 * 512 + 8 * q + i]; w1[i] = (args.in[6])[1 * 512 + 8 * q + i]; w2[i] = (args.in[6])[2 * 512 + 8 * q + i]; pm2[i] = 0.f; pm1[i] = 0.f; }
            if (!head) {
                float a[8], b[8];
                unpack8(*(const u32x4*)(((bf16*)(args.ws + WS_A)) + pj((size_t)(r0 - 2), C_CC + 8 * q)), a); unpack8(*(const u32x4*)(((bf16*)(args.ws + WS_A)) + pj((size_t)(r0 - 2), C_CU + 8 * q)), b);
#pragma unroll
                for (int i = 0; i < 8; ++i) pm2[i] = a[i] * b[i];
                unpack8(*(const u32x4*)(((bf16*)(args.ws + WS_A)) + pj((size_t)(r0 - 1), C_CC + 8 * q)), a); unpack8(*(const u32x4*)(((bf16*)(args.ws + WS_A)) + pj((size_t)(r0 - 1), C_CU + 8 * q)), b);
#pragma unroll
                for (int i = 0; i < 8; ++i) pm1[i] = a[i] * b[i];
            }
            const bf16* pj0 = ((bf16*)(args.ws + WS_A));
            constexpr int YB = 4; u32x4 nb[YB][3];
#pragma unroll
            for (int j = 0; j < YB; ++j) { nb[j][0] = *(const u32x4*)(pj0 + pj((size_t)(r0 + j), C_CB + 8 * q)); nb[j][1] = *(const u32x4*)(pj0 + pj((size_t)(r0 + j), C_CC + 8 * q)); nb[j][2] = *(const u32x4*)(pj0 + pj((size_t)(r0 + j), C_CU + 8 * q)); }
#pragma unroll 1
            for (int r = 0; r < 32; r += YB) {
                u32x4 cur[YB][3];
#pragma unroll
                for (int j = 0; j < YB; ++j) { cur[j][0] = nb[j][0]; cur[j][1] = nb[j][1]; cur[j][2] = nb[j][2]; }
                {
#pragma unroll
                    for (int j = 0; j < YB; ++j) { const size_t rn = (size_t)(r0 + (r + YB + j < 32 ? r + YB + j : 31));
                        nb[j][0] = *(const u32x4*)(pj0 + pj(rn, C_CB + 8 * q)); nb[j][1] = *(const u32x4*)(pj0 + pj(rn, C_CC + 8 * q)); nb[j][2] = *(const u32x4*)(pj0 + pj(rn, C_CU + 8 * q)); } }
#pragma unroll
                for (int j = 0; j < YB; ++j) {
                    float cb[8], cc[8], cu[8], y[8];
                    unpack8(cur[j][0], cb); unpack8(cur[j][1], cc); unpack8(cur[j][2], cu);
#pragma unroll
                    for (int i = 0; i < 8; ++i) { const float p = cc[i] * cu[i]; y[i] = cb[i] * (w0[i] * pm2[i] + w1[i] * pm1[i] + w2[i] * p); pm2[i] = pm1[i]; pm1[i] = p; }
                    *(u32x4*)(((bf16*)(args.ws + WS_HB)) + (size_t)(r0 + r + j) * D + 512 + 8 * q) = pack8(y);
                }
            }
        }
#pragma unroll 1
        for (int jj = 0; jj < 2; ++jj) {
            const int ch0 = 8 * (q + 64 * jj);
            float w0[8], w1[8], w2[8], w3[8], bs[8], u3[8], u2[8], u1[8];
#pragma unroll
            for (int i = 0; i < 8; ++i) { w0[i] = (args.in[7])[0 * 1024 + ch0 + i]; w1[i] = (args.in[7])[1 * 1024 + ch0 + i]; w2[i] = (args.in[7])[2 * 1024 + ch0 + i]; w3[i] = (args.in[7])[3 * 1024 + ch0 + i];
                bs[i] = (args.in[8])[ch0 + i]; u3[i] = 0.f; u2[i] = 0.f; u1[i] = 0.f; }
            if (!head) { unpack8(*(const u32x4*)(((bf16*)(args.ws + WS_A)) + pj((size_t)(r0 - 3), C_XBC + ch0)), u3); unpack8(*(const u32x4*)(((bf16*)(args.ws + WS_A)) + pj((size_t)(r0 - 2), C_XBC + ch0)), u2);
                unpack8(*(const u32x4*)(((bf16*)(args.ws + WS_A)) + pj((size_t)(r0 - 1), C_XBC + ch0)), u1); }
            const bf16* pjx = ((bf16*)(args.ws + WS_A));
            constexpr int XB = 8; u32x4 nb[XB];
#pragma unroll
            for (int j = 0; j < XB; ++j) nb[j] = *(const u32x4*)(pjx + pj((size_t)(r0 + j), C_XBC + ch0));
#pragma unroll 1
            for (int r = 0; r < 32; r += XB) {
                u32x4 cur[XB];
#pragma unroll
                for (int j = 0; j < XB; ++j) cur[j] = nb[j];
#pragma unroll
                for (int j = 0; j < XB; ++j) nb[j] = *(const u32x4*)(pjx + pj((size_t)(r0 + (r + XB + j < 32 ? r + XB + j : 31)), C_XBC + ch0));
#pragma unroll
                for (int j = 0; j < XB; ++j) {
                    float u[8], y[8]; unpack8(cur[j], u);
#pragma unroll
                    for (int i = 0; i < 8; ++i) { y[i] = silu_f(bs[i] + w0[i] * u3[i] + w1[i] * u2[i] + w2[i] * u1[i] + w3[i] * u[i]); u3[i] = u2[i]; u2[i] = u1[i]; u1[i] = u[i]; }
                    *(u32x4*)(((bf16*)(args.ws + WS_XC)) + (size_t)(r0 + r + j) * D + ch0) = pack8(y);
                }
            }
        }
    }
}

constexpr int SD_SET = 55296, SD_BM = 0, SD_CM = 17408, SD_DX = 34816, SD_DXD = 39936, SD_XS = 45056, SD_ZR = 50176, SD_WM = 2 * SD_SET, SD_SB = SD_WM + 2 * 9216, SD_ACS = SD_SB + 8704, SD_DTS = SD_ACS + 768, SD_END = SD_DTS + 768;
static_assert(SD_END <= MISC_OFF, "SSD LDS map");
typedef short s16x4 __attribute__((ext_vector_type(4)));
__device__ __forceinline__ bf16x8 lds_tr8(const LAS unsigned char* p, int stride4) {
    const s16x4 a = __builtin_bit_cast(s16x4, __builtin_amdgcn_ds_read_tr16_b64_v4i16((LAS s16x4*)p));
    const s16x4 b = __builtin_bit_cast(s16x4, __builtin_amdgcn_ds_read_tr16_b64_v4i16((LAS s16x4*)(p + stride4)));
    return __builtin_shufflevector(a, b, 0, 1, 2, 3, 4, 5, 6, 7);
}
#define DPP_SHR_ADD(v, n) do { const int t_ = __builtin_amdgcn_update_dpp(0, __float_as_int(v), 0x110 + (n), 0xf, 0xf, true); (v) += __int_as_float(t_); } while (0)
__device__ __forceinline__ void p4_ssd(const Frame& F_, CArgs& args_) {
    Frame F = F_; F.lane = lane_id_asm(); F.tid = F.wave * 64 + F.lane;
    ARGS_LAUNDER(args_);
    LAS unsigned char* lds = F.lds; const int tid = F.tid, lane = F.lane, wave = F.wave, fr = lane & 15, fq = lane >> 4;
    const int tq = fr >> 2, tp = fr & 3;
    for (int uid = F.vcu; uid < 256; uid += F.G) {
        const int b = uid >> 4, h = (uid >> 1) & 7, ph = uid & 1, g = h >> 2;
        const float Ah = -__expf((args.in[10])[h]), Dh = (args.in[11])[h];
        const int xs_col = h * 64 + ph * 32, b_col = 512 + g * 128, c_col = 768 + g * 128, z_col = C_Z + h * 64 + ph * 32;
        f32x4 Sacc[2] = {(f32x4){0.f, 0.f, 0.f, 0.f}, (f32x4){0.f, 0.f, 0.f, 0.f}};
        for (int i = tid; i < 32 * 136 / 2; i += 512) ((LAS unsigned*)(lds + SD_SB))[i] = 0u;
        u32x4 pb[2][2], pc[2][2], px[2], pz[2]; float pdt[2] = {0.f, 0.f};
#pragma unroll
        for (int X = 0; X < 2; ++X) { px[X] = (u32x4){0u, 0u, 0u, 0u}; pz[X] = (u32x4){0u, 0u, 0u, 0u}; }
        const size_t trow0 = (size_t)b * SEQ;
        const bf16* XCp = ((const bf16*)(args.ws + WS_XC)); const bf16* PJ = ((const bf16*)(args.ws + WS_A)); const float* DTp = ((const float*)(args.ws + WS_DT));
        bf16* HBp = ((bf16*)(args.ws + WS_HB)); float* SQp = ((float*)(args.ws + WS_SSQ));
#define SSD_LOAD(cc, X) do { const size_t t0_ = trow0 + (size_t)(cc) * 64; \
            _Pragma("unroll") for (int k = 0; k < 2; ++k) { const int i_ = tid + 512 * k; pb[X][k] = *(const u32x4*)(XCp + (t0_ + (i_ >> 4)) * D + b_col + 8 * (i_ & 15)); pc[X][k] = *(const u32x4*)(XCp + (t0_ + (i_ >> 4)) * D + c_col + 8 * (i_ & 15)); } \
            if (wave < 4) { px[X] = *(const u32x4*)(XCp + (t0_ + (tid >> 2)) * D + xs_col + 8 * (tid & 3)); pz[X] = *(const u32x4*)(PJ + pj(t0_ + (tid >> 2), z_col + 8 * (tid & 3))); } \
            if (wave == 7) pdt[X] = DTp[(t0_ + lane) * 8 + h]; } while (0)
#define SSD_AUX(slot, X) do { if (wave == 7) { float a_ = pdt[X] * Ah; DPP_SHR_ADD(a_, 1); DPP_SHR_ADD(a_, 2); DPP_SHR_ADD(a_, 4); DPP_SHR_ADD(a_, 8); \
                const float r0_ = __int_as_float(__builtin_amdgcn_readlane(__float_as_int(a_), 15)), r1_ = __int_as_float(__builtin_amdgcn_readlane(__float_as_int(a_), 31)), r2_ = __int_as_float(__builtin_amdgcn_readlane(__float_as_int(a_), 47)); \
                a_ += (fq == 1) ? r0_ : (fq == 2) ? (r0_ + r1_) : (fq == 3) ? ((r0_ + r1_) + r2_) : 0.f; \
                ((LAS float*)(lds + SD_ACS))[(slot) * 64 + lane] = a_; ((LAS float*)(lds + SD_DTS))[(slot) * 64 + lane] = pdt[X]; } } while (0)
#define SSD_TILES(ts, X, slot) do { LAS unsigned char* tb_ = lds + (ts) * SD_SET; \
            _Pragma("unroll") for (int k = 0; k < 2; ++k) { const int i_ = tid + 512 * k; *(LAS u32x4*)(tb_ + SD_BM + ((i_ >> 4) * 136 + 8 * (i_ & 15)) * 2) = pb[X][k]; *(LAS u32x4*)(tb_ + SD_CM + ((i_ >> 4) * 136 + 8 * (i_ & 15)) * 2) = pc[X][k]; } \
            if (wave < 4) { const int l_ = tid >> 2, q_ = tid & 3; const LAS float* A_ = (const LAS float*)(lds + SD_ACS) + (slot) * 64; \
                *(LAS u32x4*)(tb_ + SD_XS + (l_ * 40 + 8 * q_) * 2) = px[X]; *(LAS u32x4*)(tb_ + SD_ZR + (l_ * 40 + 8 * q_) * 2) = pz[X]; \
                float f_[8], fd_[8]; unpack8(px[X], f_); const float dt_ = ((const LAS float*)(lds + SD_DTS))[(slot) * 64 + l_], dd_ = dt_ * __expf(A_[63] - A_[l_]); \
                _Pragma("unroll") for (int e = 0; e < 8; ++e) { fd_[e] = f_[e] * dd_; f_[e] *= dt_; } \
                *(LAS u32x4*)(tb_ + SD_DX + (l_ * 40 + 8 * q_) * 2) = pack8(f_); *(LAS u32x4*)(tb_ + SD_DXD + (l_ * 40 + 8 * q_) * 2) = pack8(fd_); } } while (0)
#define SSD_W(ts, slot) do { const LAS unsigned char* tb_ = lds + (ts) * SD_SET; const LAS float* A_ = (const LAS float*)(lds + SD_ACS) + (slot) * 64; \
            _Pragma("unroll") for (int jt = 0; jt < 2; ++jt) { const int id_ = 2 * wave + jt, lt_ = id_ >> 2, st_ = id_ & 3; f32x4 acc_ = (f32x4){0.f, 0.f, 0.f, 0.f}; \
                if (st_ <= lt_) { _Pragma("unroll") for (int kk = 0; kk < 4; ++kk) { const bf16x8 a_ = *(const LAS bf16x8*)(tb_ + SD_BM + ((st_ * 16 + fr) * 136 + kk * 32 + fq * 8) * 2); const bf16x8 b_ = *(const LAS bf16x8*)(tb_ + SD_CM + ((lt_ * 16 + fr) * 136 + kk * 32 + fq * 8) * 2); \
                        acc_ = __builtin_amdgcn_mfma_f32_16x16x32_bf16(a_, b_, acc_, 0, 0, 0); } } \
                const int l_ = lt_ * 16 + fr, s0_ = st_ * 16 + 4 * fq; const float al_ = A_[l_]; float w_[4]; const f32x4 as_ = *(const LAS f32x4*)(A_ + s0_);     \
                _Pragma("unroll") for (int r = 0; r < 4; ++r) { const int s_ = s0_ + r; const float e_ = acc_[r] * __expf(fminf(al_ - as_[r], 0.f)); w_[r] = (s_ <= l_) ? e_ : 0.f; } \
                u32x2 o_; o_.x = cvt_pk_bf16(w_[0], w_[1]); o_.y = cvt_pk_bf16(w_[2], w_[3]); *(LAS u32x2*)(lds + SD_WM + (ts) * 9216 + (l_ * 72 + s0_) * 2) = o_; } } while (0)
        SSD_LOAD(0, 0); SSD_LOAD(1, 1);
        SSD_AUX(0, 0); SSD_AUX(1, 1);
        WG_BAR();
        SSD_TILES(0, 0, 0);
        SSD_LOAD(2, 0);
        WG_BAR();
        SSD_W(0, 0);
        WG_BAR();
        int a0 = 0, a1 = 1, a2 = 2;
        u32x2 ypk = (u32x2){0u, 0u}; float yq = 0.f;
        for (int c2 = 0; c2 < 64; c2 += 2) {
#pragma unroll
        for (int par = 0; par < 2; ++par) {
            const int c = c2 + par; const size_t t0 = trow0 + (size_t)c * 64;
            const LAS unsigned char* tb = lds + par * SD_SET; const LAS float* ACS = (const LAS float*)(lds + SD_ACS) + a0 * 64;
            if (c + 1 < 64) SSD_TILES(par ^ 1, par ^ 1, a1);
            if (c + 2 < 64) SSD_AUX(a2, par);
            if (c > 0) { const int lt_ = wave >> 1, pt_ = wave & 1, l_ = lt_ * 16 + fr, p0_ = pt_ * 16 + 4 * fq; const size_t tp_ = t0 - 64;
                if (fq == 0) SQp[(size_t)((h * 2 + ph) * 2 + pt_) * T + tp_ + l_] = yq;
                *(u32x2*)(HBp + (tp_ + l_) * D + xs_col + p0_) = ypk; }
            if (c + 3 < 64) SSD_LOAD(c + 3, par ^ 1);
            const int lt = wave >> 1, pt = wave & 1, l = lt * 16 + fr, p0 = pt * 16 + 4 * fq;
            f32x4 yd = (f32x4){0.f, 0.f, 0.f, 0.f}, yo = (f32x4){0.f, 0.f, 0.f, 0.f};
#pragma unroll
            for (int kk = 0; kk < 2; ++kk) { const bf16x8 a = lds_tr8(tb + SD_DX + ((kk * 32 + 8 * fq + tq) * 40 + pt * 16 + 4 * tp) * 2, 4 * 80);
                const bf16x8 bb = *(const LAS bf16x8*)(lds + SD_WM + par * 9216 + ((lt * 16 + fr) * 72 + kk * 32 + fq * 8) * 2);
                yd = __builtin_amdgcn_mfma_f32_16x16x32_bf16(a, bb, yd, 0, 0, 0); }
#pragma unroll
            for (int kk = 0; kk < 4; ++kk) { const bf16x8 a = *(const LAS bf16x8*)(lds + SD_SB + ((pt * 16 + fr) * 136 + kk * 32 + fq * 8) * 2); const bf16x8 bb = *(const LAS bf16x8*)(tb + SD_CM + ((lt * 16 + fr) * 136 + kk * 32 + fq * 8) * 2);
                yo = __builtin_amdgcn_mfma_f32_16x16x32_bf16(a, bb, yo, 0, 0, 0); }
            const u32x2 xw = *(const LAS u32x2*)(tb + SD_XS + (l * 40 + p0) * 2), zw = *(const LAS u32x2*)(tb + SD_ZR + (l * 40 + p0) * 2);
            const float el = __expf(ACS[l]), cd = __expf(ACS[63]);
#pragma unroll
            for (int jt = 0; jt < 2; ++jt) { const int id = 2 * wave + jt, nt = id >> 1, pt2 = id & 1;
                Sacc[jt] = Sacc[jt] * cd;
#pragma unroll
                for (int kk = 0; kk < 2; ++kk) { const bf16x8 a = lds_tr8(tb + SD_BM + ((kk * 32 + 8 * fq + tq) * 136 + nt * 16 + 4 * tp) * 2, 4 * 272);
                    const bf16x8 bb = lds_tr8(tb + SD_DXD + ((kk * 32 + 8 * fq + tq) * 40 + pt2 * 16 + 4 * tp) * 2, 4 * 80);
                    Sacc[jt] = __builtin_amdgcn_mfma_f32_16x16x32_bf16(a, bb, Sacc[jt], 0, 0, 0); } }
            WG_BAR();
            {
                const float xs[4] = {bflo(xw.x), bfhi(xw.x), bflo(xw.y), bfhi(xw.y)}, zz[4] = {bflo(zw.x), bfhi(zw.x), bflo(zw.y), bfhi(zw.y)};
                float y[4], q2 = 0.f;
#pragma unroll
                for (int r = 0; r < 4; ++r) { y[r] = (yd[r] + el * yo[r] + Dh * xs[r]) * silu_f(zz[r]); q2 += y[r] * y[r]; }
                q2 += __shfl_xor(q2, 16); q2 += __shfl_xor(q2, 32);
                yq = q2; ypk.x = cvt_pk_bf16(y[0], y[1]); ypk.y = cvt_pk_bf16(y[2], y[3]);
            }
#pragma unroll
            for (int jt = 0; jt < 2; ++jt) { const int id = 2 * wave + jt, nt = id >> 1, pt2 = id & 1;
                u32x2 o; o.x = cvt_pk_bf16(Sacc[jt][0], Sacc[jt][1]); o.y = cvt_pk_bf16(Sacc[jt][2], Sacc[jt][3]);
                *(LAS u32x2*)(lds + SD_SB + ((pt2 * 16 + fr) * 136 + nt * 16 + 4 * fq) * 2) = o; }
            if (c + 1 < 64) SSD_W(par ^ 1, a1);
            WG_BAR();
            { const int t_ = a0; a0 = a1; a1 = a2; a2 = t_; }
        }
        }
#undef SSD_LOAD
#undef SSD_AUX
#undef SSD_TILES
#undef SSD_W
        { const int lt_ = wave >> 1, pt_ = wave & 1, l_ = lt_ * 16 + fr, p0_ = pt_ * 16 + 4 * fq; const size_t tp_ = trow0 + (size_t)63 * 64;
            if (fq == 0) SQp[(size_t)((h * 2 + ph) * 2 + pt_) * T + tp_ + l_] = yq;
            *(u32x2*)(HBp + (tp_ + l_) * D + xs_col + p0_) = ypk; }
        WG_BAR();
    }
}

__device__ __forceinline__ void p1_router_weights(const Frame& F_, CArgs& args_) {
    Frame F = F_; F.lane = lane_id_asm(); F.tid = F.wave * 64 + F.lane;
    ARGS_LAUNDER(args_);
    LAS float* red = (LAS float*)F.lds;
    for (int w = F.vcu; w < 256; w += F.G) {
        const int b = w >> 4, e0 = 4 * (w & 15); float bs[4] = {0.f, 0.f, 0.f, 0.f};
        const float* mod = (const float*)(args.ws + WS_MOD) + b * 6144;
#pragma unroll
        for (int kk = 0; kk < 2; ++kk) { const int k = F.tid + 512 * kk; const f32x4 wv = *(const f32x4*)((args.in[15]) + (size_t)k * 64 + e0);
            const float sc = (args.in[14])[k] * (1.0f + mod[4096 + k]), sh = mod[3072 + k];
#pragma unroll
            for (int j = 0; j < 4; ++j) { ((bf16*)(args.ws + WS_WR))[((size_t)b * 64 + e0 + j) * 1024 + k] = f2bf(wv[j] * sc); bs[j] += sh * wv[j]; } }
#pragma unroll
        for (int j = 0; j < 4; ++j) bs[j] = wave_sum(bs[j]);
        if (F.lane == 0) { red[F.wave * 4 + 0] = bs[0]; red[F.wave * 4 + 1] = bs[1]; red[F.wave * 4 + 2] = bs[2]; red[F.wave * 4 + 3] = bs[3]; }
        WG_BAR();
        if (F.tid < 4) { float s = 0.f;
#pragma unroll
            for (int q = 0; q < 8; ++q) s += red[q * 4 + F.tid];
            ((float*)(args.ws + WS_RB))[b * 64 + e0 + F.tid] = s; }
        WG_BAR();
    }
}
constexpr int RT_WST = 1032;
constexpr int RT_LOG = 0, RT_CNT = 65536, RT_BASE = 65536 + 256, RT_LE = 66560, RT_LW = 66560 + 8192;
constexpr int RT_RS = RT_LW + 8192;
static_assert(64 * RT_WST * 2 <= MISC_OFF && RT_RS + 1024 <= MISC_OFF, "router LDS map");
__device__ __forceinline__ void p7_router(const Frame& F_, CArgs& args_) {
    Frame F = F_; F.lane = lane_id_asm(); F.tid = F.wave * 64 + F.lane;
    ARGS_LAUNDER(args_);
    LAS unsigned char* lds = F.lds; const int tid = F.tid, lane = F.lane, wave = F.wave, fr = lane & 15, fq = lane >> 4;
    LAS int* lcnt = (LAS int*)(lds + RT_CNT); LAS int* lbase = (LAS int*)(lds + RT_BASE);
    LAS unsigned* le = (LAS unsigned*)(lds + RT_LE); LAS float* lw = (LAS float*)(lds + RT_LW);
    const float bias = (args.in[16])[lane];
    for (int tile = F.vcu; tile < T / 256; tile += F.G) {
        const int s = (tile * 256) / TS, b = (tile * 256) / SEQ;
        { const u32x4* wsrc = (const u32x4*)((const bf16*)(args.ws + WS_WR) + (size_t)b * 64 * 1024);
          u32x4 wt[16];
#pragma unroll
          for (int j = 0; j < 16; ++j) wt[j] = wsrc[tid + 512 * j];
#pragma unroll
          for (int j = 0; j < 16; ++j) { const int i = tid + 512 * j, e = i >> 7, c = i & 127; *(LAS u32x4*)(lds + (e * RT_WST + 8 * c) * 2) = wt[j]; } }
        WG_BAR();
        const bf16* xb = (const bf16*)(args.ws + WS_X1) + (size_t)(tile * 256 + wave * 32) * D;
        f32x4 acc[2][4]; float ssq[2] = {0.f, 0.f};
#pragma unroll
        for (int g = 0; g < 2; ++g)
#pragma unroll
            for (int n = 0; n < 4; ++n) acc[g][n] = (f32x4){0.f, 0.f, 0.f, 0.f};
        constexpr int XG = 2;
        u32x4 xs0[XG][2], xs1[XG][2], xs2[XG][2], xs3[XG][2];
#define RT_XLOAD(dst, k0_) do { _Pragma("unroll") for (int q = 0; q < XG; ++q) _Pragma("unroll") for (int g = 0; g < 2; ++g) dst[q][g] = *(const u32x4*)(xb + (size_t)(16 * g + fr) * D + 32 * ((k0_) + q) + 8 * fq); } while (0)
#define RT_XMMA(srcx, k0_) do { _Pragma("unroll") for (int q = 0; q < XG; ++q) { const int ks = (k0_) + q; bf16x8 bfr[2]; \
            _Pragma("unroll") for (int g = 0; g < 2; ++g) { const u32x4 xv = srcx[q][g]; bfr[g] = __builtin_bit_cast(bf16x8, xv); float f[8]; unpack8(xv, f); _Pragma("unroll") for (int j = 0; j < 8; ++j) ssq[g] += f[j] * f[j]; } \
            _Pragma("unroll") for (int n = 0; n < 4; ++n) { const bf16x8 afr = *(const LAS bf16x8*)(lds + ((16 * n + fr) * RT_WST + 32 * ks + 8 * fq) * 2); \
                _Pragma("unroll") for (int g = 0; g < 2; ++g) acc[g][n] = __builtin_amdgcn_mfma_f32_16x16x32_bf16(afr, bfr[g], acc[g][n], 0, 0, 0); } } } while (0)
        RT_XLOAD(xs0, 0); RT_XLOAD(xs1, XG); RT_XLOAD(xs2, 2 * XG); RT_XLOAD(xs3, 3 * XG);
#pragma unroll 1
        for (int k0 = 0; k0 < 32; k0 += 4 * XG) {
            const int kn = k0 + 4 * XG < 32 ? k0 + 4 * XG : k0;
            RT_XMMA(xs0, k0);          RT_XLOAD(xs0, kn);
            RT_XMMA(xs1, k0 + XG);     RT_XLOAD(xs1, kn + XG);
            RT_XMMA(xs2, k0 + 2 * XG); RT_XLOAD(xs2, kn + 2 * XG);
            RT_XMMA(xs3, k0 + 3 * XG); RT_XLOAD(xs3, kn + 3 * XG);
        }
#undef RT_XLOAD
#undef RT_XMMA
        WG_BAR();
        if (tid < 64) lcnt[tid] = 0;
#pragma unroll
        for (int g = 0; g < 2; ++g) { float q = ssq[g]; q += __shfl_xor(q, 16); q += __shfl_xor(q, 32); const float rstd = rsqrtf(q * (1.0f / D) + EPS);
            if (fq == 0) *(LAS float*)(lds + RT_RS + (wave * 32 + 16 * g + fr) * 4) = rstd;
#pragma unroll
            for (int n = 0; n < 4; ++n) { const f32x4 rb = *(const f32x4*)((const float*)(args.ws + WS_RB) + b * 64 + 16 * n + 4 * fq);
                *(LAS f32x4*)(lds + RT_LOG + ((wave * 32 + 16 * g + fr) * 64 + 16 * n + 4 * fq) * 4) = acc[g][n] * rstd + rb; } }
        WG_BAR();
        f32x4 hsc[4], hsh[4];
#pragma unroll
        for (int j = 0; j < 4; ++j) { const int col = 16 * lane + 4 * j; const float* mod = (const float*)(args.ws + WS_MOD) + b * 6144;
            hsc[j] = *(const f32x4*)((args.in[14]) + col) * (*(const f32x4*)(mod + 4096 + col) + 1.0f); hsh[j] = *(const f32x4*)(mod + 3072 + col); }
        const bf16* xrow = (const bf16*)(args.ws + WS_X1) + (size_t)(tile * 256 + wave * 32) * D + 16 * lane;
        unsigned char* hrow = (unsigned char*)(args.ws + WS_H8) + (size_t)(tile * 256 + wave * 32) * D + 16 * lane;
        u32x4 xn0 = *(const u32x4*)(xrow), xn1 = *(const u32x4*)(xrow + 8);
#pragma unroll 2
        for (int i = 0; i < 32; ++i) {
            const int tl = wave * 32 + i;
            const u32x4 xc0 = xn0, xc1 = xn1;
            if (i + 1 < 32) { xn0 = *(const u32x4*)(xrow + (size_t)(i + 1) * D); xn1 = *(const u32x4*)(xrow + (size_t)(i + 1) * D + 8); }
            { const float rs = *(const LAS float*)(lds + RT_RS + tl * 4); float f[16]; { float t8[8]; unpack8(xc0, t8);
#pragma unroll
                for (int j = 0; j < 8; ++j) f[j] = t8[j]; unpack8(xc1, t8);
#pragma unroll
                for (int j = 0; j < 8; ++j) f[8 + j] = t8[j]; }
                u32x4 hw; unsigned hv[4];
#pragma unroll
                for (int j = 0; j < 4; ++j) { const f32x4 h = (f32x4){f[4 * j], f[4 * j + 1], f[4 * j + 2], f[4 * j + 3]} * rs * hsc[j] + hsh[j];
                    int q8 = __builtin_amdgcn_cvt_pk_fp8_f32(h.x, h.y, 0, false); q8 = __builtin_amdgcn_cvt_pk_fp8_f32(h.z, h.w, q8, true); hv[j] = (unsigned)q8; }
                hw.x = hv[0]; hw.y = hv[1]; hw.z = hv[2]; hw.w = hv[3];
                *(u32x4*)(hrow + (size_t)i * D) = hw; }
            const float logit = *(const LAS float*)(lds + RT_LOG + (tl * 64 + lane) * 4);
            const float score = __builtin_amdgcn_rcpf(1.0f + __expf(-logit)), sel = score + bias;
            const float m1 = max8(sel);
            const unsigned long long eq = __ballot(sel == m1);
            const unsigned gm = (unsigned)(eq >> (lane & 56)) & 0xffu;
            const int first = gm ? __builtin_ctz(gm) : 0;
            const float m2 = max8(((lane & 7) == first) ? -INFINITY : sel);
            const float gs = m1 + m2; const int g = lane >> 3; int grank = 0;
            const unsigned ghi = f32_key(gs); const unsigned long long gme = ((unsigned long long)ghi << 32) | (unsigned)(7 - g);
#pragma unroll
            for (int j = 0; j < 8; ++j) { const unsigned long long go = ((unsigned long long)(unsigned)__builtin_amdgcn_readlane((int)ghi, 8 * j) << 32) | (unsigned)(7 - j); grank += (go > gme) ? 1 : 0; }
            const bool gsel = grank < 4; const unsigned long long gmask = __ballot(gsel);
            int rank = 0;
            const unsigned khi = f32_key(sel); const unsigned long long kme = ((unsigned long long)khi << 32) | (unsigned)(63 - lane);
#pragma unroll
            for (int j = 0; j < 8; ++j) if ((gmask >> (8 * j)) & 1ull) {
#pragma unroll
                for (int i = 0; i < 8; ++i) { const unsigned long long ko = ((unsigned long long)(unsigned)__builtin_amdgcn_readlane((int)khi, 8 * j + i) << 32) | (unsigned)(63 - (8 * j + i)); rank += (ko > kme) ? 1 : 0; } }
            const bool chosen = gsel && rank < TOPK;
            const float wsum = wave_sum(chosen ? score : 0.f);
            if (chosen) { const int pos = __hip_atomic_fetch_add(lcnt + lane, 1, __ATOMIC_RELAXED, __HIP_MEMORY_SCOPE_WORKGROUP);
                le[tl * 8 + rank] = (unsigned)lane | ((unsigned)pos << 8); lw[tl * 8 + rank] = score / wsum * 2.5f; }
        }
        WG_BAR();
        if (tid < 64) lbase[tid] = (int)__hip_atomic_fetch_add(((unsigned*)(args.ws + WS_CTL) + CW_CNT) + s * 80 + tid, (unsigned)lcnt[tid], RLX_AGENT);
        WG_BAR();
        for (int idx = tid; idx < 2048; idx += 512) { const unsigned v = le[idx]; const int e = v & 0xffu; const size_t o = (size_t)tile * 2048 + idx;
            const int pos = (int)(v >> 8) + lbase[e]; ((int*)(args.ws + WS_IDX))[o] = e; ((int*)(args.ws + WS_APOS))[o] = pos; ((float*)(args.ws + WS_WGT))[o] = lw[idx];
            ((int*)(args.ws + WS_LIST))[(size_t)e * T + pos] = tile * 256 + (idx >> 3); }
        WG_BAR();
    }
}
__device__ __forceinline__ void load_eoff(const Frame& F_, CArgs& args_) {
    Frame F = F_; F.lane = lane_id_asm(); F.tid = F.wave * 64 + F.lane;
    ARGS_LAUNDER(args_);
    LAS int* eoff = (LAS int*)(F.lds + EO_OFF); LAS int* ecnt = (LAS int*)(F.lds + EC_OFF);
    if (F.tid < S_SB) { const int s = F.tid; int acc = 0;
        for (int e = 0; e < NEX; ++e) { const int cnt = e < NE ? (int)((unsigned*)(args.ws + WS_CTL) + CW_CNT)[s * 80 + e] : TS; eoff[s * 72 + e] = acc; ecnt[s * 72 + e] = cnt; acc += (cnt + 255) & ~255; }
        eoff[s * 72 + NEX] = acc; }
    WG_BAR();
}
__device__ __forceinline__ int moe_tables(const Frame& F_, CArgs& args_, int s, bool gather) {
    Frame F = F_; F.lane = lane_id_asm(); F.tid = F.wave * 64 + F.lane;
    ARGS_LAUNDER(args_);
    asm volatile("" : "+s"(s));
    const LAS int* eoff = (const LAS int*)(F.lds + EO_OFF) + s * 72;
    LAS unsigned char* te = F.lds + TE_OFF;
    const int NT = eoff[NEX] >> 8;
    for (int e = F.wave; e < NEX; e += 8) { const int t0 = eoff[e] >> 8, t1 = eoff[e + 1] >> 8; for (int t = t0 + F.lane; t < t1; t += 64) te[t] = (unsigned char)e; }
    WG_BAR();
    if (gather) { LAS unsigned* tab = (LAS unsigned*)(F.lds + TAB_OFF);
        int nsl = (2 * NT - F.vcu + F.G - 1) / F.G; nsl = nsl < 0 ? 0 : (nsl > TAB_SLOTS ? TAB_SLOTS : nsl);
        const int nent = nsl * 256; const int* LISTp = (const int*)(args.ws + WS_LIST);
#pragma unroll 1
        for (int base = 0; base < nent; base += 2048) {
            int tokv[4], dflt[4]; bool fromlist[4];
#pragma unroll
            for (int j = 0; j < 4; ++j) { int idx = base + j * 512 + F.tid; idx = idx < nent ? idx : nent - 1; const int i = idx >> 8, r = idx & 255, rt = (i * F.G + F.vcu) >> 1;
                const int e = te[rt], pos = rt * 256 - eoff[e] + r;
                fromlist[j] = e < NE && pos < ((const LAS int*)(F.lds + EC_OFF))[s * 72 + e]; dflt[j] = e < NE ? 0 : s * TS + pos;
                tokv[j] = LISTp[fromlist[j] ? (size_t)e * T + pos : (size_t)0]; }
#pragma unroll
            for (int j = 0; j < 4; ++j) { const int idx = base + j * 512 + F.tid; if (idx < nent) tab[idx] = (unsigned)(fromlist[j] ? tokv[j] : dflt[j]) * 1024u; }
        } }
    WG_BAR();
    return NT;
}
__device__ __forceinline__ void pc_combine(const Frame& F_, CArgs& args_, int s) {
    Frame F = F_; F.lane = lane_id_asm(); F.tid = F.wave * 64 + F.lane;
    ARGS_LAUNDER(args_);
    asm volatile("" : "+s"(s));
    const LAS int* eoff = (const LAS int*)(F.lds + EO_OFF) + s * 72;
    const int shoff = eoff[NE];
    const int gw = F.vcu * 8 + F.wave, NGW = F.G * 8, lane = F.lane;
    constexpr int PER = 16;
    const unsigned char* Y8 = (const unsigned char*)(args.ws + WS_A); const bf16* x1b = (const bf16*)(args.ws + WS_X1);
    for (int blk = gw; blk < TS / PER; blk += NGW) {
        const int tl0 = blk * PER, b = (s * TS + tl0) / SEQ;
        f32x4 g2[4], nf[4];
#pragma unroll
        for (int i = 0; i < 4; ++i) { const int col = 256 * i + 4 * lane; g2[i] = *(const f32x4*)(((float*)(args.ws + WS_MOD)) + b * 6144 + 5120 + col); nf[i] = *(const f32x4*)((args.in[23]) + col); }
#pragma unroll 2
        for (int r = 0; r < PER; ++r) {
            const int tl = tl0 + r, t = s * TS + tl;
            f32x4 acc[4];
#pragma unroll
            for (int i = 0; i < 4; ++i) acc[i] = (f32x4){0.f, 0.f, 0.f, 0.f};
#pragma unroll
            for (int k = 0; k < 9; ++k) {
                const int row = k < 8 ? eoff[((int*)(args.ws + WS_IDX))[(size_t)t * 8 + k]] + ((int*)(args.ws + WS_APOS))[(size_t)t * 8 + k] : shoff + tl; const float w = (k < 8 ? ((float*)(args.ws + WS_WGT))[(size_t)t * 8 + k] : 1.0f) * (1.0f / 16.0f);
                unsigned yw[4];
#pragma unroll
                for (int i = 0; i < 4; ++i) yw[i] = *(const unsigned*)(Y8 + ((size_t)(row >> 8) * 4 + i) * 65536 + (size_t)(row & 255) * 256 + 4 * lane);
#pragma unroll
                for (int i = 0; i < 4; ++i) { const f32x2 lo = __builtin_amdgcn_cvt_pk_f32_fp8((int)yw[i], false), hi = __builtin_amdgcn_cvt_pk_f32_fp8((int)yw[i], true);
                    acc[i] = acc[i] + (f32x4){lo.x, lo.y, hi.x, hi.y} * w; }
            }
            float* orow = (args.out) + (size_t)t * D + 4 * lane; float ss = 0.f; f32x4 xf[4];
#pragma unroll
            for (int i = 0; i < 4; ++i) { const u32x2 xw = *(const u32x2*)(x1b + (size_t)t * D + 256 * i + 4 * lane); const f32x4 x1 = (f32x4){bflo(xw.x), bfhi(xw.x), bflo(xw.y), bfhi(xw.y)}; const f32x4 v = x1 + g2[i] * acc[i]; xf[i] = v; ss += (v.x * v.x + v.y * v.y) + (v.z * v.z + v.w * v.w); }
            const float rstd = rsqrtf(wave_sum(ss) * (1.0f / D) + EPS);
#pragma unroll
            for (int i = 0; i < 4; ++i) *(f32x4*)(orow + 256 * i) = xf[i] * rstd * nf[i];
        }
    }
}

__device__ __forceinline__ void stagger(int quanta) { const int j = ((int)blockIdx.x >> 3) & 7; for (int i = 0; i < j * quanta; ++i) __builtin_amdgcn_s_sleep(16); }

constexpr int NPH = 10 + 3 * S_SB;
__global__ void __launch_bounds__(512, 2) fwd_kernel(Args args_k) {
    CArgs& kargs = *(CArgs*)__builtin_amdgcn_kernarg_segment_ptr();
    extern __shared__ __attribute__((aligned(16))) unsigned char lds_raw[];
    Frame F;
    F.lds = (LAS unsigned char*)lds_raw; F.MISC = (volatile LAS unsigned*)(F.lds + MISC_OFF);
    F.wave = __builtin_amdgcn_readfirstlane((int)threadIdx.x >> 6); F.lane = 0; F.tid = 0;
    F.G = gridDim.x; { const int bx = blockIdx.x; F.vcu = (F.G % 8 == 0) ? (bx % 8) * (F.G / 8) + bx / 8 : bx; }
    F.ctl = (unsigned*)(kargs.ws + WS_CTL);
    if (threadIdx.x < 64) ((LAS unsigned*)(F.lds + MISC_OFF))[threadIdx.x] = 0u;
    __syncthreads();
    XcdBarrier bar; bar.bar = F.ctl + CW_BAR; bar.x = 0; bar.st = nullptr;
    if (!MK_PER_PHASE) bar = xcd_barrier_post(F.ctl + CW_BAR, F.MISC);
    const int lo = MK_PER_PHASE ? kargs.ph_lo : 0, hi = MK_PER_PHASE ? kargs.ph_hi : NPH;
#ifndef PH_ENABLE
#define PH_ENABLE 0xffffffffu
#endif
#define IN(k) (((PH_ENABLE >> ((k) > 9 ? 10 + ((k) - 10) % 3 : (k))) & 1u) && lo <= (k) && (k) < hi)
#ifndef DUP_MASK
#define DUP_MASK 0u
#endif
#define REPEAT(k) _Pragma("unroll 1") for (int rep_ = 0; rep_ < 1 + (int)((DUP_MASK >> (k)) & 1u); ++rep_)
#define SEAM(k) do { if (!MK_PER_PHASE && IN(k) && IN((k) + 1)) xcd_barrier(bar, F.wave); } while (0)

    if (IN(0)) { REPEAT(0) { p0_prologue(F, kargs); } SEAM(0); }
    if (IN(1)) { ARGS_LAUNDER(kargs); p1_router_weights(F, kargs); REPEAT(1) { p_norm_mod<true, false>(F, kargs, (args.in[0]), (args.in[4]), 0, 1024, ((bf16*)(args.ws + WS_HB)), nullptr); } SEAM(1); }
    if (IN(2)) { ARGS_LAUNDER(kargs);
        pg8::PlainOrder S; S.init(((bf16*)(args.ws + WS_HB)), ((bf16*)(args.ws + WS_WIN)), T, NPROJ, D, F.G, (int)blockIdx.x); pg8::EpiBf16T E{((bf16*)(args.ws + WS_A)), NPROJ / 256};
        stagger(STG_P2); REPEAT(2) { pg8::gemm_phase<pg8::EpiBf16T, pg8::PlainOrder, true>(F.lds, F.wave, D, S, E); } SEAM(2); }
    if (IN(3)) { REPEAT(3) { p3_conv(F, kargs); } SEAM(3); }
    if (IN(4)) { REPEAT(4) { p4_ssd(F, kargs); } SEAM(4); }
    if (IN(5)) { ARGS_LAUNDER(kargs);
        pg8::PlainOrder S; S.init(((bf16*)(args.ws + WS_HB)), ((bf16*)(args.ws + WS_WOUT)), T, D, D, F.G, (int)blockIdx.x);
        {
            const int lane = lane_id_asm(), tid = F.wave * 64 + lane, r = tid & 255, hf = tid >> 8;
            LAS float* rstab = (LAS float*)(F.lds + TAB_OFF); LAS float* tmp = (LAS float*)(F.lds);
            pg8::Unit u;
            for (int i0 = 0; i0 < 16; i0 += 4) {
                float sv[4]; bool ok[4]; float pv[4][16];
#pragma unroll
                for (int j = 0; j < 4; ++j) { ok[j] = S.next(i0 + j, u); const int pm = ok[j] ? u.pm : 0;
                    const float* sp = ((const float*)(args.ws + WS_SSQ)) + (size_t)(16 * hf) * T + pm * 256 + r;
#pragma unroll
                    for (int q = 0; q < 16; ++q) pv[j][q] = sp[(size_t)q * T]; }
#pragma unroll
                for (int j = 0; j < 4; ++j) { float s = 0.f;
#pragma unroll
                    for (int q = 0; q < 16; ++q) s += pv[j][q];
                    sv[j] = s; if (hf) tmp[j * 256 + r] = s; }
                WG_BAR();
#pragma unroll
                for (int j = 0; j < 4; ++j) if (!hf && ok[j]) rstab[(i0 + j) * 256 + r] = rsqrtf((sv[j] + tmp[j * 256 + r]) * (1.0f / 512.0f) + EPS);
                WG_BAR();
                if (!ok[3]) break;
            }
        }
        pg8::EpiX1 E{(args.in[0]), (bf16*)(args.ws + WS_X1), ((float*)(args.ws + WS_MOD)) + 2048, (const LAS float*)(F.lds + TAB_OFF)};
        stagger(STG_P5); REPEAT(5) { pg8::gemm_phase<pg8::EpiX1, pg8::PlainOrder, false>(F.lds, F.wave, D, S, E); } SEAM(5); }
    if (IN(6)) { p7_router(F, kargs); SEAM(9); }
    load_eoff(F, kargs);
    for (int s = 0; s < S_SB; ++s) {
        const int k0 = 10 + 3 * s;
        if (IN(k0)) { ARGS_LAUNDER(kargs);
            const int NT = moe_tables(F, kargs, s, true);
            pg8::MoeOrder<1, true> S; S.NT = NT; S.G = F.G; S.c = F.vcu; S.A = (const char*)(args.ws + WS_H8); S.W = (const char*)(args.ws + WS_WGU); S.rowb = 0; S.w_exp = (size_t)512 * 1024; S.w_tile = (size_t)256 * 1024;
            S.te = F.lds + TE_OFF; S.tab = (const LAS unsigned*)(F.lds + TAB_OFF);
            pg8::EpiGU E{(unsigned char*)(args.ws + WS_HID)};
            stagger(STG_G); REPEAT(10) { pg8::gemm_phase<pg8::EpiGU, pg8::MoeOrder<1, true>, true, true>(F.lds, F.wave, D, S, E); } SEAM(k0); }
        if (IN(k0 + 1)) { ARGS_LAUNDER(kargs);
            const int NT = moe_tables(F, kargs, s, false);
            pg8::MoeOrder<2, false> S; S.NT = NT; S.G = F.G; S.c = F.vcu; S.A = (const char*)(args.ws + WS_HID); S.W = (const char*)(args.ws + WS_WD); S.rowb = 256u; S.w_exp = (size_t)1024 * 256; S.w_tile = (size_t)256 * 256;
            S.te = F.lds + TE_OFF; S.tab = (const LAS unsigned*)(F.lds + TAB_OFF);
            pg8::EpiFp8 E{(unsigned char*)(args.ws + WS_A), D, 1.0f};
            int Kd = 256; asm volatile("" : "+s"(Kd));
            stagger(STG_D); REPEAT(11) { pg8::gemm_phase<pg8::EpiFp8, pg8::MoeOrder<2, false>, true, true>(F.lds, F.wave, Kd, S, E); } SEAM(k0 + 1); }
        if (IN(k0 + 2)) { pc_combine(F, kargs, s); if (MK_PER_PHASE == 0 && s + 1 < S_SB) { asm volatile("s_waitcnt vmcnt(0)" ::: "memory"); __syncthreads(); } }
    }
#undef IN
#undef SEAM
}

extern "C" void kernel_launch(void* const* d_in, const int* in_sizes, int n_in, void* d_out, int out_size, void* d_ws, size_t ws_size, hipStream_t stream) {
    static int grid = 0;
    if (grid == 0) {
        if (n_in != 24 || in_sizes[0] != T * D || out_size != T * D || ws_size < WS_END) { fprintf(stderr, "kernel_launch: unexpected shapes / workspace (n_in %d, ws %zu, need %zu)\n", n_in, ws_size, (size_t)WS_END); grid = -1; return; }
        int dev = 0, cus = 0, per_cu = 0;
        if (hipGetDevice(&dev) != hipSuccess || hipDeviceGetAttribute(&cus, hipDeviceAttributeMultiprocessorCount, dev) != hipSuccess) { grid = -1; return; }
        if (hipFuncSetAttribute((const void*)fwd_kernel, hipFuncAttributeMaxDynamicSharedMemorySize, LDS_BYTES) != hipSuccess) { fprintf(stderr, "kernel_launch: hipFuncSetAttribute failed\n"); grid = -1; return; }
        if (hipOccupancyMaxActiveBlocksPerMultiprocessor(&per_cu, (const void*)fwd_kernel, 512, LDS_BYTES) != hipSuccess || per_cu < 1) fprintf(stderr, "kernel_launch: occupancy query says %d\n", per_cu);
        (void)hipGetLastError();
        grid = cus;
    }
    if (grid < 0) return;
    if (hipMemsetAsync((char*)d_ws + WS_CTL, 0, CTL_ZERO_BYTES, stream) != hipSuccess) return;
    Args a{};
    for (int i = 0; i < 24; ++i) a.in[i] = (const float*)d_in[i];
    a.out = (float*)d_out; a.ws = (unsigned char*)d_ws;
#if MK_PER_PHASE
    for (int p = 0; p < NPH; ++p) { a.ph_lo = p; a.ph_hi = p + 1; hipLaunchKernelGGL(fwd_kernel, dim3(grid), dim3(512), LDS_BYTES, stream, a); }
#else
    a.ph_lo = 0; a.ph_hi = NPH;
    hipLaunchKernelGGL(fwd_kernel, dim3(grid), dim3(512), LDS_BYTES, stream, a);
#endif
}
```

```cpp
#include <hip/hip_runtime.h>
#include <cstdio>
#include <cstdint>

#define LAS __attribute__((address_space(3)))
#define GAS __attribute__((address_space(1)))
typedef unsigned short bf16;
typedef short bf16x8 __attribute__((ext_vector_type(8)));
typedef float f32x4 __attribute__((ext_vector_type(4)));
typedef float f32x2 __attribute__((ext_vector_type(2)));
typedef unsigned u32x4 __attribute__((ext_vector_type(4)));
typedef unsigned u32x2 __attribute__((ext_vector_type(2)));

#define STG_P2 0
#define STG_P5 0
#define STG_G 0
#define STG_D 0
#ifndef MK_PER_PHASE
#define MK_PER_PHASE 0
#endif

constexpr int T = 65536, D = 1024, SEQ = 4096, NB = 16;
constexpr int NPROJ = 3072, LDWIN = 3080;
constexpr int C_CB = 0, C_CC = 512, C_CU = 1024, C_Z = 1536, C_XBC = 2048;
constexpr int NE = 64, NEX = 65, TOPK = 8;
constexpr int S_SB = 1, TS = T / S_SB;
constexpr int MAXT = (TS * 9) / 256 + 64;
constexpr int MAXROWS = MAXT * 256;
constexpr float EPS = 1e-6f;

constexpr size_t MiB = 1u << 20;
constexpr size_t WS_CTL = 0, CTL_ZERO_BYTES = 1 * MiB;
constexpr size_t WS_MOD = 128 * 1024;
constexpr size_t WS_WDT = 1 * MiB;
constexpr size_t WS_WIN = 2 * MiB, WS_WOUT = 8 * MiB, WS_WR = 10 * MiB;
constexpr size_t WS_RB = 1 * MiB + 64 * 1024;
constexpr size_t WS_WGU = 12 * MiB;
constexpr size_t WS_WD = 45 * MiB;
constexpr size_t WS_DT = 62 * MiB;
constexpr size_t WS_IDX = 64 * MiB, WS_WGT = 66 * MiB, WS_APOS = 68 * MiB, WS_ROWOF = 70 * MiB;
constexpr size_t WS_R2T = 72 * MiB;
constexpr size_t WS_HB = 76 * MiB;
constexpr size_t WS_HID = 76 * MiB;
constexpr size_t WS_A = 232 * MiB;
constexpr size_t WS_XC = 616 * MiB;
constexpr size_t WS_SSQ = 744 * MiB;
constexpr size_t WS_LOG = 752 * MiB;
constexpr size_t WS_H8 = 768 * MiB;
constexpr size_t WS_X1 = 832 * MiB;
constexpr size_t WS_LIST = 960 * MiB;
constexpr size_t WS_END = 976 * MiB;
static_assert(WS_WGU + (size_t)NEX * 512 * 1024 <= WS_WD && WS_WD + (size_t)NEX * 1024 * 256 <= WS_DT && WS_R2T + (size_t)S_SB * MAXROWS * 4 <= WS_HB && WS_HID + (size_t)MAXROWS * 256 <= WS_A && WS_HB + (size_t)T * D * 2 <= WS_A
              && WS_A + (size_t)T * NPROJ * 2 <= WS_XC && WS_A + (size_t)MAXROWS * 1024 <= WS_X1 && WS_XC + (size_t)T * D * 2 <= WS_SSQ && WS_SSQ + (size_t)32 * T * 4 <= WS_LOG && WS_LOG + (size_t)T * 64 * 4 <= WS_H8
              && WS_H8 + (size_t)T * D <= WS_X1 && WS_X1 + (size_t)T * D * 2 <= WS_LIST && WS_LIST + (size_t)NE * T * 4 <= WS_END, "ws map");
constexpr int CW_BAR = 4096;
constexpr int CW_CNT = 8192;

constexpr int RING_BYTES = 131072;
constexpr int TAB_SLOTS = 20;
constexpr int TAB_OFF = RING_BYTES, TAB_BYTES = TAB_SLOTS * 1024;
constexpr int TE_OFF = TAB_OFF + TAB_BYTES;
constexpr int EO_OFF = TE_OFF + ((MAXT + 63) / 64) * 64;
constexpr int EC_OFF = EO_OFF + S_SB * 72 * 4;
constexpr int MISC_OFF = EC_OFF + S_SB * 72 * 4;
constexpr int LDS_BYTES = ((MISC_OFF + 256 + 1023) / 1024) * 1024;
static_assert(LDS_BYTES <= 160 * 1024 && (2 * MAXT + 255) / 256 <= TAB_SLOTS, "LDS");

#define RLX_AGENT __ATOMIC_RELAXED, __HIP_MEMORY_SCOPE_AGENT
#define LDS_WAIT() asm volatile("s_waitcnt lgkmcnt(0)" ::: "memory")
#define WG_BAR() do { asm volatile("s_waitcnt lgkmcnt(0)" ::: "memory"); __builtin_amdgcn_s_barrier(); asm volatile("" ::: "memory"); } while (0)
__device__ __forceinline__ unsigned cvt_pk_bf16(float lo, float hi) { unsigned r; asm volatile("v_cvt_pk_bf16_f32 %0, %1, %2" : "=v"(r) : "v"(lo), "v"(hi)); return r; }
__device__ __forceinline__ float bflo(unsigned w) { return __uint_as_float(w << 16); }
__device__ __forceinline__ float bfhi(unsigned w) { return __uint_as_float(w & 0xffff0000u); }
__device__ __forceinline__ float bf2f(unsigned short h) { return __uint_as_float(((unsigned)h) << 16); }
__device__ __forceinline__ unsigned short f2bf(float f) { return (unsigned short)(cvt_pk_bf16(f, 0.f) & 0xffffu); }
__device__ __forceinline__ float silu_f(float x) { return x * __builtin_amdgcn_rcpf(1.0f + __expf(-x)); }
#define DPP_F(v, ctrl) __int_as_float(__builtin_amdgcn_update_dpp(0, __float_as_int(v), (ctrl), 0xf, 0xf, false))
__device__ __forceinline__ float wave_sum(float v) {
    v += DPP_F(v, 0xB1); v += DPP_F(v, 0x4E); v += DPP_F(v, 0x141); v += DPP_F(v, 0x140);
    const float r0 = __int_as_float(__builtin_amdgcn_readlane(__float_as_int(v), 0)), r1 = __int_as_float(__builtin_amdgcn_readlane(__float_as_int(v), 16)),
                r2 = __int_as_float(__builtin_amdgcn_readlane(__float_as_int(v), 32)), r3 = __int_as_float(__builtin_amdgcn_readlane(__float_as_int(v), 48));
    return (r0 + r1) + (r2 + r3);
}
__device__ __forceinline__ float max8(float v) {
    v = fmaxf(v, DPP_F(v, 0xB1)); v = fmaxf(v, DPP_F(v, 0x4E)); v = fmaxf(v, DPP_F(v, 0x141)); return v;
}
__device__ __forceinline__ unsigned f32_key(float f) { const unsigned b = __float_as_uint(f); return b ^ ((b >> 31) ? 0xffffffffu : 0x80000000u); }
__device__ __forceinline__ void unpack8(const u32x4 w, float (&f)[8]) {
    f[0] = bflo(w.x); f[1] = bfhi(w.x); f[2] = bflo(w.y); f[3] = bfhi(w.y); f[4] = bflo(w.z); f[5] = bfhi(w.z); f[6] = bflo(w.w); f[7] = bfhi(w.w);
}
__device__ __forceinline__ u32x4 pack8(const float (&f)[8]) {
    u32x4 w; w.x = cvt_pk_bf16(f[0], f[1]); w.y = cvt_pk_bf16(f[2], f[3]); w.z = cvt_pk_bf16(f[4], f[5]); w.w = cvt_pk_bf16(f[6], f[7]); return w;
}

__device__ __forceinline__ int lane_id_asm() { int l; asm volatile("v_mbcnt_lo_u32_b32 %0, -1, 0\n\tv_mbcnt_hi_u32_b32 %0, -1, %0" : "=v"(l)); return l; }

__device__ __forceinline__ size_t pj(size_t row, int col) { return ((row >> 8) * (NPROJ / 256) + (size_t)(col >> 8)) * 65536 + (row & 255) * 256 + (size_t)(col & 255); }

#define XB_TMO      128
#define XB_XCNT(j)  (256  + 64 * (j))
#define XB_XSUB(j)  (1280 + 64 * (j))
#define XB_XGEN(j)  (2304 + 64 * (j))
#define XB_TOP      3328
#define XB_TOPGEN   3392
#define XCD_BAR_WORDS 3456
#define XB_SPIN_CAP (1u << 18)
__device__ __forceinline__ unsigned xb_ld(unsigned* p)              { return __hip_atomic_load(p, __ATOMIC_RELAXED, __HIP_MEMORY_SCOPE_AGENT); }
__device__ __forceinline__ unsigned xb_add(unsigned* p, unsigned v) { return __hip_atomic_fetch_add(p, v, __ATOMIC_RELAXED, __HIP_MEMORY_SCOPE_AGENT); }
__device__ __forceinline__ unsigned xb_xcc_id() { return (unsigned)__builtin_amdgcn_s_getreg((3 << 11) | 20) & 0xFu; }
#define XB_SPIN(cond, bar) do { unsigned _sp = 0; while (cond) { __builtin_amdgcn_s_sleep(1); \
    if ((++_sp & 255u) == 0u) { if (xb_ld(&(bar)[XB_TMO])) break; if (_sp > XB_SPIN_CAP) { atomicAdd(&(bar)[XB_TMO], 1u); break; } } } } while (0)
struct XcdBarrier { unsigned* bar; unsigned x; volatile LAS unsigned* st; };
__device__ __forceinline__ XcdBarrier xcd_barrier_post(unsigned* bar, volatile LAS unsigned* st) {
    XcdBarrier b; b.bar = bar; b.x = xb_xcc_id(); b.st = st;
    if (threadIdx.x == 0) (void)xb_add(&bar[XB_XCNT(b.x)], 1u);
    return b;
}
__device__ __forceinline__ void xcd_barrier_complete(unsigned* bar, unsigned x, unsigned& nloc, unsigned& nx) {
    const unsigned G = gridDim.x * gridDim.y * gridDim.z;
    unsigned sum, cnt, mine, sp = 0u;
    for (;;) {
        sum = 0u; cnt = 0u; mine = 0u;
#pragma unroll
        for (unsigned j = 0; j < 16; ++j) { const unsigned c = xb_ld(&bar[XB_XCNT(j)]); sum += c; cnt += (c > 0u) ? 1u : 0u; mine = (j == x) ? c : mine; }
        if (sum == G) break;
        __builtin_amdgcn_s_sleep(1);
        if ((++sp & 255u) == 0u) { if (xb_ld(&bar[XB_TMO])) break; if (sp > XB_SPIN_CAP) { atomicAdd(&bar[XB_TMO], 1u); break; } }
    }
    nloc = mine > 0u ? mine : 1u; nx = cnt > 0u ? cnt : 1u;
}
__device__ __forceinline__ void xcd_barrier(const XcdBarrier& b, const int wave) {
    asm volatile("s_waitcnt vmcnt(0)" ::: "memory");
    __syncthreads();
    if (wave == 0 && lane_id_asm() == 0) {
        unsigned* bar = b.bar;
        __builtin_amdgcn_s_waitcnt(0);
        unsigned nloc = b.st[0], nx = b.st[1];
        if (nloc == 0u) { xcd_barrier_complete(bar, b.x, nloc, nx); b.st[0] = nloc; b.st[1] = nx; }
        const unsigned old = xb_add(&bar[XB_XSUB(b.x)], 1u);
        const unsigned gen = old / nloc;
        if (old + 1u == (gen + 1u) * nloc) {
            __builtin_amdgcn_fence(__ATOMIC_RELEASE, "agent");
            asm volatile("s_waitcnt vmcnt(0)" ::: "memory");
            const unsigned og = xb_add(&bar[XB_TOP], 1u);
            const unsigned tg = og / nx;
            if (og + 1u == (tg + 1u) * nx) xb_add(&bar[XB_TOPGEN], 1u);
            else XB_SPIN(xb_ld(&bar[XB_TOPGEN]) == tg, bar);
            __builtin_amdgcn_fence(__ATOMIC_ACQUIRE, "agent");
            xb_add(&bar[XB_XGEN(b.x)], 1u);
            asm volatile("s_waitcnt vmcnt(0)" ::: "memory");
        } else {
            XB_SPIN(xb_ld(&bar[XB_XGEN(b.x)]) == gen, bar);
            __builtin_amdgcn_fence(__ATOMIC_ACQUIRE, "agent");
            asm volatile("s_waitcnt vmcnt(0)" ::: "memory");
        }
    }
    __syncthreads();
}

namespace pg8 {
constexpr int BM = 256, BK = 64, HALF = 128, HTB = HALF * BK * 2, STAGE_BYTES = 8 * HTB, NXCD = 8, WGM = 8;
__host__ __device__ __forceinline__ int lds_byte(int r, int c) { const int st = (r >> 4) * 2 + (c >> 5), rr = r & 15, cc = c & 31, ob = rr * 64 + cc * 2; return st * 1024 + (ob ^ (((ob >> 9) & 1) << 5)); }
__host__ __device__ __forceinline__ void stage_rc(int b, int& R, int& C) { const int st = b / 1024, sb = b % 1024, swz = sb ^ (((sb >> 9) & 1) << 5); R = (st >> 1) * 16 + swz / 64; C = (st & 1) * 32 + (swz % 64) / 2; }
__host__ __device__ __forceinline__ int perm32(int rho) { const int n = rho >> 4, i = rho & 15; return 8 * (i >> 2) + 4 * n + (i & 3); }

struct Unit { int pm, pn, ord; const char* a; const char* b; };

struct PlainOrder {
    static constexpr bool GATHER = false;
    int nM, nN, nwg, G, c; const char* A; const char* Bt; size_t tstep;
    __device__ void init(const void* A_, const void* Bt_, int M, int N, int K, int G_, int c_) { nM = M / BM; nN = N / BM; nwg = nM * nN; G = G_; c = c_; A = (const char*)A_; Bt = (const char*)Bt_; tstep = (size_t)BM * K * 2; }
    __device__ bool next(int i, Unit& u) const {
#if defined(PROBE_PK)
        const long L = (long)(i >> 1) * G + c; if (L >= nwg) return false;
#else
        const long L = (long)i * G + c; if (L >= nwg) return false;
#endif
        int wgid = (int)L; { const int q = nwg / NXCD, r = nwg % NXCD, xcd = wgid % NXCD, off = wgid / NXCD; wgid = (xcd < r ? xcd * (q + 1) : r * (q + 1) + (xcd - r) * q) + off; }
        const int nig = WGM * nN, gid = wgid / nig, fm = gid * WGM, gsz = (nM - fm) < WGM ? (nM - fm) : WGM;
        u.pm = fm + ((wgid % nig) % gsz); u.pn = (wgid % nig) / gsz; u.ord = i; u.a = A + (size_t)u.pm * tstep; u.b = Bt + (size_t)u.pn * tstep; return true;
    }
    __device__ __forceinline__ unsigned aoff(int, int) const { return 0u; }
};
template <int SH, bool TAB> struct MoeOrder {
    static constexpr bool GATHER = true;
    int NT, G, c; const char* A; const char* W; unsigned rowb; size_t w_exp, w_tile; const LAS unsigned char* te; const LAS unsigned* tab;
    __device__ bool next(int i, Unit& u) const {
#if defined(PROBE_GK)
        const int L = (SH == 1 ? (i >> 1) : i) * G + c; const int rt = L >> SH; if (rt >= NT) return false;
#elif defined(PROBE_DK)
        const int L = (SH == 2 ? (i >> 1) : i) * G + c; const int rt = L >> SH; if (rt >= NT) return false;
#else
        const int L = i * G + c; const int rt = L >> SH; if (rt >= NT) return false;
#endif
        u.pm = rt; u.pn = L & ((1 << SH) - 1); u.ord = i; const int e = te[rt];
        u.a = A; u.b = W + (size_t)e * w_exp + (size_t)u.pn * w_tile; return true;
    }
    __device__ __forceinline__ unsigned aoff(int ord, int r) const { if constexpr (TAB) {
#if defined(PROBE_GK)
            return tab[(ord >> 1) * 256 + r];
#else
            return tab[ord * 256 + r];
#endif
        } else return (unsigned)((((ord * G + c) >> SH) << 8) + r) * rowb; }
};

template <class Epi, class Sched, bool ALIGN_EPI, bool F8 = false, bool BTILED = false>
__device__ __forceinline__ void gemm_phase(LAS unsigned char* lds, const int wid, const int K, const Sched& S, const Epi& E) {
    const int lane = lane_id_asm(), tid = wid * 64 + lane,
        wr = wid >> 2, wc = wid & 3, fr = lane & 15, fq = lane >> 4;
    const int nt = F8 ? K / 128 : K / BK; const int RB = F8 ? K : 2 * K;
    unsigned voffA[2], voffB[2];
#pragma unroll
    for (int i = 0; i < 2; ++i) { int R, C; stage_rc(tid * 16 + i * 8192, R, C); const int Rb = (int)Epi::PERM == 2 ? (64 * (R >> 5) + 16 * ((R >> 2) & 3) + 4 * ((R >> 4) & 1) + (R & 3)) : (Epi::PERM ? ((R & ~31) + perm32(R & 31)) : R);
        voffA[i] = (unsigned)(R * RB + C * 2); voffB[i] = (unsigned)(Rb * (BTILED ? 128 : RB) + C * 2); }
    const size_t kstep = (size_t)(BK * 2); const size_t kstepB = BTILED ? (size_t)BM * 128 : kstep;
    const size_t hstep = (size_t)HALF * RB;
    const size_t hstepB = (int)Epi::PERM == 2 ? (size_t)8 * (BTILED ? 128 : RB) : (BTILED ? (size_t)HALF * 128 : hstep);
    const unsigned ldsw = (unsigned)wid * 1024u;
    const int aoff = lds_byte(wr * 64 + fr, fq * 8), boff = lds_byte(wc * 32 + fr, fq * 8);
#define PG8_SA(b, h) (((b) * 2 + (h)) * HTB)
#define PG8_SB(b, h) ((4 + (b) * 2 + (h)) * HTB)
#define PG8_STAGE(bufoff, gbase, voff) do { _Pragma("unroll") for (int _i = 0; _i < 2; ++_i) \
        __builtin_amdgcn_global_load_lds((const unsigned*)((const char*)(gbase) + (voff)[_i]), (LAS unsigned*)(lds + (bufoff) + ldsw + _i * 8192), 16, 0, 0); } while (0)
#define PG8_STAGE_A(bufoff, kb, h, GO) do { if constexpr (Sched::GATHER) { PG8_STAGE(bufoff, kb, GO[h]); } else { PG8_STAGE(bufoff, (kb) + (h) * hstep, voffA); } } while (0)
#define PG8_STAGE_A2(bufoff, kb, h) do { if constexpr (Sched::GATHER) { if (last) { PG8_STAGE(bufoff, kb, gN[h]); } else { PG8_STAGE(bufoff, kb, gC[h]); } } else { PG8_STAGE(bufoff, (kb) + (h) * hstep, voffA); } } while (0)
#define PG8_FR(p) (*(const LAS v4i_*)(p))
#define PG8_LDA(dst, b, h) do { _Pragma("unroll") for (int m = 0; m < 4; ++m) { if constexpr (F8) { dst##8[m] = __builtin_shufflevector(PG8_FR(lds + PG8_SA(b, h) + aoff + m * 2048), PG8_FR(lds + PG8_SA(b, h) + aoff + m * 2048 + 1024), 0, 1, 2, 3, 4, 5, 6, 7); } \
        else { _Pragma("unroll") for (int k = 0; k < 2; ++k) dst[m][k] = *(const LAS bf16x8*)(lds + PG8_SA(b, h) + aoff + m * 2048 + k * 1024); } } } while (0)
#define PG8_LDB(dst, b, h) do { _Pragma("unroll") for (int n = 0; n < 2; ++n) { if constexpr (F8) { dst##8[n] = __builtin_shufflevector(PG8_FR(lds + PG8_SB(b, h) + boff + n * 2048), PG8_FR(lds + PG8_SB(b, h) + boff + n * 2048 + 1024), 0, 1, 2, 3, 4, 5, 6, 7); } \
        else { _Pragma("unroll") for (int k = 0; k < 2; ++k) dst[n][k] = *(const LAS bf16x8*)(lds + PG8_SB(b, h) + boff + n * 2048 + k * 1024); } } } while (0)
#define PG8_MMA(ai, bj, At, Bt) do { __builtin_amdgcn_s_setprio(1); _Pragma("unroll") for (int m = 0; m < 4; ++m) _Pragma("unroll") for (int n = 0; n < 2; ++n) { \
        if constexpr (F8) { acc[ai][bj][m][n] = __builtin_amdgcn_mfma_scale_f32_16x16x128_f8f6f4(Bt##8[n], At##8[m], acc[ai][bj][m][n], 0, 0, 0, 0x7f7f7f7f, 0, Epi::MXSCALE); } \
        else { _Pragma("unroll") for (int k = 0; k < 2; ++k) acc[ai][bj][m][n] = __builtin_amdgcn_mfma_f32_16x16x32_bf16(Bt[n][k], At[m][k], acc[ai][bj][m][n], 0, 0, 0); } } \
        if constexpr (F8) { _Pragma("unroll") for (int m = 0; m < 4; ++m) asm volatile("" : "+v"(acc[ai][bj][m][0]), "+v"(acc[ai][bj][m][1])); }     \
        __builtin_amdgcn_s_setprio(0); } while (0)
#define PG8_WAIT_V(n) asm volatile("s_waitcnt vmcnt(" #n ")" ::: "memory")
#define PG8_WAIT_L(n) asm volatile("s_waitcnt lgkmcnt(" #n ")" ::: "memory")
#define PG8_WAIT_VR(relax) do { if (relax) asm volatile("s_waitcnt vmcnt(%0)" :: "n"(8 + Epi::NSTORE) : "memory"); else asm volatile("s_waitcnt vmcnt(8)" ::: "memory"); } while (0)
#define PG8_BAR do { __builtin_amdgcn_s_barrier(); if constexpr (F8) asm volatile("" ::: "memory"); } while (0)
#define PG8_SCHED __builtin_amdgcn_sched_barrier(0)
#define PG8_GLOAD(G_, u_) do { if constexpr (Sched::GATHER) { _Pragma("unroll") for (int _i = 0; _i < 2; ++_i) { int R_, C_; stage_rc(tid * 16 + _i * 8192, R_, C_); _Pragma("unroll") for (int _h = 0; _h < 2; ++_h) G_[_h][_i] = S.aoff((u_).ord, _h * HALF + R_) + (unsigned)C_ * 2u; } } } while (0)
    Unit cur, nxt;
    if (!S.next(0, cur)) return;
    f32x4 acc[2][2][4][2];
#pragma unroll
    for (int a = 0; a < 2; ++a)
#pragma unroll
        for (int b = 0; b < 2; ++b)
#pragma unroll
            for (int m = 0; m < 4; ++m)
#pragma unroll
                for (int n = 0; n < 2; ++n) acc[a][b][m][n] = (f32x4){0.f, 0.f, 0.f, 0.f};
    typedef int v4i_ __attribute__((ext_vector_type(4))); typedef int v8i_ __attribute__((ext_vector_type(8)));
    bf16x8 At[4][2], B0[2][2], B1[2][2];
    v8i_ At8[4], B08[2], B18[2];
    unsigned gC[2][2] = {{0u, 0u}, {0u, 0u}}, gN[2][2] = {{0u, 0u}, {0u, 0u}};
    PG8_GLOAD(gC, cur);
    const char* cA = cur.a; const char* cB = cur.b;
    PG8_STAGE(PG8_SB(0, 0), cB, voffB); PG8_STAGE(PG8_SB(0, 1), cB + hstepB, voffB); PG8_STAGE_A(PG8_SA(0, 0), cA, 0, gC); PG8_STAGE_A(PG8_SA(0, 1), cA, 1, gC);
    if (wr == 1) PG8_BAR;
    PG8_WAIT_V(2); PG8_BAR;
    PG8_STAGE(PG8_SB(1, 0), cB + kstepB, voffB); PG8_STAGE_A(PG8_SA(1, 0), cA + kstep, 0, gC); PG8_STAGE(PG8_SB(1, 1), cB + hstepB + kstepB, voffB);
    PG8_WAIT_V(6); PG8_BAR;
    int ui = 0;
    for (;;) {
        const bool has_next = S.next(ui + 1, nxt);
        const char* nA = has_next ? nxt.a : cA; const char* nB = has_next ? nxt.b : cB;
        if constexpr (Sched::GATHER) { if (has_next) { PG8_GLOAD(gN, nxt); } else {
#pragma unroll
            for (int _h = 0; _h < 2; ++_h)
#pragma unroll
                for (int _i = 0; _i < 2; ++_i) gN[_h][_i] = gC[_h][_i]; } }
#pragma unroll 1
        for (int t = 0; t < nt; t += 2) {
            const bool last = (t == nt - 2);
            const char* a1 = cA + (size_t)(t + 1) * kstep;
            const char* a2 = last ? nA : cA + (size_t)(t + 2) * kstep; const char* b2 = last ? nB : cB + (size_t)(t + 2) * kstepB;
            const char* a3 = a2 + kstep; const char* b3 = b2 + kstepB;
            if constexpr (Epi::HAS_MID) { if (t == nt / 2) E.mid(acc, cur, wr, fr); }
            const bool relax = Epi::NSTORE > 0 && t == 0 && ui > 0;
            PG8_LDB(B0, 0, 0); PG8_LDB(B1, 0, 1); PG8_SCHED; PG8_LDA(At, 0, 0); if (!relax) PG8_STAGE_A(PG8_SA(1, 1), a1, 1, gC);
            PG8_WAIT_VR(relax); PG8_WAIT_L(0); PG8_BAR; PG8_MMA(0, 0, At, B0); PG8_MMA(0, 1, At, B1); PG8_BAR; PG8_SCHED;
            PG8_LDA(At, 0, 1); PG8_STAGE(PG8_SB(0, 0), b2, voffB); PG8_STAGE(PG8_SB(0, 1), b2 + hstepB, voffB); PG8_STAGE_A2(PG8_SA(0, 0), a2, 0);
            PG8_WAIT_VR(relax); PG8_WAIT_L(0); PG8_BAR; PG8_MMA(1, 0, At, B0); PG8_MMA(1, 1, At, B1); PG8_BAR; PG8_SCHED;
            PG8_LDB(B0, 1, 0); PG8_LDB(B1, 1, 1); PG8_SCHED; PG8_LDA(At, 1, 0); PG8_STAGE_A2(PG8_SA(0, 1), a2, 1);
            PG8_WAIT_VR(relax); PG8_WAIT_L(0); PG8_BAR; PG8_MMA(0, 0, At, B0); PG8_MMA(0, 1, At, B1); PG8_BAR; PG8_SCHED;
            PG8_LDA(At, 1, 1); PG8_STAGE(PG8_SB(1, 0), b3, voffB); PG8_STAGE(PG8_SB(1, 1), b3 + hstepB, voffB); PG8_STAGE_A2(PG8_SA(1, 0), a3, 0);
            PG8_WAIT_V(8); PG8_WAIT_L(0); PG8_BAR; PG8_MMA(1, 0, At, B0); PG8_MMA(1, 1, At, B1); PG8_BAR; PG8_SCHED;
        }
        if constexpr (Epi::NSTORE > 0) { if (has_next) PG8_STAGE_A(PG8_SA(1, 1), nA + kstep, 1, gN); }
        if constexpr (ALIGN_EPI) { if (wr == 0) PG8_BAR; }
        E(acc, cur, wr, wc, fr, fq);
        if (!has_next) break;
#pragma unroll
        for (int a = 0; a < 2; ++a)
#pragma unroll
            for (int b = 0; b < 2; ++b)
#pragma unroll
                for (int m = 0; m < 4; ++m)
#pragma unroll
                    for (int n = 0; n < 2; ++n) acc[a][b][m][n] = (f32x4){0.f, 0.f, 0.f, 0.f};
        cur = nxt; cA = nA; cB = nB; ++ui;
#pragma unroll
        for (int _h = 0; _h < 2; ++_h)
#pragma unroll
            for (int _i = 0; _i < 2; ++_i) gC[_h][_i] = gN[_h][_i];
        if constexpr (ALIGN_EPI) { if (wr == 1) PG8_BAR; }
    }
    PG8_WAIT_V(0);
    if constexpr (!ALIGN_EPI) { if (wr == 0) PG8_BAR; }
    PG8_BAR;
#undef PG8_SA
#undef PG8_SB
#undef PG8_STAGE
#undef PG8_STAGE_A
#undef PG8_STAGE_A2
#undef PG8_LDA
#undef PG8_FR
#undef PG8_LDB
#undef PG8_MMA
#undef PG8_WAIT_V
#undef PG8_WAIT_L
#undef PG8_WAIT_VR
#undef PG8_BAR
#undef PG8_SCHED
#undef PG8_GLOAD
}

struct EpiBf16 {
    static constexpr bool PERM = true, HAS_MID = false; static constexpr int NSTORE = 16;
    static constexpr int MXSCALE = 0x7f7f7f7f;
    bf16* O; int ldc;
    __device__ __forceinline__ void operator()(const f32x4 (&acc)[2][2][4][2], const Unit& u, int wr, int wc, int fr, int fq) const {
#if defined(PROBE_PK)
        if ((u.ord & 1) == 0) return;
#endif
        const int row0 = u.pm * BM + wr * 64 + fr, col0 = u.pn * BM + wc * 32 + 8 * fq;
#pragma unroll
        for (int ai = 0; ai < 2; ++ai)
#pragma unroll
            for (int m = 0; m < 4; ++m) { bf16* rowp = O + (size_t)(row0 + ai * HALF + m * 16) * ldc + col0;
#pragma unroll
                for (int bj = 0; bj < 2; ++bj) { const f32x4 v0 = acc[ai][bj][m][0], v1 = acc[ai][bj][m][1];
                    u32x4 w; w.x = cvt_pk_bf16(v0[0], v0[1]); w.y = cvt_pk_bf16(v0[2], v0[3]); w.z = cvt_pk_bf16(v1[0], v1[1]); w.w = cvt_pk_bf16(v1[2], v1[3]);
                    *(u32x4*)(rowp + bj * HALF) = w; } }
    }
};
struct EpiBf16T {
    static constexpr bool PERM = true, HAS_MID = false; static constexpr int NSTORE = 16;
    static constexpr int MXSCALE = 0x7f7f7f7f;
    bf16* O; int ntn;
    __device__ __forceinline__ void operator()(const f32x4 (&acc)[2][2][4][2], const Unit& u, int wr, int wc, int fr, int fq) const {
        bf16* tile = O + ((size_t)u.pm * ntn + u.pn) * 65536 + (wr * 64 + fr) * 256 + wc * 32 + 8 * fq;
#pragma unroll
        for (int ai = 0; ai < 2; ++ai)
#pragma unroll
            for (int m = 0; m < 4; ++m) { bf16* rowp = tile + (ai * HALF + m * 16) * 256;
#pragma unroll
                for (int bj = 0; bj < 2; ++bj) { const f32x4 v0 = acc[ai][bj][m][0], v1 = acc[ai][bj][m][1];
                    u32x4 w; w.x = cvt_pk_bf16(v0[0], v0[1]); w.y = cvt_pk_bf16(v0[2], v0[3]); w.z = cvt_pk_bf16(v1[0], v1[1]); w.w = cvt_pk_bf16(v1[2], v1[3]);
                    *(u32x4*)(rowp + bj * HALF) = w; } }
    }
};
struct EpiGU {
    static constexpr bool PERM = true, HAS_MID = false; static constexpr int NSTORE = 8;
    static constexpr int MXSCALE = 0x7f7f7f7f;
    unsigned char* H;
    __device__ __forceinline__ void operator()(const f32x4 (&acc)[2][2][4][2], const Unit& u, int wr, int wc, int fr, int fq) const {
#if defined(PROBE_GK)
        if ((u.ord & 1) == 0) return;
#endif
        const int row0 = u.pm * BM + wr * 64 + fr, col0 = u.pn * HALF + wc * 32 + 8 * fq;
#pragma unroll
        for (int ai = 0; ai < 2; ++ai)
#pragma unroll
            for (int m = 0; m < 4; ++m) { unsigned char* rowp = H + (size_t)(row0 + ai * HALF + m * 16) * 256 + col0;
                float h[8];
#pragma unroll
                for (int n = 0; n < 2; ++n)
#pragma unroll
                    for (int i = 0; i < 4; i += 2) {
                        const f32x2 g = (f32x2){acc[ai][0][m][n][i], acc[ai][0][m][n][i + 1]}, u = (f32x2){acc[ai][1][m][n][i], acc[ai][1][m][n][i + 1]};
                        const f32x2 t = g * (-1.4426950408889634f / 64.0f); const f32x2 e = (f32x2){__builtin_amdgcn_exp2f(t.x), __builtin_amdgcn_exp2f(t.y)};
                        const f32x2 d = e * 1024.0f + 1024.0f;
                        const f32x2 r = (f32x2){__builtin_amdgcn_rcpf(d.x), __builtin_amdgcn_rcpf(d.y)}; const f32x2 hh = (g * u) * r;
                        h[4 * n + i] = hh.x; h[4 * n + i + 1] = hh.y; }
                int lo = __builtin_amdgcn_cvt_pk_fp8_f32(h[0], h[1], 0, false); lo = __builtin_amdgcn_cvt_pk_fp8_f32(h[2], h[3], lo, true);
                int hi = __builtin_amdgcn_cvt_pk_fp8_f32(h[4], h[5], 0, false); hi = __builtin_amdgcn_cvt_pk_fp8_f32(h[6], h[7], hi, true);
                *(u32x2*)rowp = (u32x2){(unsigned)lo, (unsigned)hi}; }
    }
};
struct EpiFp8 {
    static constexpr int PERM = 2; static constexpr bool HAS_MID = false; static constexpr int NSTORE = 8;
    static constexpr int MXSCALE = 0x7b7b7b7b;
    unsigned char* O; int ldc; float sc;
    __device__ __forceinline__ void operator()(const f32x4 (&acc)[2][2][4][2], const Unit& u, int wr, int wc, int fr, int fq) const {
        const int row0 = u.pm * BM + wr * 64 + fr, col0 = u.pn * BM + wc * 64 + 16 * fq;
#pragma unroll
        for (int ai = 0; ai < 2; ++ai)
#pragma unroll
            for (int m = 0; m < 4; ++m) { u32x4 w;
#pragma unroll
                for (int bj = 0; bj < 2; ++bj) { const f32x4 v0 = acc[ai][bj][m][0], v1 = acc[ai][bj][m][1];
                    int lo = __builtin_amdgcn_cvt_pk_fp8_f32(v0[0], v0[1], 0, false); lo = __builtin_amdgcn_cvt_pk_fp8_f32(v0[2], v0[3], lo, true);
                    int hi = __builtin_amdgcn_cvt_pk_fp8_f32(v1[0], v1[1], 0, false); hi = __builtin_amdgcn_cvt_pk_fp8_f32(v1[2], v1[3], hi, true);
                    if (bj == 0) { w.x = (unsigned)lo; w.y = (unsigned)hi; } else { w.z = (unsigned)lo; w.w = (unsigned)hi; } }
                *(u32x4*)(O + (size_t)(row0 + ai * HALF + m * 16) * ldc + col0) = w; }
    }
};
struct EpiX1 {
    static constexpr bool PERM = true, HAS_MID = true; static constexpr int NSTORE = 0;
    static constexpr int MXSCALE = 0x7f7f7f7f;
    const float* x; bf16* o; const float* g1; const LAS float* rstab;
    __device__ __forceinline__ void mid(f32x4 (&acc)[2][2][4][2], const Unit& u, int wr, int fr) const {
#pragma unroll
        for (int ai = 0; ai < 2; ++ai)
#pragma unroll
            for (int m = 0; m < 4; ++m) { const float rs = rstab[u.ord * 256 + ai * HALF + wr * 64 + m * 16 + fr];
#pragma unroll
                for (int bj = 0; bj < 2; ++bj)
#pragma unroll
                    for (int n = 0; n < 2; ++n) acc[ai][bj][m][n] = acc[ai][bj][m][n] * rs; }
    }
    __device__ __forceinline__ void operator()(const f32x4 (&acc)[2][2][4][2], const Unit& u, int wr, int wc, int fr, int fq) const {
        const int row0 = u.pm * BM + wr * 64 + fr, col0 = u.pn * BM + wc * 32 + 8 * fq; const int b = (u.pm * BM) / SEQ;
        f32x4 gv[2][2];
#pragma unroll
        for (int bj = 0; bj < 2; ++bj)
#pragma unroll
            for (int n = 0; n < 2; ++n) gv[bj][n] = *(const f32x4*)(g1 + (size_t)b * 6144 + col0 + bj * HALF + 4 * n);
#pragma unroll
        for (int ai = 0; ai < 2; ++ai) {
            f32x4 xv[4][2][2];
#pragma unroll
            for (int m = 0; m < 4; ++m)
#pragma unroll
                for (int bj = 0; bj < 2; ++bj)
#pragma unroll
                    for (int n = 0; n < 2; ++n) xv[m][bj][n] = *(const f32x4*)(x + (size_t)(row0 + ai * HALF + m * 16) * D + col0 + bj * HALF + 4 * n);
#pragma unroll
            for (int m = 0; m < 4; ++m)
#pragma unroll
                for (int bj = 0; bj < 2; ++bj) { const f32x4 v0 = xv[m][bj][0] + gv[bj][0] * acc[ai][bj][m][0], v1 = xv[m][bj][1] + gv[bj][1] * acc[ai][bj][m][1];
                    u32x4 w; w.x = cvt_pk_bf16(v0[0], v0[1]); w.y = cvt_pk_bf16(v0[2], v0[3]); w.z = cvt_pk_bf16(v1[0], v1[1]); w.w = cvt_pk_bf16(v1[2], v1[3]);
                    *(u32x4*)(o + (size_t)(row0 + ai * HALF + m * 16) * D + col0 + bj * HALF) = w; }
            asm volatile("" ::: "memory"); }
    }
};
struct EpiLogits {
    static constexpr bool PERM = false, HAS_MID = false; static constexpr int NSTORE = 0;
    static constexpr int MXSCALE = 0x7f7f7f7f;
    float* L;
    __device__ __forceinline__ void operator()(const f32x4 (&acc)[2][2][4][2], const Unit& u, int wr, int wc, int fr, int fq) const {
        if (wc < 2 && u.pn == 0) {
            const int row0 = u.pm * BM + wr * 64 + fr, col0 = wc * 32 + 4 * fq;
#pragma unroll
            for (int ai = 0; ai < 2; ++ai)
#pragma unroll
                for (int m = 0; m < 4; ++m)
#pragma unroll
                    for (int n = 0; n < 2; ++n) *(f32x4*)(L + (size_t)(row0 + ai * HALF + m * 16) * 64 + col0 + n * 16) = acc[ai][0][m][n];
        }
    }
};
}

struct Args { const float* in[24]; float* out; unsigned char* ws; int ph_lo, ph_hi; };
typedef const Args __attribute__((address_space(4))) CArgs;
#define ARGS_LAUNDER(src_) CArgs* ap_ = &(src_); asm volatile("" : "+s"(ap_)); CArgs& args = *ap_
struct Frame {
    LAS unsigned char* lds; volatile LAS unsigned* MISC; unsigned* ctl;
    int tid, lane, wave, vcu, G;
};

struct TrIt { const float* src; unsigned char* dst; const float* ks; int ldw, ldk, useks, f8; };
__device__ __forceinline__ void tr_load(const TrIt& t, f32x4 (&tv)[8], float (&tk)[8], int lane) {
#pragma unroll
    for (int i = 0; i < 8; ++i) { const int kk = 8 * i + (lane >> 3), n4 = 4 * (lane & 7); tv[i] = *(const f32x4*)(t.src + (size_t)kk * t.ldw + n4); tk[i] = t.ks[kk]; }
}
__device__ __forceinline__ void tr_store(const TrIt& t, const f32x4 (&tv)[8], const float (&tk)[8], LAS float* scr, int lane) {
#pragma unroll
    for (int i = 0; i < 8; ++i) { const int kk = 8 * i + (lane >> 3), n4 = 4 * (lane & 7); const f32x4 v = tv[i] * (t.useks ? tk[i] : 1.0f);
        LAS float* d = scr + kk * 33 + n4; d[0] = v.x; d[1] = v.y; d[2] = v.z; d[3] = v.w; }
    LDS_WAIT(); asm volatile("" ::: "memory");
    const int c = lane & 7;
#pragma unroll
    for (int j = 0; j < 4; ++j) { const int n = (lane >> 3) + 8 * j; const LAS float* s = scr + (8 * c) * 33 + n;
        if (t.f8) {
            int lo = __builtin_amdgcn_cvt_pk_fp8_f32(s[0 * 33] * 64.f, s[1 * 33] * 64.f, 0, false); lo = __builtin_amdgcn_cvt_pk_fp8_f32(s[2 * 33] * 64.f, s[3 * 33] * 64.f, lo, true);
            int hi = __builtin_amdgcn_cvt_pk_fp8_f32(s[4 * 33] * 64.f, s[5 * 33] * 64.f, 0, false); hi = __builtin_amdgcn_cvt_pk_fp8_f32(s[6 * 33] * 64.f, s[7 * 33] * 64.f, hi, true);
            *(u32x2*)(t.dst + (size_t)n * t.ldk + 8 * c) = (u32x2){(unsigned)lo, (unsigned)hi};
        } else {
            u32x4 o; o.x = cvt_pk_bf16(s[0 * 33], s[1 * 33]); o.y = cvt_pk_bf16(s[2 * 33], s[3 * 33]); o.z = cvt_pk_bf16(s[4 * 33], s[5 * 33]); o.w = cvt_pk_bf16(s[6 * 33], s[7 * 33]);
            *(u32x4*)(t.dst + ((size_t)n * t.ldk + 8 * c) * 2) = o; } }
    LDS_WAIT(); asm volatile("" ::: "memory");
}
__device__ __forceinline__ void p0_prologue(const Frame& F_, CArgs& args_) {
    Frame F = F_; F.lane = lane_id_asm(); F.tid = F.wave * 64 + F.lane;
    ARGS_LAUNDER(args_);
    const int gw = F.vcu * 8 + F.wave, NGW = F.G * 8, lane = F.lane;
    for (int cg = F.vcu; cg < 96; cg += F.G) {
        const int j = cg * 64 + lane, k0 = F.wave * 128;
        float acc[16];
#pragma unroll
        for (int b = 0; b < 16; ++b) acc[b] = 0.f;
#pragma unroll 8
        for (int kk = 0; kk < 128; ++kk) { const float w = (args.in[2])[(size_t)(k0 + kk) * 6144 + j];
#pragma unroll
            for (int b = 0; b < 16; ++b) acc[b] += (args.in[1])[b * 1024 + k0 + kk] * w; }
        LAS float* part = (LAS float*)F.lds;
#pragma unroll
        for (int b = 0; b < 16; ++b) part[(F.wave * 16 + b) * 64 + lane] = acc[b];
        WG_BAR();
        for (int o = F.tid; o < 1024; o += 512) { const int b = o >> 6, jj = o & 63; float s = (args.in[3])[cg * 64 + jj];
#pragma unroll
            for (int w = 0; w < 8; ++w) s += part[(w * 16 + b) * 64 + jj];
            ((float*)(args.ws + WS_MOD))[b * 6144 + cg * 64 + jj] = s; }
        WG_BAR();
    }
    LAS float* scr = (LAS float*)(F.lds + F.wave * 16384);
    constexpr int I_IN = 16 * 96, I_OUT = 16 * 32, I_E = NEX * 128;
    constexpr int NITEMS = I_IN + I_OUT + 3 * I_E;
    auto decode = [&](int it) -> TrIt { TrIt t; t.useks = 0; t.ks = (args.in[12]); t.f8 = 0; int r = it;
        if (r < I_IN) { const int kb = r / 96, nb = r % 96; t.src = (args.in[5]) + (size_t)(kb * 64) * LDWIN + nb * 32; t.ldw = LDWIN; t.dst = (unsigned char*)(((bf16*)(args.ws + WS_WIN)) + ((size_t)((nb * 32) / 256 * 16 + kb) * 256 + (nb * 32) % 256) * 64); t.ldk = 64; return t; } r -= I_IN;
        if (r < I_OUT) { const int kb = r / 32, nb = r % 32, k0 = kb * 64; const int dc = k0 < 512 ? k0 + 512 : k0 - 512;
            t.src = (args.in[13]) + (size_t)k0 * 1024 + nb * 32; t.ldw = 1024; t.dst = (unsigned char*)(((bf16*)(args.ws + WS_WOUT)) + (size_t)(nb * 32) * 1024 + dc); t.ldk = 1024; if (k0 >= 512) { t.useks = 1; t.ks = (args.in[12]) + (k0 - 512); } return t; } r -= I_OUT;
        t.f8 = 1;
        if (r < 2 * I_E) { const int up = r >= I_E; if (up) r -= I_E; const int e = r / 128, q = r % 128, kb = q / 8, nb = q % 8, n0 = nb * 32;
            const float* W = up ? (e < NE ? (args.in[18]) + (size_t)e * 262144 : (args.in[21])) : (e < NE ? (args.in[17]) + (size_t)e * 262144 : (args.in[20]));
            const int drow = (n0 / 128) * 256 + up * 128 + (n0 % 128);
            t.src = W + (size_t)(kb * 64) * 256 + n0; t.ldw = 256; t.dst = (unsigned char*)(args.ws + WS_WGU) + ((size_t)e * 512 + drow) * 1024 + kb * 64; t.ldk = 1024; return t; } r -= 2 * I_E;
        { const int e = r / 128, q = r % 128, kb = q / 32, nb = q % 32; const float* W = e < NE ? (args.in[19]) + (size_t)e * 262144 : (args.in[22]);
            t.src = W + (size_t)(kb * 64) * 1024 + nb * 32; t.ldw = 1024; t.dst = (unsigned char*)(args.ws + WS_WD) + ((size_t)e * 1024 + nb * 32) * 256 + kb * 64; t.ldk = 256; return t; } };
    if (gw < NITEMS) {
        TrIt nxt = decode(gw); f32x4 nv[8]; float nk[8];
        tr_load(nxt, nv, nk, lane);
#pragma unroll 1
        for (int it = gw; it < NITEMS; it += NGW) {
            const TrIt cur = nxt; f32x4 cv[8]; float ck[8];
#pragma unroll
            for (int i = 0; i < 8; ++i) { cv[i] = nv[i]; ck[i] = nk[i]; }
            nxt = decode(it + NGW < NITEMS ? it + NGW : it);
            tr_load(nxt, nv, nk, lane);
            tr_store(cur, cv, ck, scr, lane);
        }
    }
    for (int e = blockIdx.x * 512 + F.tid; e < 4096; e += F.G * 512) { const int p = e >> 3, hh = e & 7;
        ((unsigned*)(args.ws + WS_WDT))[e] = cvt_pk_bf16((args.in[5])[(size_t)(2 * p) * LDWIN + NPROJ + hh], (args.in[5])[(size_t)(2 * p + 1) * LDWIN + NPROJ + hh]); }
}

template <bool WITH_DT, bool XBF>
__device__ __forceinline__ void p_norm_mod(const Frame& F_, CArgs& args_, const void* xin_, const float* gain, int shift_off, int scale_off, bf16* hout, unsigned char* h8out) {
    Frame F = F_; F.lane = lane_id_asm(); F.tid = F.wave * 64 + F.lane;
    ARGS_LAUNDER(args_);
    const int gw = F.vcu * 8 + F.wave, NGW = F.G * 8, lane = F.lane;
    for (int blk = gw; blk < T / 32; blk += NGW) {
        const int row0 = blk * 32, b = row0 / SEQ;
        f32x4 sc[4], sh[4];
#pragma unroll
        for (int j = 0; j < 4; ++j) { const int col = 4 * lane + 256 * j; const f32x4 g = *(const f32x4*)(gain + col); const f32x4 s1 = *(const f32x4*)(((float*)(args.ws + WS_MOD)) + b * 6144 + scale_off + col);
            sc[j] = g * (s1 + 1.0f); sh[j] = *(const f32x4*)(((float*)(args.ws + WS_MOD)) + b * 6144 + shift_off + col); }
        unsigned wdt[WITH_DT ? 4 : 1][2][WITH_DT ? 8 : 1];
        if constexpr (WITH_DT) {
#pragma unroll
            for (int j = 0; j < 4; ++j)
#pragma unroll
                for (int pr = 0; pr < 2; ++pr) { const u32x4* wp = (const u32x4*)(args.ws + WS_WDT) + (size_t)(2 * lane + 128 * j + pr) * 2; const u32x4 a = wp[0], c = wp[1];
                    wdt[j][pr][0] = a.x; wdt[j][pr][1] = a.y; wdt[j][pr][2] = a.z; wdt[j][pr][3] = a.w; wdt[j][pr][4] = c.x; wdt[j][pr][5] = c.y; wdt[j][pr][6] = c.z; wdt[j][pr][7] = c.w; }
        }
        float dtb = 0.f; if constexpr (WITH_DT) dtb = (args.in[9])[lane & 7];
        f32x4 nx[2][4];
#pragma unroll
        for (int p = 0; p < 2; ++p)
#pragma unroll
            for (int j = 0; j < 4; ++j) {
                if constexpr (XBF) { const u32x2 w = ((const u32x2*)((const bf16*)xin_ + (size_t)(row0 + p) * D) + lane)[64 * j]; nx[p][j] = (f32x4){bflo(w.x), bfhi(w.x), bflo(w.y), bfhi(w.y)}; }
                else nx[p][j] = ((const f32x4*)((const float*)xin_ + (size_t)(row0 + p) * D) + lane)[64 * j]; }
#pragma unroll 2
        for (int r = 0; r < 32; ++r) {
            const int row = row0 + r;
            f32x4 v[4]; float s = 0.f;
#pragma unroll
            for (int j = 0; j < 4; ++j) v[j] = nx[r & 1][j];
            { const int rn = row0 + (r + 2 < 32 ? r + 2 : 31);
#pragma unroll
                for (int j = 0; j < 4; ++j) {
                    if constexpr (XBF) { const u32x2 w = ((const u32x2*)((const bf16*)xin_ + (size_t)rn * D) + lane)[64 * j]; nx[r & 1][j] = (f32x4){bflo(w.x), bfhi(w.x), bflo(w.y), bfhi(w.y)}; }
                    else nx[r & 1][j] = ((const f32x4*)((const float*)xin_ + (size_t)rn * D) + lane)[64 * j]; } }
#pragma unroll
            for (int j = 0; j < 4; ++j) s += (v[j].x * v[j].x + v[j].y * v[j].y) + (v[j].z * v[j].z + v[j].w * v[j].w);
            const float rstd = rsqrtf(wave_sum(s) * (1.0f / D) + EPS);
            u32x2* o8 = (u32x2*)(hout + (size_t)row * D) + lane;
            float dv[8] = {0.f, 0.f, 0.f, 0.f, 0.f, 0.f, 0.f, 0.f};
#pragma unroll
            for (int j = 0; j < 4; ++j) { const f32x4 h = v[j] * rstd * sc[j] + sh[j];
                if constexpr (!WITH_DT) { int q8 = __builtin_amdgcn_cvt_pk_fp8_f32(h.x, h.y, 0, false); q8 = __builtin_amdgcn_cvt_pk_fp8_f32(h.z, h.w, q8, true); ((unsigned*)(h8out + (size_t)row * D))[lane + 64 * j] = (unsigned)q8; }
                const unsigned wx = cvt_pk_bf16(h.x, h.y), wy = cvt_pk_bf16(h.z, h.w); if (WITH_DT) o8[64 * j] = (u32x2){wx, wy};
                if constexpr (WITH_DT) {
                    typedef __bf16 bf2 __attribute__((ext_vector_type(2)));
#pragma unroll
                    for (int hh = 0; hh < 8; ++hh) { dv[hh] = __builtin_amdgcn_fdot2_f32_bf16(__builtin_bit_cast(bf2, wx), __builtin_bit_cast(bf2, wdt[j][0][hh]), dv[hh], false);
                        dv[hh] = __builtin_amdgcn_fdot2_f32_bf16(__builtin_bit_cast(bf2, wy), __builtin_bit_cast(bf2, wdt[j][1][hh]), dv[hh], false); } } }
            if constexpr (WITH_DT) {
#pragma unroll
                for (int hh = 0; hh < 8; ++hh) dv[hh] = wave_sum(dv[hh]);
                float mine = dv[0];
#pragma unroll
                for (int hh = 1; hh < 8; ++hh) mine = (lane == hh) ? dv[hh] : mine;
                if (lane < 8) { const float a = mine + dtb; ((float*)(args.ws + WS_DT))[(size_t)row * 8 + lane] = a > 20.f ? a : log1pf(__expf(a)); }
            }
        }
    }
}

__device__ __forceinline__ void p3_conv(const Frame& F_, CArgs& args_) {
    Frame F = F_; F.lane = lane_id_asm(); F.tid = F.wave * 64 + F.lane;
    ARGS_LAUNDER(args_);
    const int q = F.tid & 63, seg = F.tid >> 6;
    for (int tile = F.vcu; tile < T / 256; tile += F.G) {
        const int r0 = tile * 256 + seg * 32; const bool head = (r0 % SEQ) == 0;
        {
            float w0[8], w1[8], w2[8], pm2[8], pm1[8];
#pragma unroll
            for (int i = 0; i < 8; ++i) { w0[i] = (args.in[6])[0 * 512 + 8 * q + i]; w1[i] = (args.in[6])[1 * 512 + 8 * q + i]; w2[i] = (args.in[6])[2 * 512 + 8 * q + i]; pm2[i] = 0.f; pm1[i] = 0.f; }
            if (!head) {
                float a[8], b[8];
                unpack8(*(const u32x4*)(((bf16*)(args.ws + WS_A)) + pj((size_t)(r0 - 2), C_CC + 8 * q)), a); unpack8(*(const u32x4*)(((bf16*)(args.ws + WS_A)) + pj((size_t)(r0 - 2), C_CU + 8 * q)), b);
#pragma unroll
                for (int i = 0; i < 8; ++i) pm2[i] = a[i] * b[i];
                unpack8(*(const u32x4*)(((bf16*)(args.ws + WS_A)) + pj((size_t)(r0 - 1), C_CC + 8 * q)), a); unpack8(*(const u32x4*)(((bf16*)(args.ws + WS_A)) + pj((size_t)(r0 - 1), C_CU + 8 * q)), b);
#pragma unroll
                for (int i = 0; i < 8; ++i) pm1[i] = a[i] * b[i];
            }
            const bf16* pj0 = ((bf16*)(args.ws + WS_A));
            constexpr int YB = 4; u32x4 nb[YB][3];
#pragma unroll
            for (int j = 0; j < YB; ++j) { nb[j][0] = *(const u32x4*)(pj0 + pj((size_t)(r0 + j), C_CB + 8 * q)); nb[j][1] = *(const u32x4*)(pj0 + pj((size_t)(r0 + j), C_CC + 8 * q)); nb[j][2] = *(const u32x4*)(pj0 + pj((size_t)(r0 + j), C_CU + 8 * q)); }
#pragma unroll 1
            for (int r = 0; r < 32; r += YB) {
                u32x4 cur[YB][3];
#pragma unroll
                for (int j = 0; j < YB; ++j) { cur[j][0] = nb[j][0]; cur[j][1] = nb[j][1]; cur[j][2] = nb[j][2]; }
                {
#pragma unroll
                    for (int j = 0; j < YB; ++j) { const size_t rn = (size_t)(r0 + (r + YB + j < 32 ? r + YB + j : 31));
                        nb[j][0] = *(const u32x4*)(pj0 + pj(rn, C_CB + 8 * q)); nb[j][1] = *(const u32x4*)(pj0 + pj(rn, C_CC + 8 * q)); nb[j][2] = *(const u32x4*)(pj0 + pj(rn, C_CU + 8 * q)); } }
#pragma unroll
                for (int j = 0; j < YB; ++j) {
                    float cb[8], cc[8], cu[8], y[8];
                    unpack8(cur[j][0], cb); unpack8(cur[j][1], cc); unpack8(cur[j][2], cu);
#pragma unroll
                    for (int i = 0; i < 8; ++i) { const float p = cc[i] * cu[i]; y[i] = cb[i] * (w0[i] * pm2[i] + w1[i] * pm1[i] + w2[i] * p); pm2[i] = pm1[i]; pm1[i] = p; }
                    *(u32x4*)(((bf16*)(args.ws + WS_HB)) + (size_t)(r0 + r + j) * D + 512 + 8 * q) = pack8(y);
                }
            }
        }
#pragma unroll 1
        for (int jj = 0; jj < 2; ++jj) {
            const int ch0 = 8 * (q + 64 * jj);
            float w0[8], w1[8], w2[8], w3[8], bs[8], u3[8], u2[8], u1[8];
#pragma unroll
            for (int i = 0; i < 8; ++i) { w0[i] = (args.in[7])[0 * 1024 + ch0 + i]; w1[i] = (args.in[7])[1 * 1024 + ch0 + i]; w2[i] = (args.in[7])[2 * 1024 + ch0 + i]; w3[i] = (args.in[7])[3 * 1024 + ch0 + i];
                bs[i] = (args.in[8])[ch0 + i]; u3[i] = 0.f; u2[i] = 0.f; u1[i] = 0.f; }
            if (!head) { unpack8(*(const u32x4*)(((bf16*)(args.ws + WS_A)) + pj((size_t)(r0 - 3), C_XBC + ch0)), u3); unpack8(*(const u32x4*)(((bf16*)(args.ws + WS_A)) + pj((size_t)(r0 - 2), C_XBC + ch0)), u2);
                unpack8(*(const u32x4*)(((bf16*)(args.ws + WS_A)) + pj((size_t)(r0 - 1), C_XBC + ch0)), u1); }
            const bf16* pjx = ((bf16*)(args.ws + WS_A));
            constexpr int XB = 8; u32x4 nb[XB];
#pragma unroll
            for (int j = 0; j < XB; ++j) nb[j] = *(const u32x4*)(pjx + pj((size_t)(r0 + j), C_XBC + ch0));
#pragma unroll 1
            for (int r = 0; r < 32; r += XB) {
                u32x4 cur[XB];
#pragma unroll
                for (int j = 0; j < XB; ++j) cur[j] = nb[j];
#pragma unroll
                for (int j = 0; j < XB; ++j) nb[j] = *(const u32x4*)(pjx + pj((size_t)(r0 + (r + XB + j < 32 ? r + XB + j : 31)), C_XBC + ch0));
#pragma unroll
                for (int j = 0; j < XB; ++j) {
                    float u[8], y[8]; unpack8(cur[j], u);
#pragma unroll
                    for (int i = 0; i < 8; ++i) { y[i] = silu_f(bs[i] + w0[i] * u3[i] + w1[i] * u2[i] + w2[i] * u1[i] + w3[i] * u[i]); u3[i] = u2[i]; u2[i] = u1[i]; u1[i] = u[i]; }
                    *(u32x4*)(((bf16*)(args.ws + WS_XC)) + (size_t)(r0 + r + j) * D + ch0) = pack8(y);
                }
            }
        }
    }
}

constexpr int SD_SET = 55296, SD_BM = 0, SD_CM = 17408, SD_DX = 34816, SD_DXD = 39936, SD_XS = 45056, SD_ZR = 50176, SD_WM = 2 * SD_SET, SD_SB = SD_WM + 2 * 9216, SD_ACS = SD_SB + 8704, SD_DTS = SD_ACS + 768, SD_END = SD_DTS + 768;
static_assert(SD_END <= MISC_OFF, "SSD LDS map");
typedef short s16x4 __attribute__((ext_vector_type(4)));
__device__ __forceinline__ bf16x8 lds_tr8(const LAS unsigned char* p, int stride4) {
    const s16x4 a = __builtin_bit_cast(s16x4, __builtin_amdgcn_ds_read_tr16_b64_v4i16((LAS s16x4*)p));
    const s16x4 b = __builtin_bit_cast(s16x4, __builtin_amdgcn_ds_read_tr16_b64_v4i16((LAS s16x4*)(p + stride4)));
    return __builtin_shufflevector(a, b, 0, 1, 2, 3, 4, 5, 6, 7);
}
#define DPP_SHR_ADD(v, n) do { const int t_ = __builtin_amdgcn_update_dpp(0, __float_as_int(v), 0x110 + (n), 0xf, 0xf, true); (v) += __int_as_float(t_); } while (0)
__device__ __forceinline__ void p4_ssd(const Frame& F_, CArgs& args_) {
    Frame F = F_; F.lane = lane_id_asm(); F.tid = F.wave * 64 + F.lane;
    ARGS_LAUNDER(args_);
    LAS unsigned char* lds = F.lds; const int tid = F.tid, lane = F.lane, wave = F.wave, fr = lane & 15, fq = lane >> 4;
    const int tq = fr >> 2, tp = fr & 3;
    for (int uid = F.vcu; uid < 256; uid += F.G) {
        const int b = uid >> 4, h = (uid >> 1) & 7, ph = uid & 1, g = h >> 2;
        const float Ah = -__expf((args.in[10])[h]), Dh = (args.in[11])[h];
        const int xs_col = h * 64 + ph * 32, b_col = 512 + g * 128, c_col = 768 + g * 128, z_col = C_Z + h * 64 + ph * 32;
        f32x4 Sacc[2] = {(f32x4){0.f, 0.f, 0.f, 0.f}, (f32x4){0.f, 0.f, 0.f, 0.f}};
        for (int i = tid; i < 32 * 136 / 2; i += 512) ((LAS unsigned*)(lds + SD_SB))[i] = 0u;
        u32x4 pb[2][2], pc[2][2], px[2], pz[2]; float pdt[2] = {0.f, 0.f};
#pragma unroll
        for (int X = 0; X < 2; ++X) { px[X] = (u32x4){0u, 0u, 0u, 0u}; pz[X] = (u32x4){0u, 0u, 0u, 0u}; }
        const size_t trow0 = (size_t)b * SEQ;
        const bf16* XCp = ((const bf16*)(args.ws + WS_XC)); const bf16* PJ = ((const bf16*)(args.ws + WS_A)); const float* DTp = ((const float*)(args.ws + WS_DT));
        bf16* HBp = ((bf16*)(args.ws + WS_HB)); float* SQp = ((float*)(args.ws + WS_SSQ));
#define SSD_LOAD(cc, X) do { const size_t t0_ = trow0 + (size_t)(cc) * 64; \
            _Pragma("unroll") for (int k = 0; k < 2; ++k) { const int i_ = tid + 512 * k; pb[X][k] = *(const u32x4*)(XCp + (t0_ + (i_ >> 4)) * D + b_col + 8 * (i_ & 15)); pc[X][k] = *(const u32x4*)(XCp + (t0_ + (i_ >> 4)) * D + c_col + 8 * (i_ & 15)); } \
            if (wave < 4) { px[X] = *(const u32x4*)(XCp + (t0_ + (tid >> 2)) * D + xs_col + 8 * (tid & 3)); pz[X] = *(const u32x4*)(PJ + pj(t0_ + (tid >> 2), z_col + 8 * (tid & 3))); } \
            if (wave == 7) pdt[X] = DTp[(t0_ + lane) * 8 + h]; } while (0)
#define SSD_AUX(slot, X) do { if (wave == 7) { float a_ = pdt[X] * Ah; DPP_SHR_ADD(a_, 1); DPP_SHR_ADD(a_, 2); DPP_SHR_ADD(a_, 4); DPP_SHR_ADD(a_, 8); \
                const float r0_ = __int_as_float(__builtin_amdgcn_readlane(__float_as_int(a_), 15)), r1_ = __int_as_float(__builtin_amdgcn_readlane(__float_as_int(a_), 31)), r2_ = __int_as_float(__builtin_amdgcn_readlane(__float_as_int(a_), 47)); \
                a_ += (fq == 1) ? r0_ : (fq == 2) ? (r0_ + r1_) : (fq == 3) ? ((r0_ + r1_) + r2_) : 0.f; \
                ((LAS float*)(lds + SD_ACS))[(slot) * 64 + lane] = a_; ((LAS float*)(lds + SD_DTS))[(slot) * 64 + lane] = pdt[X]; } } while (0)
#define SSD_TILES(ts, X, slot) do { LAS unsigned char* tb_ = lds + (ts) * SD_SET; \
            _Pragma("unroll") for (int k = 0; k < 2; ++k) { const int i_ = tid + 512 * k; *(LAS u32x4*)(tb_ + SD_BM + ((i_ >> 4) * 136 + 8 * (i_ & 15)) * 2) = pb[X][k]; *(LAS u32x4*)(tb_ + SD_CM + ((i_ >> 4) * 136 + 8 * (i_ & 15)) * 2) = pc[X][k]; } \
            if (wave < 4) { const int l_ = tid >> 2, q_ = tid & 3; const LAS float* A_ = (const LAS float*)(lds + SD_ACS) + (slot) * 64; \
                *(LAS u32x4*)(tb_ + SD_XS + (l_ * 40 + 8 * q_) * 2) = px[X]; *(LAS u32x4*)(tb_ + SD_ZR + (l_ * 40 + 8 * q_) * 2) = pz[X]; \
                float f_[8], fd_[8]; unpack8(px[X], f_); const float dt_ = ((const LAS float*)(lds + SD_DTS))[(slot) * 64 + l_], dd_ = dt_ * __expf(A_[63] - A_[l_]); \
                _Pragma("unroll") for (int e = 0; e < 8; ++e) { fd_[e] = f_[e] * dd_; f_[e] *= dt_; } \
                *(LAS u32x4*)(tb_ + SD_DX + (l_ * 40 + 8 * q_) * 2) = pack8(f_); *(LAS u32x4*)(tb_ + SD_DXD + (l_ * 40 + 8 * q_) * 2) = pack8(fd_); } } while (0)
#define SSD_W(ts, slot) do { const LAS unsigned char* tb_ = lds + (ts) * SD_SET; const LAS float* A_ = (const LAS float*)(lds + SD_ACS) + (slot) * 64; \
            _Pragma("unroll") for (int jt = 0; jt < 2; ++jt) { const int id_ = 2 * wave + jt, lt_ = id_ >> 2, st_ = id_ & 3; f32x4 acc_ = (f32x4){0.f, 0.f, 0.f, 0.f}; \
                if (st_ <= lt_) { _Pragma("unroll") for (int kk = 0; kk < 4; ++kk) { const bf16x8 a_ = *(const LAS bf16x8*)(tb_ + SD_BM + ((st_ * 16 + fr) * 136 + kk * 32 + fq * 8) * 2); const bf16x8 b_ = *(const LAS bf16x8*)(tb_ + SD_CM + ((lt_ * 16 + fr) * 136 + kk * 32 + fq * 8) * 2); \
                        acc_ = __builtin_amdgcn_mfma_f32_16x16x32_bf16(a_, b_, acc_, 0, 0, 0); } } \
                const int l_ = lt_ * 16 + fr, s0_ = st_ * 16 + 4 * fq; const float al_ = A_[l_]; float w_[4]; const f32x4 as_ = *(const LAS f32x4*)(A_ + s0_);     \
                _Pragma("unroll") for (int r = 0; r < 4; ++r) { const int s_ = s0_ + r; const float e_ = acc_[r] * __expf(fminf(al_ - as_[r], 0.f)); w_[r] = (s_ <= l_) ? e_ : 0.f; } \
                u32x2 o_; o_.x = cvt_pk_bf16(w_[0], w_[1]); o_.y = cvt_pk_bf16(w_[2], w_[3]); *(LAS u32x2*)(lds + SD_WM + (ts) * 9216 + (l_ * 72 + s0_) * 2) = o_; } } while (0)
        SSD_LOAD(0, 0); SSD_LOAD(1, 1);
        SSD_AUX(0, 0); SSD_AUX(1, 1);
        WG_BAR();
        SSD_TILES(0, 0, 0);
        SSD_LOAD(2, 0);
        WG_BAR();
        SSD_W(0, 0);
        WG_BAR();
        int a0 = 0, a1 = 1, a2 = 2;
        u32x2 ypk = (u32x2){0u, 0u}; float yq = 0.f;
        for (int c2 = 0; c2 < 64; c2 += 2) {
#pragma unroll
        for (int par = 0; par < 2; ++par) {
            const int c = c2 + par; const size_t t0 = trow0 + (size_t)c * 64;
            const LAS unsigned char* tb = lds + par * SD_SET; const LAS float* ACS = (const LAS float*)(lds + SD_ACS) + a0 * 64;
            if (c + 1 < 64) SSD_TILES(par ^ 1, par ^ 1, a1);
            if (c + 2 < 64) SSD_AUX(a2, par);
            if (c > 0) { const int lt_ = wave >> 1, pt_ = wave & 1, l_ = lt_ * 16 + fr, p0_ = pt_ * 16 + 4 * fq; const size_t tp_ = t0 - 64;
                if (fq == 0) SQp[(size_t)((h * 2 + ph) * 2 + pt_) * T + tp_ + l_] = yq;
                *(u32x2*)(HBp + (tp_ + l_) * D + xs_col + p0_) = ypk; }
            if (c + 3 < 64) SSD_LOAD(c + 3, par ^ 1);
            const int lt = wave >> 1, pt = wave & 1, l = lt * 16 + fr, p0 = pt * 16 + 4 * fq;
            f32x4 yd = (f32x4){0.f, 0.f, 0.f, 0.f}, yo = (f32x4){0.f, 0.f, 0.f, 0.f};
#pragma unroll
            for (int kk = 0; kk < 2; ++kk) { const bf16x8 a = lds_tr8(tb + SD_DX + ((kk * 32 + 8 * fq + tq) * 40 + pt * 16 + 4 * tp) * 2, 4 * 80);
                const bf16x8 bb = *(const LAS bf16x8*)(lds + SD_WM + par * 9216 + ((lt * 16 + fr) * 72 + kk * 32 + fq * 8) * 2);
                yd = __builtin_amdgcn_mfma_f32_16x16x32_bf16(a, bb, yd, 0, 0, 0); }
#pragma unroll
            for (int kk = 0; kk < 4; ++kk) { const bf16x8 a = *(const LAS bf16x8*)(lds + SD_SB + ((pt * 16 + fr) * 136 + kk * 32 + fq * 8) * 2); const bf16x8 bb = *(const LAS bf16x8*)(tb + SD_CM + ((lt * 16 + fr) * 136 + kk * 32 + fq * 8) * 2);
                yo = __builtin_amdgcn_mfma_f32_16x16x32_bf16(a, bb, yo, 0, 0, 0); }
            const u32x2 xw = *(const LAS u32x2*)(tb + SD_XS + (l * 40 + p0) * 2), zw = *(const LAS u32x2*)(tb + SD_ZR + (l * 40 + p0) * 2);
            const float el = __expf(ACS[l]), cd = __expf(ACS[63]);
#pragma unroll
            for (int jt = 0; jt < 2; ++jt) { const int id = 2 * wave + jt, nt = id >> 1, pt2 = id & 1;
                Sacc[jt] = Sacc[jt] * cd;
#pragma unroll
                for (int kk = 0; kk < 2; ++kk) { const bf16x8 a = lds_tr8(tb + SD_BM + ((kk * 32 + 8 * fq + tq) * 136 + nt * 16 + 4 * tp) * 2, 4 * 272);
                    const bf16x8 bb = lds_tr8(tb + SD_DXD + ((kk * 32 + 8 * fq + tq) * 40 + pt2 * 16 + 4 * tp) * 2, 4 * 80);
                    Sacc[jt] = __builtin_amdgcn_mfma_f32_16x16x32_bf16(a, bb, Sacc[jt], 0, 0, 0); } }
            WG_BAR();
            {
                const float xs[4] = {bflo(xw.x), bfhi(xw.x), bflo(xw.y), bfhi(xw.y)}, zz[4] = {bflo(zw.x), bfhi(zw.x), bflo(zw.y), bfhi(zw.y)};
                float y[4], q2 = 0.f;
#pragma unroll
                for (int r = 0; r < 4; ++r) { y[r] = (yd[r] + el * yo[r] + Dh * xs[r]) * silu_f(zz[r]); q2 += y[r] * y[r]; }
                q2 += __shfl_xor(q2, 16); q2 += __shfl_xor(q2, 32);
                yq = q2; ypk.x = cvt_pk_bf16(y[0], y[1]); ypk.y = cvt_pk_bf16(y[2], y[3]);
            }
#pragma unroll
            for (int jt = 0; jt < 2; ++jt) { const int id = 2 * wave + jt, nt = id >> 1, pt2 = id & 1;
                u32x2 o; o.x = cvt_pk_bf16(Sacc[jt][0], Sacc[jt][1]); o.y = cvt_pk_bf16(Sacc[jt][2], Sacc[jt][3]);
                *(LAS u32x2*)(lds + SD_SB + ((pt2 * 16 + fr) * 136 + nt * 16 + 4 * fq) * 2) = o; }
            if (c + 1 < 64) SSD_W(par ^ 1, a1);
            WG_BAR();
            { const int t_ = a0; a0 = a1; a1 = a2; a2 = t_; }
        }
        }
#undef SSD_LOAD
#undef SSD_AUX
#undef SSD_TILES
#undef SSD_W
        { const int lt_ = wave >> 1, pt_ = wave & 1, l_ = lt_ * 16 + fr, p0_ = pt_ * 16 + 4 * fq; const size_t tp_ = trow0 + (size_t)63 * 64;
            if (fq == 0) SQp[(size_t)((h * 2 + ph) * 2 + pt_) * T + tp_ + l_] = yq;
            *(u32x2*)(HBp + (tp_ + l_) * D + xs_col + p0_) = ypk; }
        WG_BAR();
    }
}

__device__ __forceinline__ void p1_router_weights(const Frame& F_, CArgs& args_) {
    Frame F = F_; F.lane = lane_id_asm(); F.tid = F.wave * 64 + F.lane;
    ARGS_LAUNDER(args_);
    LAS float* red = (LAS float*)F.lds;
    for (int w = F.vcu; w < 256; w += F.G) {
        const int b = w >> 4, e0 = 4 * (w & 15); float bs[4] = {0.f, 0.f, 0.f, 0.f};
        const float* mod = (const float*)(args.ws + WS_MOD) + b * 6144;
#pragma unroll
        for (int kk = 0; kk < 2; ++kk) { const int k = F.tid + 512 * kk; const f32x4 wv = *(const f32x4*)((args.in[15]) + (size_t)k * 64 + e0);
            const float sc = (args.in[14])[k] * (1.0f + mod[4096 + k]), sh = mod[3072 + k];
#pragma unroll
            for (int j = 0; j < 4; ++j) { ((bf16*)(args.ws + WS_WR))[((size_t)b * 64 + e0 + j) * 1024 + k] = f2bf(wv[j] * sc); bs[j] += sh * wv[j]; } }
#pragma unroll
        for (int j = 0; j < 4; ++j) bs[j] = wave_sum(bs[j]);
        if (F.lane == 0) { red[F.wave * 4 + 0] = bs[0]; red[F.wave * 4 + 1] = bs[1]; red[F.wave * 4 + 2] = bs[2]; red[F.wave * 4 + 3] = bs[3]; }
        WG_BAR();
        if (F.tid < 4) { float s = 0.f;
#pragma unroll
            for (int q = 0; q < 8; ++q) s += red[q * 4 + F.tid];
            ((float*)(args.ws + WS_RB))[b * 64 + e0 + F.tid] = s; }
        WG_BAR();
    }
}
constexpr int RT_WST = 1032;
constexpr int RT_LOG = 0, RT_CNT = 65536, RT_BASE = 65536 + 256, RT_LE = 66560, RT_LW = 66560 + 8192;
constexpr int RT_RS = RT_LW + 8192;
static_assert(64 * RT_WST * 2 <= MISC_OFF && RT_RS + 1024 <= MISC_OFF, "router LDS map");
__device__ __forceinline__ void p7_router(const Frame& F_, CArgs& args_) {
    Frame F = F_; F.lane = lane_id_asm(); F.tid = F.wave * 64 + F.lane;
    ARGS_LAUNDER(args_);
    LAS unsigned char* lds = F.lds; const int tid = F.tid, lane = F.lane, wave = F.wave, fr = lane & 15, fq = lane >> 4;
    LAS int* lcnt = (LAS int*)(lds + RT_CNT); LAS int* lbase = (LAS int*)(lds + RT_BASE);
    LAS unsigned* le = (LAS unsigned*)(lds + RT_LE); LAS float* lw = (LAS float*)(lds + RT_LW);
    const float bias = (args.in[16])[lane];
    for (int tile = F.vcu; tile < T / 256; tile += F.G) {
        const int s = (tile * 256) / TS, b = (tile * 256) / SEQ;
        { const u32x4* wsrc = (const u32x4*)((const bf16*)(args.ws + WS_WR) + (size_t)b * 64 * 1024);
          u32x4 wt[16];
#pragma unroll
          for (int j = 0; j < 16; ++j) wt[j] = wsrc[tid + 512 * j];
#pragma unroll
          for (int j = 0; j < 16; ++j) { const int i = tid + 512 * j, e = i >> 7, c = i & 127; *(LAS u32x4*)(lds + (e * RT_WST + 8 * c) * 2) = wt[j]; } }
        WG_BAR();
        const bf16* xb = (const bf16*)(args.ws + WS_X1) + (size_t)(tile * 256 + wave * 32) * D;
        f32x4 acc[2][4]; float ssq[2] = {0.f, 0.f};
#pragma unroll
        for (int g = 0; g < 2; ++g)
#pragma unroll
            for (int n = 0; n < 4; ++n) acc[g][n] = (f32x4){0.f, 0.f, 0.f, 0.f};
        constexpr int XG = 2;
        u32x4 xs0[XG][2], xs1[XG][2], xs2[XG][2], xs3[XG][2];
#define RT_XLOAD(dst, k0_) do { _Pragma("unroll") for (int q = 0; q < XG; ++q) _Pragma("unroll") for (int g = 0; g < 2; ++g) dst[q][g] = *(const u32x4*)(xb + (size_t)(16 * g + fr) * D + 32 * ((k0_) + q) + 8 * fq); } while (0)
#define RT_XMMA(srcx, k0_) do { _Pragma("unroll") for (int q = 0; q < XG; ++q) { const int ks = (k0_) + q; bf16x8 bfr[2]; \
            _Pragma("unroll") for (int g = 0; g < 2; ++g) { const u32x4 xv = srcx[q][g]; bfr[g] = __builtin_bit_cast(bf16x8, xv); float f[8]; unpack8(xv, f); _Pragma("unroll") for (int j = 0; j < 8; ++j) ssq[g] += f[j] * f[j]; } \
            _Pragma("unroll") for (int n = 0; n < 4; ++n) { const bf16x8 afr = *(const LAS bf16x8*)(lds + ((16 * n + fr) * RT_WST + 32 * ks + 8 * fq) * 2); \
                _Pragma("unroll") for (int g = 0; g < 2; ++g) acc[g][n] = __builtin_amdgcn_mfma_f32_16x16x32_bf16(afr, bfr[g], acc[g][n], 0, 0, 0); } } } while (0)
        RT_XLOAD(xs0, 0); RT_XLOAD(xs1, XG); RT_XLOAD(xs2, 2 * XG); RT_XLOAD(xs3, 3 * XG);
#pragma unroll 1
        for (int k0 = 0; k0 < 32; k0 += 4 * XG) {
            const int kn = k0 + 4 * XG < 32 ? k0 + 4 * XG : k0;
            RT_XMMA(xs0, k0);          RT_XLOAD(xs0, kn);
            RT_XMMA(xs1, k0 + XG);     RT_XLOAD(xs1, kn + XG);
            RT_XMMA(xs2, k0 + 2 * XG); RT_XLOAD(xs2, kn + 2 * XG);
            RT_XMMA(xs3, k0 + 3 * XG); RT_XLOAD(xs3, kn + 3 * XG);
        }
#undef RT_XLOAD
#undef RT_XMMA
        WG_BAR();
        if (tid < 64) lcnt[tid] = 0;
#pragma unroll
        for (int g = 0; g < 2; ++g) { float q = ssq[g]; q += __shfl_xor(q, 16); q += __shfl_xor(q, 32); const float rstd = rsqrtf(q * (1.0f / D) + EPS);
            if (fq == 0) *(LAS float*)(lds + RT_RS + (wave * 32 + 16 * g + fr) * 4) = rstd;
#pragma unroll
            for (int n = 0; n < 4; ++n) { const f32x4 rb = *(const f32x4*)((const float*)(args.ws + WS_RB) + b * 64 + 16 * n + 4 * fq);
                *(LAS f32x4*)(lds + RT_LOG + ((wave * 32 + 16 * g + fr) * 64 + 16 * n + 4 * fq) * 4) = acc[g][n] * rstd + rb; } }
        WG_BAR();
        f32x4 hsc[4], hsh[4];
#pragma unroll
        for (int j = 0; j < 4; ++j) { const int col = 16 * lane + 4 * j; const float* mod = (const float*)(args.ws + WS_MOD) + b * 6144;
            hsc[j] = *(const f32x4*)((args.in[14]) + col) * (*(const f32x4*)(mod + 4096 + col) + 1.0f); hsh[j] = *(const f32x4*)(mod + 3072 + col); }
        const bf16* xrow = (const bf16*)(args.ws + WS_X1) + (size_t)(tile * 256 + wave * 32) * D + 16 * lane;
        unsigned char* hrow = (unsigned char*)(args.ws + WS_H8) + (size_t)(tile * 256 + wave * 32) * D + 16 * lane;
        u32x4 xn0 = *(const u32x4*)(xrow), xn1 = *(const u32x4*)(xrow + 8);
#pragma unroll 2
        for (int i = 0; i < 32; ++i) {
            const int tl = wave * 32 + i;
            const u32x4 xc0 = xn0, xc1 = xn1;
            if (i + 1 < 32) { xn0 = *(const u32x4*)(xrow + (size_t)(i + 1) * D); xn1 = *(const u32x4*)(xrow + (size_t)(i + 1) * D + 8); }
            { const float rs = *(const LAS float*)(lds + RT_RS + tl * 4); float f[16]; { float t8[8]; unpack8(xc0, t8);
#pragma unroll
                for (int j = 0; j < 8; ++j) f[j] = t8[j]; unpack8(xc1, t8);
#pragma unroll
                for (int j = 0; j < 8; ++j) f[8 + j] = t8[j]; }
                u32x4 hw; unsigned hv[4];
#pragma unroll
                for (int j = 0; j < 4; ++j) { const f32x4 h = (f32x4){f[4 * j], f[4 * j + 1], f[4 * j + 2], f[4 * j + 3]} * rs * hsc[j] + hsh[j];
                    int q8 = __builtin_amdgcn_cvt_pk_fp8_f32(h.x, h.y, 0, false); q8 = __builtin_amdgcn_cvt_pk_fp8_f32(h.z, h.w, q8, true); hv[j] = (unsigned)q8; }
                hw.x = hv[0]; hw.y = hv[1]; hw.z = hv[2]; hw.w = hv[3];
                *(u32x4*)(hrow + (size_t)i * D) = hw; }
            const float logit = *(const LAS float*)(lds + RT_LOG + (tl * 64 + lane) * 4);
            const float score = __builtin_amdgcn_rcpf(1.0f + __expf(-logit)), sel = score + bias;
            const float m1 = max8(sel);
            const unsigned long long eq = __ballot(sel == m1);
            const unsigned gm = (unsigned)(eq >> (lane & 56)) & 0xffu;
            const int first = gm ? __builtin_ctz(gm) : 0;
            const float m2 = max8(((lane & 7) == first) ? -INFINITY : sel);
            const float gs = m1 + m2; const int g = lane >> 3; int grank = 0;
            const unsigned ghi = f32_key(gs); const unsigned long long gme = ((unsigned long long)ghi << 32) | (unsigned)(7 - g);
#pragma unroll
            for (int j = 0; j < 8; ++j) { const unsigned long long go = ((unsigned long long)(unsigned)__builtin_amdgcn_readlane((int)ghi, 8 * j) << 32) | (unsigned)(7 - j); grank += (go > gme) ? 1 : 0; }
            const bool gsel = grank < 4; const unsigned long long gmask = __ballot(gsel);
            int rank = 0;
            const unsigned khi = f32_key(sel); const unsigned long long kme = ((unsigned long long)khi << 32) | (unsigned)(63 - lane);
#pragma unroll
            for (int j = 0; j < 8; ++j) if ((gmask >> (8 * j)) & 1ull) {
#pragma unroll
                for (int i = 0; i < 8; ++i) { const unsigned long long ko = ((unsigned long long)(unsigned)__builtin_amdgcn_readlane((int)khi, 8 * j + i) << 32) | (unsigned)(63 - (8 * j + i)); rank += (ko > kme) ? 1 : 0; } }
            const bool chosen = gsel && rank < TOPK;
            const float wsum = wave_sum(chosen ? score : 0.f);
            if (chosen) { const int pos = __hip_atomic_fetch_add(lcnt + lane, 1, __ATOMIC_RELAXED, __HIP_MEMORY_SCOPE_WORKGROUP);
                le[tl * 8 + rank] = (unsigned)lane | ((unsigned)pos << 8); lw[tl * 8 + rank] = score / wsum * 2.5f; }
        }
        WG_BAR();
        if (tid < 64) lbase[tid] = (int)__hip_atomic_fetch_add(((unsigned*)(args.ws + WS_CTL) + CW_CNT) + s * 80 + tid, (unsigned)lcnt[tid], RLX_AGENT);
        WG_BAR();
        for (int idx = tid; idx < 2048; idx += 512) { const unsigned v = le[idx]; const int e = v & 0xffu; const size_t o = (size_t)tile * 2048 + idx;
            const int pos = (int)(v >> 8) + lbase[e]; ((int*)(args.ws + WS_IDX))[o] = e; ((int*)(args.ws + WS_APOS))[o] = pos; ((float*)(args.ws + WS_WGT))[o] = lw[idx];
            ((int*)(args.ws + WS_LIST))[(size_t)e * T + pos] = tile * 256 + (idx >> 3); }
        WG_BAR();
    }
}
__device__ __forceinline__ void load_eoff(const Frame& F_, CArgs& args_) {
    Frame F = F_; F.lane = lane_id_asm(); F.tid = F.wave * 64 + F.lane;
    ARGS_LAUNDER(args_);
    LAS int* eoff = (LAS int*)(F.lds + EO_OFF); LAS int* ecnt = (LAS int*)(F.lds + EC_OFF);
    if (F.tid < S_SB) { const int s = F.tid; int acc = 0;
        for (int e = 0; e < NEX; ++e) { const int cnt = e < NE ? (int)((unsigned*)(args.ws + WS_CTL) + CW_CNT)[s * 80 + e] : TS; eoff[s * 72 + e] = acc; ecnt[s * 72 + e] = cnt; acc += (cnt + 255) & ~255; }
        eoff[s * 72 + NEX] = acc; }
    WG_BAR();
}
__device__ __forceinline__ int moe_tables(const Frame& F_, CArgs& args_, int s, bool gather) {
    Frame F = F_; F.lane = lane_id_asm(); F.tid = F.wave * 64 + F.lane;
    ARGS_LAUNDER(args_);
    asm volatile("" : "+s"(s));
    const LAS int* eoff = (const LAS int*)(F.lds + EO_OFF) + s * 72;
    LAS unsigned char* te = F.lds + TE_OFF;
    const int NT = eoff[NEX] >> 8;
    for (int e = F.wave; e < NEX; e += 8) { const int t0 = eoff[e] >> 8, t1 = eoff[e + 1] >> 8; for (int t = t0 + F.lane; t < t1; t += 64) te[t] = (unsigned char)e; }
    WG_BAR();
    if (gather) { LAS unsigned* tab = (LAS unsigned*)(F.lds + TAB_OFF);
        int nsl = (2 * NT - F.vcu + F.G - 1) / F.G; nsl = nsl < 0 ? 0 : (nsl > TAB_SLOTS ? TAB_SLOTS : nsl);
        const int nent = nsl * 256; const int* LISTp = (const int*)(args.ws + WS_LIST);
#pragma unroll 1
        for (int base = 0; base < nent; base += 2048) {
            int tokv[4], dflt[4]; bool fromlist[4];
#pragma unroll
            for (int j = 0; j < 4; ++j) { int idx = base + j * 512 + F.tid; idx = idx < nent ? idx : nent - 1; const int i = idx >> 8, r = idx & 255, rt = (i * F.G + F.vcu) >> 1;
                const int e = te[rt], pos = rt * 256 - eoff[e] + r;
                fromlist[j] = e < NE && pos < ((const LAS int*)(F.lds + EC_OFF))[s * 72 + e]; dflt[j] = e < NE ? 0 : s * TS + pos;
                tokv[j] = LISTp[fromlist[j] ? (size_t)e * T + pos : (size_t)0]; }
#pragma unroll
            for (int j = 0; j < 4; ++j) { const int idx = base + j * 512 + F.tid; if (idx < nent) tab[idx] = (unsigned)(fromlist[j] ? tokv[j] : dflt[j]) * 1024u; }
        } }
    WG_BAR();
    return NT;
}
__device__ __forceinline__ void pc_combine(const Frame& F_, CArgs& args_, int s) {
    Frame F = F_; F.lane = lane_id_asm(); F.tid = F.wave * 64 + F.lane;
    ARGS_LAUNDER(args_);
    asm volatile("" : "+s"(s));
    const LAS int* eoff = (const LAS int*)(F.lds + EO_OFF) + s * 72;
    const int shoff = eoff[NE];
    const int gw = F.vcu * 8 + F.wave, NGW = F.G * 8, lane = F.lane;
    constexpr int PER = 16;
    const unsigned char* Y8 = (const unsigned char*)(args.ws + WS_A); const bf16* x1b = (const bf16*)(args.ws + WS_X1);
    for (int blk = gw; blk < TS / PER; blk += NGW) {
        const int tl0 = blk * PER, b = (s * TS + tl0) / SEQ;
        f32x4 g2[4], nf[4];
#pragma unroll
        for (int i = 0; i < 4; ++i) { const int col = 256 * i + 4 * lane; g2[i] = *(const f32x4*)(((float*)(args.ws + WS_MOD)) + b * 6144 + 5120 + col); nf[i] = *(const f32x4*)((args.in[23]) + col); }
#pragma unroll 2
        for (int r = 0; r < PER; ++r) {
            const int tl = tl0 + r, t = s * TS + tl;
            f32x4 acc[4];
#pragma unroll
            for (int i = 0; i < 4; ++i) acc[i] = (f32x4){0.f, 0.f, 0.f, 0.f};
#pragma unroll
            for (int k = 0; k < 9; ++k) {
                const int row = k < 8 ? eoff[((int*)(args.ws + WS_IDX))[(size_t)t * 8 + k]] + ((int*)(args.ws + WS_APOS))[(size_t)t * 8 + k] : shoff + tl; const float w = (k < 8 ? ((float*)(args.ws + WS_WGT))[(size_t)t * 8 + k] : 1.0f) * (1.0f / 16.0f);
                unsigned yw[4];
#pragma unroll
                for (int i = 0; i < 4; ++i) yw[i] = *(const unsigned*)(Y8 + (size_t)row * D + 256 * i + 4 * lane);
#pragma unroll
                for (int i = 0; i < 4; ++i) { const f32x2 lo = __builtin_amdgcn_cvt_pk_f32_fp8((int)yw[i], false), hi = __builtin_amdgcn_cvt_pk_f32_fp8((int)yw[i], true);
                    acc[i] = acc[i] + (f32x4){lo.x, lo.y, hi.x, hi.y} * w; }
            }
            float* orow = (args.out) + (size_t)t * D + 4 * lane; float ss = 0.f; f32x4 xf[4];
#pragma unroll
            for (int i = 0; i < 4; ++i) { const u32x2 xw = *(const u32x2*)(x1b + (size_t)t * D + 256 * i + 4 * lane); const f32x4 x1 = (f32x4){bflo(xw.x), bfhi(xw.x), bflo(xw.y), bfhi(xw.y)}; const f32x4 v = x1 + g2[i] * acc[i]; xf[i] = v; ss += (v.x * v.x + v.y * v.y) + (v.z * v.z + v.w * v.w); }
            const float rstd = rsqrtf(wave_sum(ss) * (1.0f / D) + EPS);
#pragma unroll
            for (int i = 0; i < 4; ++i) *(f32x4*)(orow + 256 * i) = xf[i] * rstd * nf[i];
        }
    }
}

__device__ __forceinline__ void stagger(int quanta) { const int j = ((int)blockIdx.x >> 3) & 7; for (int i = 0; i < j * quanta; ++i) __builtin_amdgcn_s_sleep(16); }

constexpr int NPH = 10 + 3 * S_SB;
__global__ void __launch_bounds__(512, 2) fwd_kernel(Args args_k) {
    CArgs& kargs = *(CArgs*)__builtin_amdgcn_kernarg_segment_ptr();
    extern __shared__ __attribute__((aligned(16))) unsigned char lds_raw[];
    Frame F;
    F.lds = (LAS unsigned char*)lds_raw; F.MISC = (volatile LAS unsigned*)(F.lds + MISC_OFF);
    F.wave = __builtin_amdgcn_readfirstlane((int)threadIdx.x >> 6); F.lane = 0; F.tid = 0;
    F.G = gridDim.x; { const int bx = blockIdx.x; F.vcu = (F.G % 8 == 0) ? (bx % 8) * (F.G / 8) + bx / 8 : bx; }
    F.ctl = (unsigned*)(kargs.ws + WS_CTL);
    if (threadIdx.x < 64) ((LAS unsigned*)(F.lds + MISC_OFF))[threadIdx.x] = 0u;
    __syncthreads();
    XcdBarrier bar; bar.bar = F.ctl + CW_BAR; bar.x = 0; bar.st = nullptr;
    if (!MK_PER_PHASE) bar = xcd_barrier_post(F.ctl + CW_BAR, F.MISC);
    const int lo = MK_PER_PHASE ? kargs.ph_lo : 0, hi = MK_PER_PHASE ? kargs.ph_hi : NPH;
#ifndef PH_ENABLE
#define PH_ENABLE 0xffffffffu
#endif
#define IN(k) (((PH_ENABLE >> ((k) > 9 ? 10 + ((k) - 10) % 3 : (k))) & 1u) && lo <= (k) && (k) < hi)
#ifndef DUP_MASK
#define DUP_MASK 0u
#endif
#define REPEAT(k) _Pragma("unroll 1") for (int rep_ = 0; rep_ < 1 + (int)((DUP_MASK >> (k)) & 1u); ++rep_)
#define SEAM(k) do { if (!MK_PER_PHASE && IN(k) && IN((k) + 1)) xcd_barrier(bar, F.wave); } while (0)

    if (IN(0)) { REPEAT(0) { p0_prologue(F, kargs); } SEAM(0); }
    if (IN(1)) { ARGS_LAUNDER(kargs); p1_router_weights(F, kargs); REPEAT(1) { p_norm_mod<true, false>(F, kargs, (args.in[0]), (args.in[4]), 0, 1024, ((bf16*)(args.ws + WS_HB)), nullptr); } SEAM(1); }
    if (IN(2)) { ARGS_LAUNDER(kargs);
        pg8::PlainOrder S; S.init(((bf16*)(args.ws + WS_HB)), ((bf16*)(args.ws + WS_WIN)), T, NPROJ, D, F.G, (int)blockIdx.x); pg8::EpiBf16T E{((bf16*)(args.ws + WS_A)), NPROJ / 256};
        stagger(STG_P2); REPEAT(2) { pg8::gemm_phase<pg8::EpiBf16T, pg8::PlainOrder, true, false, true>(F.lds, F.wave, D, S, E); } SEAM(2); }
    if (IN(3)) { REPEAT(3) { p3_conv(F, kargs); } SEAM(3); }
    if (IN(4)) { REPEAT(4) { p4_ssd(F, kargs); } SEAM(4); }
    if (IN(5)) { ARGS_LAUNDER(kargs);
        pg8::PlainOrder S; S.init(((bf16*)(args.ws + WS_HB)), ((bf16*)(args.ws + WS_WOUT)), T, D, D, F.G, (int)blockIdx.x);
        {
            const int lane = lane_id_asm(), tid = F.wave * 64 + lane, r = tid & 255, hf = tid >> 8;
            LAS float* rstab = (LAS float*)(F.lds + TAB_OFF); LAS float* tmp = (LAS float*)(F.lds);
            pg8::Unit u;
            for (int i0 = 0; i0 < 16; i0 += 4) {
                float sv[4]; bool ok[4]; float pv[4][16];
#pragma unroll
                for (int j = 0; j < 4; ++j) { ok[j] = S.next(i0 + j, u); const int pm = ok[j] ? u.pm : 0;
                    const float* sp = ((const float*)(args.ws + WS_SSQ)) + (size_t)(16 * hf) * T + pm * 256 + r;
#pragma unroll
                    for (int q = 0; q < 16; ++q) pv[j][q] = sp[(size_t)q * T]; }
#pragma unroll
                for (int j = 0; j < 4; ++j) { float s = 0.f;
#pragma unroll
                    for (int q = 0; q < 16; ++q) s += pv[j][q];
                    sv[j] = s; if (hf) tmp[j * 256 + r] = s; }
                WG_BAR();
#pragma unroll
                for (int j = 0; j < 4; ++j) if (!hf && ok[j]) rstab[(i0 + j) * 256 + r] = rsqrtf((sv[j] + tmp[j * 256 + r]) * (1.0f / 512.0f) + EPS);
                WG_BAR();
                if (!ok[3]) break;
            }
        }
        pg8::EpiX1 E{(args.in[0]), (bf16*)(args.ws + WS_X1), ((float*)(args.ws + WS_MOD)) + 2048, (const LAS float*)(F.lds + TAB_OFF)};
        stagger(STG_P5); REPEAT(5) { pg8::gemm_phase<pg8::EpiX1, pg8::PlainOrder, false>(F.lds, F.wave, D, S, E); } SEAM(5); }
    if (IN(6)) { p7_router(F, kargs); SEAM(9); }
    load_eoff(F, kargs);
    for (int s = 0; s < S_SB; ++s) {
        const int k0 = 10 + 3 * s;
        if (IN(k0)) { ARGS_LAUNDER(kargs);
            const int NT = moe_tables(F, kargs, s, true);
            pg8::MoeOrder<1, true> S; S.NT = NT; S.G = F.G; S.c = F.vcu; S.A = (const char*)(args.ws + WS_H8); S.W = (const char*)(args.ws + WS_WGU); S.rowb = 0; S.w_exp = (size_t)512 * 1024; S.w_tile = (size_t)256 * 1024;
            S.te = F.lds + TE_OFF; S.tab = (const LAS unsigned*)(F.lds + TAB_OFF);
            pg8::EpiGU E{(unsigned char*)(args.ws + WS_HID)};
            stagger(STG_G); REPEAT(10) { pg8::gemm_phase<pg8::EpiGU, pg8::MoeOrder<1, true>, true, true>(F.lds, F.wave, D, S, E); } SEAM(k0); }
        if (IN(k0 + 1)) { ARGS_LAUNDER(kargs);
            const int NT = moe_tables(F, kargs, s, false);
            pg8::MoeOrder<2, false> S; S.NT = NT; S.G = F.G; S.c = F.vcu; S.A = (const char*)(args.ws + WS_HID); S.W = (const char*)(args.ws + WS_WD); S.rowb = 256u; S.w_exp = (size_t)1024 * 256; S.w_tile = (size_t)256 * 256;
            S.te = F.lds + TE_OFF; S.tab = (const LAS unsigned*)(F.lds + TAB_OFF);
            pg8::EpiFp8 E{(unsigned char*)(args.ws + WS_A), D, 1.0f};
            int Kd = 256; asm volatile("" : "+s"(Kd));
            stagger(STG_D); REPEAT(11) { pg8::gemm_phase<pg8::EpiFp8, pg8::MoeOrder<2, false>, true, true>(F.lds, F.wave, Kd, S, E); } SEAM(k0 + 1); }
        if (IN(k0 + 2)) { pc_combine(F, kargs, s); if (MK_PER_PHASE == 0 && s + 1 < S_SB) { asm volatile("s_waitcnt vmcnt(0)" ::: "memory"); __syncthreads(); } }
    }
#undef IN
#undef SEAM
}

extern "C" void kernel_launch(void* const* d_in, const int* in_sizes, int n_in, void* d_out, int out_size, void* d_ws, size_t ws_size, hipStream_t stream) {
    static int grid = 0;
    if (grid == 0) {
        if (n_in != 24 || in_sizes[0] != T * D || out_size != T * D || ws_size < WS_END) { fprintf(stderr, "kernel_launch: unexpected shapes / workspace (n_in %d, ws %zu, need %zu)\n", n_in, ws_size, (size_t)WS_END); grid = -1; return; }
        int dev = 0, cus = 0, per_cu = 0;
        if (hipGetDevice(&dev) != hipSuccess || hipDeviceGetAttribute(&cus, hipDeviceAttributeMultiprocessorCount, dev) != hipSuccess) { grid = -1; return; }
        if (hipFuncSetAttribute((const void*)fwd_kernel, hipFuncAttributeMaxDynamicSharedMemorySize, LDS_BYTES) != hipSuccess) { fprintf(stderr, "kernel_launch: hipFuncSetAttribute failed\n"); grid = -1; return; }
        if (hipOccupancyMaxActiveBlocksPerMultiprocessor(&per_cu, (const void*)fwd_kernel, 512, LDS_BYTES) != hipSuccess || per_cu < 1) fprintf(stderr, "kernel_launch: occupancy query says %d\n", per_cu);
        (void)hipGetLastError();
        grid = cus;
    }
    if (grid < 0) return;
    if (hipMemsetAsync((char*)d_ws + WS_CTL, 0, CTL_ZERO_BYTES, stream) != hipSuccess) return;
    Args a{};
    for (int i = 0; i < 24; ++i) a.in[i] = (const float*)d_in[i];
    a.out = (float*)d_out; a.ws = (unsigned char*)d_ws;
#if MK_PER_PHASE
    for (int p = 0; p < NPH; ++p) { a.ph_lo = p; a.ph_hi = p + 1; hipLaunchKernelGGL(fwd_kernel, dim3(grid), dim3(512), LDS_BYTES, stream, a); }
#else
    a.ph_lo = 0; a.ph_hi = NPH;
    hipLaunchKernelGGL(fwd_kernel, dim3(grid), dim3(512), LDS_BYTES, stream, a);
#endif
}
```

```cpp
#include <hip/hip_runtime.h>
#include <cstdio>
#include <cstdint>

#define LAS __attribute__((address_space(3)))
#define GAS __attribute__((address_space(1)))
typedef unsigned short bf16;
typedef short bf16x8 __attribute__((ext_vector_type(8)));
typedef float f32x4 __attribute__((ext_vector_type(4)));
typedef float f32x2 __attribute__((ext_vector_type(2)));
typedef unsigned u32x4 __attribute__((ext_vector_type(4)));
typedef unsigned u32x2 __attribute__((ext_vector_type(2)));

#define STG_P2 0
#define STG_P5 0
#define STG_G 0
#define STG_D 0
#ifndef MK_PER_PHASE
#define MK_PER_PHASE 0
#endif

constexpr int T = 65536, D = 1024, SEQ = 4096, NB = 16;
constexpr int NPROJ = 3072, LDWIN = 3080;
constexpr int C_CB = 0, C_CC = 512, C_CU = 1024, C_Z = 1536, C_XBC = 2048;
constexpr int NE = 64, NEX = 65, TOPK = 8;
constexpr int S_SB = 1, TS = T / S_SB;
constexpr int MAXT = (TS * 9) / 256 + 64;
constexpr int MAXROWS = MAXT * 256;
constexpr float EPS = 1e-6f;

constexpr size_t MiB = 1u << 20;
constexpr size_t WS_CTL = 0, CTL_ZERO_BYTES = 1 * MiB;
constexpr size_t WS_MOD = 128 * 1024;
constexpr size_t WS_WDT = 1 * MiB;
constexpr size_t WS_WIN = 2 * MiB, WS_WOUT = 8 * MiB, WS_WR = 10 * MiB;
constexpr size_t WS_RB = 1 * MiB + 64 * 1024;
constexpr size_t WS_WGU = 12 * MiB;
constexpr size_t WS_WD = 45 * MiB;
constexpr size_t WS_DT = 62 * MiB;
constexpr size_t WS_IDX = 64 * MiB, WS_WGT = 66 * MiB, WS_APOS = 68 * MiB, WS_ROWOF = 70 * MiB;
constexpr size_t WS_R2T = 72 * MiB;
constexpr size_t WS_HB = 76 * MiB;
constexpr size_t WS_HID = 76 * MiB;
constexpr size_t WS_A = 232 * MiB;
constexpr size_t WS_XC = 616 * MiB;
constexpr size_t WS_SSQ = 744 * MiB;
constexpr size_t WS_LOG = 752 * MiB;
constexpr size_t WS_H8 = 768 * MiB;
constexpr size_t WS_X1 = 832 * MiB;
constexpr size_t WS_LIST = 960 * MiB;
constexpr size_t WS_END = 976 * MiB;
static_assert(WS_WGU + (size_t)NEX * 512 * 1024 <= WS_WD && WS_WD + (size_t)NEX * 1024 * 256 <= WS_DT && WS_R2T + (size_t)S_SB * MAXROWS * 4 <= WS_HB && WS_HID + (size_t)MAXROWS * 256 <= WS_A && WS_HB + (size_t)T * D * 2 <= WS_A
              && WS_A + (size_t)T * NPROJ * 2 <= WS_XC && WS_A + (size_t)MAXROWS * 1024 <= WS_X1 && WS_XC + (size_t)T * D * 2 <= WS_SSQ && WS_SSQ + (size_t)32 * T * 4 <= WS_LOG && WS_LOG + (size_t)T * 64 * 4 <= WS_H8
              && WS_H8 + (size_t)T * D <= WS_X1 && WS_X1 + (size_t)T * D * 2 <= WS_LIST && WS_LIST + (size_t)NE * T * 4 <= WS_END, "ws map");
constexpr int CW_BAR = 4096;
constexpr int CW_CNT = 8192;

constexpr int RING_BYTES = 131072;
constexpr int TAB_SLOTS = 20;
constexpr int TAB_OFF = RING_BYTES, TAB_BYTES = TAB_SLOTS * 1024;
constexpr int TE_OFF = TAB_OFF + TAB_BYTES;
constexpr int EO_OFF = TE_OFF + ((MAXT + 63) / 64) * 64;
constexpr int EC_OFF = EO_OFF + S_SB * 72 * 4;
constexpr int MISC_OFF = EC_OFF + S_SB * 72 * 4;
constexpr int LDS_BYTES = ((MISC_OFF + 256 + 1023) / 1024) * 1024;
static_assert(LDS_BYTES <= 160 * 1024 && (2 * MAXT + 255) / 256 <= TAB_SLOTS, "LDS");

#define RLX_AGENT __ATOMIC_RELAXED, __HIP_MEMORY_SCOPE_AGENT
#define LDS_WAIT() asm volatile("s_waitcnt lgkmcnt(0)" ::: "memory")
#define WG_BAR() do { asm volatile("s_waitcnt lgkmcnt(0)" ::: "memory"); __builtin_amdgcn_s_barrier(); asm volatile("" ::: "memory"); } while (0)
__device__ __forceinline__ unsigned cvt_pk_bf16(float lo, float hi) { unsigned r; asm volatile("v_cvt_pk_bf16_f32 %0, %1, %2" : "=v"(r) : "v"(lo), "v"(hi)); return r; }
__device__ __forceinline__ float bflo(unsigned w) { return __uint_as_float(w << 16); }
__device__ __forceinline__ float bfhi(unsigned w) { return __uint_as_float(w & 0xffff0000u); }
__device__ __forceinline__ float bf2f(unsigned short h) { return __uint_as_float(((unsigned)h) << 16); }
__device__ __forceinline__ unsigned short f2bf(float f) { return (unsigned short)(cvt_pk_bf16(f, 0.f) & 0xffffu); }
__device__ __forceinline__ float silu_f(float x) { return x * __builtin_amdgcn_rcpf(1.0f + __expf(-x)); }
#define DPP_F(v, ctrl) __int_as_float(__builtin_amdgcn_update_dpp(0, __float_as_int(v), (ctrl), 0xf, 0xf, false))
__device__ __forceinline__ float wave_sum(float v) {
    v += DPP_F(v, 0xB1); v += DPP_F(v, 0x4E); v += DPP_F(v, 0x141); v += DPP_F(v, 0x140);
    const float r0 = __int_as_float(__builtin_amdgcn_readlane(__float_as_int(v), 0)), r1 = __int_as_float(__builtin_amdgcn_readlane(__float_as_int(v), 16)),
                r2 = __int_as_float(__builtin_amdgcn_readlane(__float_as_int(v), 32)), r3 = __int_as_float(__builtin_amdgcn_readlane(__float_as_int(v), 48));
    return (r0 + r1) + (r2 + r3);
}
__device__ __forceinline__ float max8(float v) {
    v = fmaxf(v, DPP_F(v, 0xB1)); v = fmaxf(v, DPP_F(v, 0x4E)); v = fmaxf(v, DPP_F(v, 0x141)); return v;
}
__device__ __forceinline__ unsigned f32_key(float f) { const unsigned b = __float_as_uint(f); return b ^ ((b >> 31) ? 0xffffffffu : 0x80000000u); }
__device__ __forceinline__ void unpack8(const u32x4 w, float (&f)[8]) {
    f[0] = bflo(w.x); f[1] = bfhi(w.x); f[2] = bflo(w.y); f[3] = bfhi(w.y); f[4] = bflo(w.z); f[5] = bfhi(w.z); f[6] = bflo(w.w); f[7] = bfhi(w.w);
}
__device__ __forceinline__ u32x4 pack8(const float (&f)[8]) {
    u32x4 w; w.x = cvt_pk_bf16(f[0], f[1]); w.y = cvt_pk_bf16(f[2], f[3]); w.z = cvt_pk_bf16(f[4], f[5]); w.w = cvt_pk_bf16(f[6], f[7]); return w;
}

__device__ __forceinline__ int lane_id_asm() { int l; asm volatile("v_mbcnt_lo_u32_b32 %0, -1, 0\n\tv_mbcnt_hi_u32_b32 %0, -1, %0" : "=v"(l)); return l; }

__device__ __forceinline__ size_t pj(size_t row, int col) { return ((row >> 8) * (NPROJ / 256) + (size_t)(col >> 8)) * 65536 + (row & 255) * 256 + (size_t)(col & 255); }

#define XB_TMO      128
#define XB_XCNT(j)  (256  + 64 * (j))
#define XB_XSUB(j)  (1280 + 64 * (j))
#define XB_XGEN(j)  (2304 + 64 * (j))
#define XB_TOP      3328
#define XB_TOPGEN   3392
#define XCD_BAR_WORDS 3456
#define XB_SPIN_CAP (1u << 18)
__device__ __forceinline__ unsigned xb_ld(unsigned* p)              { return __hip_atomic_load(p, __ATOMIC_RELAXED, __HIP_MEMORY_SCOPE_AGENT); }
__device__ __forceinline__ unsigned xb_add(unsigned* p, unsigned v) { return __hip_atomic_fetch_add(p, v, __ATOMIC_RELAXED, __HIP_MEMORY_SCOPE_AGENT); }
__device__ __forceinline__ unsigned xb_xcc_id() { return (unsigned)__builtin_amdgcn_s_getreg((3 << 11) | 20) & 0xFu; }
#define XB_SPIN(cond, bar) do { unsigned _sp = 0; while (cond) { __builtin_amdgcn_s_sleep(1); \
    if ((++_sp & 255u) == 0u) { if (xb_ld(&(bar)[XB_TMO])) break; if (_sp > XB_SPIN_CAP) { atomicAdd(&(bar)[XB_TMO], 1u); break; } } } } while (0)
struct XcdBarrier { unsigned* bar; unsigned x; volatile LAS unsigned* st; };
__device__ __forceinline__ XcdBarrier xcd_barrier_post(unsigned* bar, volatile LAS unsigned* st) {
    XcdBarrier b; b.bar = bar; b.x = xb_xcc_id(); b.st = st;
    if (threadIdx.x == 0) (void)xb_add(&bar[XB_XCNT(b.x)], 1u);
    return b;
}
__device__ __forceinline__ void xcd_barrier_complete(unsigned* bar, unsigned x, unsigned& nloc, unsigned& nx) {
    const unsigned G = gridDim.x * gridDim.y * gridDim.z;
    unsigned sum, cnt, mine, sp = 0u;
    for (;;) {
        sum = 0u; cnt = 0u; mine = 0u;
#pragma unroll
        for (unsigned j = 0; j < 16; ++j) { const unsigned c = xb_ld(&bar[XB_XCNT(j)]); sum += c; cnt += (c > 0u) ? 1u : 0u; mine = (j == x) ? c : mine; }
        if (sum == G) break;
        __builtin_amdgcn_s_sleep(1);
        if ((++sp & 255u) == 0u) { if (xb_ld(&bar[XB_TMO])) break; if (sp > XB_SPIN_CAP) { atomicAdd(&bar[XB_TMO], 1u); break; } }
    }
    nloc = mine > 0u ? mine : 1u; nx = cnt > 0u ? cnt : 1u;
}
__device__ __forceinline__ void xcd_barrier(const XcdBarrier& b, const int wave) {
    asm volatile("s_waitcnt vmcnt(0)" ::: "memory");
    __syncthreads();
    if (wave == 0 && lane_id_asm() == 0) {
        unsigned* bar = b.bar;
        __builtin_amdgcn_s_waitcnt(0);
        unsigned nloc = b.st[0], nx = b.st[1];
        if (nloc == 0u) { xcd_barrier_complete(bar, b.x, nloc, nx); b.st[0] = nloc; b.st[1] = nx; }
        const unsigned old = xb_add(&bar[XB_XSUB(b.x)], 1u);
        const unsigned gen = old / nloc;
        if (old + 1u == (gen + 1u) * nloc) {
            __builtin_amdgcn_fence(__ATOMIC_RELEASE, "agent");
            asm volatile("s_waitcnt vmcnt(0)" ::: "memory");
            const unsigned og = xb_add(&bar[XB_TOP], 1u);
            const unsigned tg = og / nx;
            if (og + 1u == (tg + 1u) * nx) xb_add(&bar[XB_TOPGEN], 1u);
            else XB_SPIN(xb_ld(&bar[XB_TOPGEN]) == tg, bar);
            __builtin_amdgcn_fence(__ATOMIC_ACQUIRE, "agent");
            xb_add(&bar[XB_XGEN(b.x)], 1u);
            asm volatile("s_waitcnt vmcnt(0)" ::: "memory");
        } else {
            XB_SPIN(xb_ld(&bar[XB_XGEN(b.x)]) == gen, bar);
            __builtin_amdgcn_fence(__ATOMIC_ACQUIRE, "agent");
            asm volatile("s_waitcnt vmcnt(0)" ::: "memory");
        }
    }
    __syncthreads();
}

namespace pg8 {
constexpr int BM = 256, BK = 64, HALF = 128, HTB = HALF * BK * 2, STAGE_BYTES = 8 * HTB, NXCD = 8, WGM = 8;
__host__ __device__ __forceinline__ int lds_byte(int r, int c) { const int st = (r >> 4) * 2 + (c >> 5), rr = r & 15, cc = c & 31, ob = rr * 64 + cc * 2; return st * 1024 + (ob ^ (((ob >> 9) & 1) << 5)); }
__host__ __device__ __forceinline__ void stage_rc(int b, int& R, int& C) { const int st = b / 1024, sb = b % 1024, swz = sb ^ (((sb >> 9) & 1) << 5); R = (st >> 1) * 16 + swz / 64; C = (st & 1) * 32 + (swz % 64) / 2; }
__host__ __device__ __forceinline__ int perm32(int rho) { const int n = rho >> 4, i = rho & 15; return 8 * (i >> 2) + 4 * n + (i & 3); }

struct Unit { int pm, pn, ord; const char* a; const char* b; };

struct PlainOrder {
    static constexpr bool GATHER = false;
    int nM, nN, nwg, G, c; const char* A; const char* Bt; size_t tstep;
    __device__ void init(const void* A_, const void* Bt_, int M, int N, int K, int G_, int c_) { nM = M / BM; nN = N / BM; nwg = nM * nN; G = G_; c = c_; A = (const char*)A_; Bt = (const char*)Bt_; tstep = (size_t)BM * K * 2; }
    __device__ bool next(int i, Unit& u) const {
#if defined(PROBE_PK)
        const long L = (long)(i >> 1) * G + c; if (L >= nwg) return false;
#else
        const long L = (long)i * G + c; if (L >= nwg) return false;
#endif
        int wgid = (int)L; { const int q = nwg / NXCD, r = nwg % NXCD, xcd = wgid % NXCD, off = wgid / NXCD; wgid = (xcd < r ? xcd * (q + 1) : r * (q + 1) + (xcd - r) * q) + off; }
        const int nig = WGM * nN, gid = wgid / nig, fm = gid * WGM, gsz = (nM - fm) < WGM ? (nM - fm) : WGM;
        u.pm = fm + ((wgid % nig) % gsz); u.pn = (wgid % nig) / gsz; u.ord = i; u.a = A + (size_t)u.pm * tstep; u.b = Bt + (size_t)u.pn * tstep; return true;
    }
    __device__ __forceinline__ unsigned aoff(int, int) const { return 0u; }
};
template <int SH, bool TAB> struct MoeOrder {
    static constexpr bool GATHER = true;
    int NT, G, c; const char* A; const char* W; unsigned rowb; size_t w_exp, w_tile; const LAS unsigned char* te; const LAS unsigned* tab;
    __device__ bool next(int i, Unit& u) const {
#if defined(PROBE_GK)
        const int L = (SH == 1 ? (i >> 1) : i) * G + c; const int rt = L >> SH; if (rt >= NT) return false;
#elif defined(PROBE_DK)
        const int L = (SH == 2 ? (i >> 1) : i) * G + c; const int rt = L >> SH; if (rt >= NT) return false;
#else
        const int L = i * G + c; const int rt = L >> SH; if (rt >= NT) return false;
#endif
        u.pm = rt; u.pn = L & ((1 << SH) - 1); u.ord = i; const int e = te[rt];
        u.a = A; u.b = W + (size_t)e * w_exp + (size_t)u.pn * w_tile; return true;
    }
    __device__ __forceinline__ unsigned aoff(int ord, int r) const { if constexpr (TAB) {
#if defined(PROBE_GK)
            return tab[(ord >> 1) * 256 + r];
#else
            return tab[ord * 256 + r];
#endif
        } else return (unsigned)((((ord * G + c) >> SH) << 8) + r) * rowb; }
};

__device__ __forceinline__ const GAS char* uni_ptr(const char* p) { const unsigned long long v = (unsigned long long)p; const unsigned lo = (unsigned)__builtin_amdgcn_readfirstlane((int)(unsigned)v), hi = (unsigned)__builtin_amdgcn_readfirstlane((int)(unsigned)(v >> 32)); return (const GAS char*)(((unsigned long long)hi << 32) | lo); }
template <class Epi, class Sched, bool ALIGN_EPI, bool F8 = false>
__device__ __forceinline__ void gemm_phase(LAS unsigned char* lds, const int wid, const int K, const Sched& S, const Epi& E) {
    const int lane = lane_id_asm(), tid = wid * 64 + lane,
        wr = wid >> 2, wc = wid & 3, fr = lane & 15, fq = lane >> 4;
    const int nt = F8 ? K / 128 : K / BK; const int RB = F8 ? K : 2 * K;
    unsigned voffA[2], voffB[2];
#pragma unroll
    for (int i = 0; i < 2; ++i) { int R, C; stage_rc(tid * 16 + i * 8192, R, C); const int Rb = (int)Epi::PERM == 2 ? (64 * (R >> 5) + 16 * ((R >> 2) & 3) + 4 * ((R >> 4) & 1) + (R & 3)) : (Epi::PERM ? ((R & ~31) + perm32(R & 31)) : R);
        voffA[i] = (unsigned)(R * RB + C * 2); voffB[i] = (unsigned)(Rb * RB + C * 2); }
    const size_t kstep = (size_t)(BK * 2);
    const size_t hstep = (size_t)HALF * RB;
    const size_t hstepB = (int)Epi::PERM == 2 ? (size_t)8 * RB : hstep;
    const unsigned ldsw = (unsigned)wid * 1024u;
    const int aoff = lds_byte(wr * 64 + fr, fq * 8), boff = lds_byte(wc * 32 + fr, fq * 8);
#define PG8_SA(b, h) (((b) * 2 + (h)) * HTB)
#define PG8_SB(b, h) ((4 + (b) * 2 + (h)) * HTB)
    const unsigned ldsbase = (unsigned)(unsigned long long)(const LAS void*)lds;
#define PG8_STAGE(bufoff, gbase, voff) do { _Pragma("unroll") for (int _i = 0; _i < 2; ++_i) { const unsigned m0v_ = ldsbase + (unsigned)(bufoff) + ldsw + (unsigned)_i * 8192u; \
        asm volatile("s_mov_b32 m0, %2\n\ts_nop 0\n\tglobal_load_lds_dwordx4 %0, %1" :: "v"((voff)[_i]), "s"(gbase), "s"(m0v_) : "memory", "m0"); } } while (0)
#define PG8_STAGE_A(bufoff, kb, h, GO) do { if constexpr (Sched::GATHER) { PG8_STAGE(bufoff, kb, GO[h]); } else { PG8_STAGE(bufoff, (kb) + (h) * hstep, voffA); } } while (0)
#define PG8_STAGE_A2(bufoff, kb, h) do { if constexpr (Sched::GATHER) { if (last) { PG8_STAGE(bufoff, kb, gN[h]); } else { PG8_STAGE(bufoff, kb, gC[h]); } } else { PG8_STAGE(bufoff, (kb) + (h) * hstep, voffA); } } while (0)
#define PG8_FR(p) (*(const LAS v4i_*)(p))
#define PG8_LDA(dst, b, h) do { _Pragma("unroll") for (int m = 0; m < 4; ++m) { if constexpr (F8) { dst##8[m] = __builtin_shufflevector(PG8_FR(lds + PG8_SA(b, h) + aoff + m * 2048), PG8_FR(lds + PG8_SA(b, h) + aoff + m * 2048 + 1024), 0, 1, 2, 3, 4, 5, 6, 7); } \
        else { _Pragma("unroll") for (int k = 0; k < 2; ++k) dst[m][k] = *(const LAS bf16x8*)(lds + PG8_SA(b, h) + aoff + m * 2048 + k * 1024); } } } while (0)
#define PG8_LDB(dst, b, h) do { _Pragma("unroll") for (int n = 0; n < 2; ++n) { if constexpr (F8) { dst##8[n] = __builtin_shufflevector(PG8_FR(lds + PG8_SB(b, h) + boff + n * 2048), PG8_FR(lds + PG8_SB(b, h) + boff + n * 2048 + 1024), 0, 1, 2, 3, 4, 5, 6, 7); } \
        else { _Pragma("unroll") for (int k = 0; k < 2; ++k) dst[n][k] = *(const LAS bf16x8*)(lds + PG8_SB(b, h) + boff + n * 2048 + k * 1024); } } } while (0)
#define PG8_MMA(ai, bj, At, Bt) do { __builtin_amdgcn_s_setprio(1); _Pragma("unroll") for (int m = 0; m < 4; ++m) _Pragma("unroll") for (int n = 0; n < 2; ++n) { \
        if constexpr (F8) { acc[ai][bj][m][n] = __builtin_amdgcn_mfma_scale_f32_16x16x128_f8f6f4(Bt##8[n], At##8[m], acc[ai][bj][m][n], 0, 0, 0, 0x7f7f7f7f, 0, Epi::MXSCALE); } \
        else { _Pragma("unroll") for (int k = 0; k < 2; ++k) acc[ai][bj][m][n] = __builtin_amdgcn_mfma_f32_16x16x32_bf16(Bt[n][k], At[m][k], acc[ai][bj][m][n], 0, 0, 0); } } \
        if constexpr (F8) { _Pragma("unroll") for (int m = 0; m < 4; ++m) asm volatile("" : "+v"(acc[ai][bj][m][0]), "+v"(acc[ai][bj][m][1])); }     \
        __builtin_amdgcn_s_setprio(0); } while (0)
#define PG8_WAIT_V(n) asm volatile("s_waitcnt vmcnt(" #n ")" ::: "memory")
#define PG8_WAIT_L(n) asm volatile("s_waitcnt lgkmcnt(" #n ")" ::: "memory")
#define PG8_WAIT_VR(relax) do { if (relax) asm volatile("s_waitcnt vmcnt(%0)" :: "n"(8 + Epi::NSTORE) : "memory"); else asm volatile("s_waitcnt vmcnt(8)" ::: "memory"); } while (0)
#define PG8_BAR do { __builtin_amdgcn_s_barrier(); if constexpr (F8) asm volatile("" ::: "memory"); } while (0)
#define PG8_SCHED __builtin_amdgcn_sched_barrier(0)
#define PG8_GLOAD(G_, u_) do { if constexpr (Sched::GATHER) { _Pragma("unroll") for (int _i = 0; _i < 2; ++_i) { int R_, C_; stage_rc(tid * 16 + _i * 8192, R_, C_); _Pragma("unroll") for (int _h = 0; _h < 2; ++_h) G_[_h][_i] = S.aoff((u_).ord, _h * HALF + R_) + (unsigned)C_ * 2u; } } } while (0)
    Unit cur, nxt;
    if (!S.next(0, cur)) return;
    f32x4 acc[2][2][4][2];
#pragma unroll
    for (int a = 0; a < 2; ++a)
#pragma unroll
        for (int b = 0; b < 2; ++b)
#pragma unroll
            for (int m = 0; m < 4; ++m)
#pragma unroll
                for (int n = 0; n < 2; ++n) acc[a][b][m][n] = (f32x4){0.f, 0.f, 0.f, 0.f};
    typedef int v4i_ __attribute__((ext_vector_type(4))); typedef int v8i_ __attribute__((ext_vector_type(8)));
    bf16x8 At[4][2], B0[2][2], B1[2][2];
    v8i_ At8[4], B08[2], B18[2];
    unsigned gC[2][2] = {{0u, 0u}, {0u, 0u}}, gN[2][2] = {{0u, 0u}, {0u, 0u}};
    PG8_GLOAD(gC, cur);
    const GAS char* cA = uni_ptr(cur.a); const GAS char* cB = uni_ptr(cur.b);
    PG8_STAGE(PG8_SB(0, 0), cB, voffB); PG8_STAGE(PG8_SB(0, 1), cB + hstepB, voffB); PG8_STAGE_A(PG8_SA(0, 0), cA, 0, gC); PG8_STAGE_A(PG8_SA(0, 1), cA, 1, gC);
    if (wr == 1) PG8_BAR;
    PG8_WAIT_V(2); PG8_BAR;
    PG8_STAGE(PG8_SB(1, 0), cB + kstep, voffB); PG8_STAGE_A(PG8_SA(1, 0), cA + kstep, 0, gC); PG8_STAGE(PG8_SB(1, 1), cB + hstepB + kstep, voffB);
    PG8_WAIT_V(6); PG8_BAR;
    int ui = 0;
    for (;;) {
        const bool has_next = S.next(ui + 1, nxt);
        const GAS char* nA = has_next ? uni_ptr(nxt.a) : cA; const GAS char* nB = has_next ? uni_ptr(nxt.b) : cB;
        if constexpr (Sched::GATHER) { if (has_next) { PG8_GLOAD(gN, nxt); } else {
#pragma unroll
            for (int _h = 0; _h < 2; ++_h)
#pragma unroll
                for (int _i = 0; _i < 2; ++_i) gN[_h][_i] = gC[_h][_i]; } }
#pragma unroll 1
        for (int t = 0; t < nt; t += 2) {
            const bool last = (t == nt - 2);
            const GAS char* a1 = cA + (size_t)(t + 1) * kstep;
            const GAS char* a2 = last ? nA : cA + (size_t)(t + 2) * kstep; const GAS char* b2 = last ? nB : cB + (size_t)(t + 2) * kstep;
            const GAS char* a3 = a2 + kstep; const GAS char* b3 = b2 + kstep;
            if constexpr (Epi::HAS_MID) { if (t == nt / 2) E.mid(acc, cur, wr, fr); }
            const bool relax = Epi::NSTORE > 0 && t == 0 && ui > 0;
            PG8_LDB(B0, 0, 0); PG8_LDB(B1, 0, 1); PG8_SCHED; PG8_LDA(At, 0, 0); if (!relax) PG8_STAGE_A(PG8_SA(1, 1), a1, 1, gC);
            PG8_WAIT_VR(relax); PG8_WAIT_L(0); PG8_BAR; PG8_MMA(0, 0, At, B0); PG8_MMA(0, 1, At, B1); PG8_BAR; PG8_SCHED;
            PG8_LDA(At, 0, 1); PG8_STAGE(PG8_SB(0, 0), b2, voffB); PG8_STAGE(PG8_SB(0, 1), b2 + hstepB, voffB); PG8_STAGE_A2(PG8_SA(0, 0), a2, 0);
            PG8_WAIT_VR(relax); PG8_WAIT_L(0); PG8_BAR; PG8_MMA(1, 0, At, B0); PG8_MMA(1, 1, At, B1); PG8_BAR; PG8_SCHED;
            PG8_LDB(B0, 1, 0); PG8_LDB(B1, 1, 1); PG8_SCHED; PG8_LDA(At, 1, 0); PG8_STAGE_A2(PG8_SA(0, 1), a2, 1);
            PG8_WAIT_VR(relax); PG8_WAIT_L(0); PG8_BAR; PG8_MMA(0, 0, At, B0); PG8_MMA(0, 1, At, B1); PG8_BAR; PG8_SCHED;
            PG8_LDA(At, 1, 1); PG8_STAGE(PG8_SB(1, 0), b3, voffB); PG8_STAGE(PG8_SB(1, 1), b3 + hstepB, voffB); PG8_STAGE_A2(PG8_SA(1, 0), a3, 0);
            PG8_WAIT_V(8); PG8_WAIT_L(0); PG8_BAR; PG8_MMA(1, 0, At, B0); PG8_MMA(1, 1, At, B1); PG8_BAR; PG8_SCHED;
        }
        if constexpr (Epi::NSTORE > 0) { if (has_next) PG8_STAGE_A(PG8_SA(1, 1), nA + kstep, 1, gN); }
        if constexpr (ALIGN_EPI) { if (wr == 0) PG8_BAR; }
        E(acc, cur, wr, wc, fr, fq);
        if (!has_next) break;
#pragma unroll
        for (int a = 0; a < 2; ++a)
#pragma unroll
            for (int b = 0; b < 2; ++b)
#pragma unroll
                for (int m = 0; m < 4; ++m)
#pragma unroll
                    for (int n = 0; n < 2; ++n) acc[a][b][m][n] = (f32x4){0.f, 0.f, 0.f, 0.f};
        cur = nxt; cA = nA; cB = nB; ++ui;
#pragma unroll
        for (int _h = 0; _h < 2; ++_h)
#pragma unroll
            for (int _i = 0; _i < 2; ++_i) gC[_h][_i] = gN[_h][_i];
        if constexpr (ALIGN_EPI) { if (wr == 1) PG8_BAR; }
    }
    PG8_WAIT_V(0);
    if constexpr (!ALIGN_EPI) { if (wr == 0) PG8_BAR; }
    PG8_BAR;
#undef PG8_SA
#undef PG8_SB
#undef PG8_STAGE
#undef PG8_STAGE_A
#undef PG8_STAGE_A2
#undef PG8_LDA
#undef PG8_FR
#undef PG8_LDB
#undef PG8_MMA
#undef PG8_WAIT_V
#undef PG8_WAIT_L
#undef PG8_WAIT_VR
#undef PG8_BAR
#undef PG8_SCHED
#undef PG8_GLOAD
}

struct EpiBf16 {
    static constexpr bool PERM = true, HAS_MID = false; static constexpr int NSTORE = 16;
    static constexpr int MXSCALE = 0x7f7f7f7f;
    bf16* O; int ldc;
    __device__ __forceinline__ void operator()(const f32x4 (&acc)[2][2][4][2], const Unit& u, int wr, int wc, int fr, int fq) const {
#if defined(PROBE_PK)
        if ((u.ord & 1) == 0) return;
#endif
        const int row0 = u.pm * BM + wr * 64 + fr, col0 = u.pn * BM + wc * 32 + 8 * fq;
#pragma unroll
        for (int ai = 0; ai < 2; ++ai)
#pragma unroll
            for (int m = 0; m < 4; ++m) { bf16* rowp = O + (size_t)(row0 + ai * HALF + m * 16) * ldc + col0;
#pragma unroll
                for (int bj = 0; bj < 2; ++bj) { const f32x4 v0 = acc[ai][bj][m][0], v1 = acc[ai][bj][m][1];
                    u32x4 w; w.x = cvt_pk_bf16(v0[0], v0[1]); w.y = cvt_pk_bf16(v0[2], v0[3]); w.z = cvt_pk_bf16(v1[0], v1[1]); w.w = cvt_pk_bf16(v1[2], v1[3]);
                    *(u32x4*)(rowp + bj * HALF) = w; } }
    }
};
struct EpiBf16T {
    static constexpr bool PERM = true, HAS_MID = false; static constexpr int NSTORE = 16;
    static constexpr int MXSCALE = 0x7f7f7f7f;
    bf16* O; int ntn;
    __device__ __forceinline__ void operator()(const f32x4 (&acc)[2][2][4][2], const Unit& u, int wr, int wc, int fr, int fq) const {
        bf16* tile = O + ((size_t)u.pm * ntn + u.pn) * 65536 + (wr * 64 + fr) * 256 + wc * 32 + 8 * fq;
#pragma unroll
        for (int ai = 0; ai < 2; ++ai)
#pragma unroll
            for (int m = 0; m < 4; ++m) { bf16* rowp = tile + (ai * HALF + m * 16) * 256;
#pragma unroll
                for (int bj = 0; bj < 2; ++bj) { const f32x4 v0 = acc[ai][bj][m][0], v1 = acc[ai][bj][m][1];
                    u32x4 w; w.x = cvt_pk_bf16(v0[0], v0[1]); w.y = cvt_pk_bf16(v0[2], v0[3]); w.z = cvt_pk_bf16(v1[0], v1[1]); w.w = cvt_pk_bf16(v1[2], v1[3]);
                    *(u32x4*)(rowp + bj * HALF) = w; } }
    }
};
struct EpiGU {
    static constexpr bool PERM = true, HAS_MID = false; static constexpr int NSTORE = 8;
    static constexpr int MXSCALE = 0x7f7f7f7f;
    unsigned char* H;
    __device__ __forceinline__ void operator()(const f32x4 (&acc)[2][2][4][2], const Unit& u, int wr, int wc, int fr, int fq) const {
#if defined(PROBE_GK)
        if ((u.ord & 1) == 0) return;
#endif
        const int row0 = u.pm * BM + wr * 64 + fr, col0 = u.pn * HALF + wc * 32 + 8 * fq;
#pragma unroll
        for (int ai = 0; ai < 2; ++ai)
#pragma unroll
            for (int m = 0; m < 4; ++m) { unsigned char* rowp = H + (size_t)(row0 + ai * HALF + m * 16) * 256 + col0;
                float h[8];
#pragma unroll
                for (int n = 0; n < 2; ++n)
#pragma unroll
                    for (int i = 0; i < 4; i += 2) {
                        const f32x2 g = (f32x2){acc[ai][0][m][n][i], acc[ai][0][m][n][i + 1]}, u = (f32x2){acc[ai][1][m][n][i], acc[ai][1][m][n][i + 1]};
                        const f32x2 t = g * (-1.4426950408889634f / 64.0f); const f32x2 e = (f32x2){__builtin_amdgcn_exp2f(t.x), __builtin_amdgcn_exp2f(t.y)};
                        const f32x2 d = e * 1024.0f + 1024.0f;
                        const f32x2 r = (f32x2){__builtin_amdgcn_rcpf(d.x), __builtin_amdgcn_rcpf(d.y)}; const f32x2 hh = (g * u) * r;
                        h[4 * n + i] = hh.x; h[4 * n + i + 1] = hh.y; }
                int lo = __builtin_amdgcn_cvt_pk_fp8_f32(h[0], h[1], 0, false); lo = __builtin_amdgcn_cvt_pk_fp8_f32(h[2], h[3], lo, true);
                int hi = __builtin_amdgcn_cvt_pk_fp8_f32(h[4], h[5], 0, false); hi = __builtin_amdgcn_cvt_pk_fp8_f32(h[6], h[7], hi, true);
                *(u32x2*)rowp = (u32x2){(unsigned)lo, (unsigned)hi}; }
    }
};
struct EpiFp8 {
    static constexpr int PERM = 2; static constexpr bool HAS_MID = false; static constexpr int NSTORE = 8;
    static constexpr int MXSCALE = 0x7b7b7b7b;
    unsigned char* O; int ldc; float sc;
    __device__ __forceinline__ void operator()(const f32x4 (&acc)[2][2][4][2], const Unit& u, int wr, int wc, int fr, int fq) const {
        const int row0 = u.pm * BM + wr * 64 + fr, col0 = u.pn * BM + wc * 64 + 16 * fq;
#pragma unroll
        for (int ai = 0; ai < 2; ++ai)
#pragma unroll
            for (int m = 0; m < 4; ++m) { u32x4 w;
#pragma unroll
                for (int bj = 0; bj < 2; ++bj) { const f32x4 v0 = acc[ai][bj][m][0], v1 = acc[ai][bj][m][1];
                    int lo = __builtin_amdgcn_cvt_pk_fp8_f32(v0[0], v0[1], 0, false); lo = __builtin_amdgcn_cvt_pk_fp8_f32(v0[2], v0[3], lo, true);
                    int hi = __builtin_amdgcn_cvt_pk_fp8_f32(v1[0], v1[1], 0, false); hi = __builtin_amdgcn_cvt_pk_fp8_f32(v1[2], v1[3], hi, true);
                    if (bj == 0) { w.x = (unsigned)lo; w.y = (unsigned)hi; } else { w.z = (unsigned)lo; w.w = (unsigned)hi; } }
                *(u32x4*)(O + (size_t)(row0 + ai * HALF + m * 16) * ldc + col0) = w; }
    }
};
struct EpiX1 {
    static constexpr bool PERM = true, HAS_MID = true; static constexpr int NSTORE = 0;
    static constexpr int MXSCALE = 0x7f7f7f7f;
    const float* x; bf16* o; const float* g1; const LAS float* rstab;
    __device__ __forceinline__ void mid(f32x4 (&acc)[2][2][4][2], const Unit& u, int wr, int fr) const {
#pragma unroll
        for (int ai = 0; ai < 2; ++ai)
#pragma unroll
            for (int m = 0; m < 4; ++m) { const float rs = rstab[u.ord * 256 + ai * HALF + wr * 64 + m * 16 + fr];
#pragma unroll
                for (int bj = 0; bj < 2; ++bj)
#pragma unroll
                    for (int n = 0; n < 2; ++n) acc[ai][bj][m][n] = acc[ai][bj][m][n] * rs; }
    }
    __device__ __forceinline__ void operator()(const f32x4 (&acc)[2][2][4][2], const Unit& u, int wr, int wc, int fr, int fq) const {
        const int row0 = u.pm * BM + wr * 64 + fr, col0 = u.pn * BM + wc * 32 + 8 * fq; const int b = (u.pm * BM) / SEQ;
        f32x4 gv[2][2];
#pragma unroll
        for (int bj = 0; bj < 2; ++bj)
#pragma unroll
            for (int n = 0; n < 2; ++n) gv[bj][n] = *(const f32x4*)(g1 + (size_t)b * 6144 + col0 + bj * HALF + 4 * n);
#pragma unroll
        for (int ai = 0; ai < 2; ++ai) {
            f32x4 xv[4][2][2];
#pragma unroll
            for (int m = 0; m < 4; ++m)
#pragma unroll
                for (int bj = 0; bj < 2; ++bj)
#pragma unroll
                    for (int n = 0; n < 2; ++n) xv[m][bj][n] = *(const f32x4*)(x + (size_t)(row0 + ai * HALF + m * 16) * D + col0 + bj * HALF + 4 * n);
#pragma unroll
            for (int m = 0; m < 4; ++m)
#pragma unroll
                for (int bj = 0; bj < 2; ++bj) { const f32x4 v0 = xv[m][bj][0] + gv[bj][0] * acc[ai][bj][m][0], v1 = xv[m][bj][1] + gv[bj][1] * acc[ai][bj][m][1];
                    u32x4 w; w.x = cvt_pk_bf16(v0[0], v0[1]); w.y = cvt_pk_bf16(v0[2], v0[3]); w.z = cvt_pk_bf16(v1[0], v1[1]); w.w = cvt_pk_bf16(v1[2], v1[3]);
                    *(u32x4*)(o + (size_t)(row0 + ai * HALF + m * 16) * D + col0 + bj * HALF) = w; }
            asm volatile("" ::: "memory"); }
    }
};
struct EpiLogits {
    static constexpr bool PERM = false, HAS_MID = false; static constexpr int NSTORE = 0;
    static constexpr int MXSCALE = 0x7f7f7f7f;
    float* L;
    __device__ __forceinline__ void operator()(const f32x4 (&acc)[2][2][4][2], const Unit& u, int wr, int wc, int fr, int fq) const {
        if (wc < 2 && u.pn == 0) {
            const int row0 = u.pm * BM + wr * 64 + fr, col0 = wc * 32 + 4 * fq;
#pragma unroll
            for (int ai = 0; ai < 2; ++ai)
#pragma unroll
                for (int m = 0; m < 4; ++m)
#pragma unroll
                    for (int n = 0; n < 2; ++n) *(f32x4*)(L + (size_t)(row0 + ai * HALF + m * 16) * 64 + col0 + n * 16) = acc[ai][0][m][n];
        }
    }
};
}

struct Args { const float* in[24]; float* out; unsigned char* ws; int ph_lo, ph_hi; };
typedef const Args __attribute__((address_space(4))) CArgs;
#define ARGS_LAUNDER(src_) CArgs* ap_ = &(src_); asm volatile("" : "+s"(ap_)); CArgs& args = *ap_
struct Frame {
    LAS unsigned char* lds; volatile LAS unsigned* MISC; unsigned* ctl;
    int tid, lane, wave, vcu, G;
};

struct TrIt { const float* src; unsigned char* dst; const float* ks; int ldw, ldk, useks, f8; };
__device__ __forceinline__ void tr_load(const TrIt& t, f32x4 (&tv)[8], float (&tk)[8], int lane) {
#pragma unroll
    for (int i = 0; i < 8; ++i) { const int kk = 8 * i + (lane >> 3), n4 = 4 * (lane & 7); tv[i] = *(const f32x4*)(t.src + (size_t)kk * t.ldw + n4); tk[i] = t.ks[kk]; }
}
__device__ __forceinline__ void tr_store(const TrIt& t, const f32x4 (&tv)[8], const float (&tk)[8], LAS float* scr, int lane) {
#pragma unroll
    for (int i = 0; i < 8; ++i) { const int kk = 8 * i + (lane >> 3), n4 = 4 * (lane & 7); const f32x4 v = tv[i] * (t.useks ? tk[i] : 1.0f);
        LAS float* d = scr + kk * 33 + n4; d[0] = v.x; d[1] = v.y; d[2] = v.z; d[3] = v.w; }
    LDS_WAIT(); asm volatile("" ::: "memory");
    const int c = lane & 7;
#pragma unroll
    for (int j = 0; j < 4; ++j) { const int n = (lane >> 3) + 8 * j; const LAS float* s = scr + (8 * c) * 33 + n;
        if (t.f8) {
            int lo = __builtin_amdgcn_cvt_pk_fp8_f32(s[0 * 33] * 64.f, s[1 * 33] * 64.f, 0, false); lo = __builtin_amdgcn_cvt_pk_fp8_f32(s[2 * 33] * 64.f, s[3 * 33] * 64.f, lo, true);
            int hi = __builtin_amdgcn_cvt_pk_fp8_f32(s[4 * 33] * 64.f, s[5 * 33] * 64.f, 0, false); hi = __builtin_amdgcn_cvt_pk_fp8_f32(s[6 * 33] * 64.f, s[7 * 33] * 64.f, hi, true);
            *(u32x2*)(t.dst + (size_t)n * t.ldk + 8 * c) = (u32x2){(unsigned)lo, (unsigned)hi};
        } else {
            u32x4 o; o.x = cvt_pk_bf16(s[0 * 33], s[1 * 33]); o.y = cvt_pk_bf16(s[2 * 33], s[3 * 33]); o.z = cvt_pk_bf16(s[4 * 33], s[5 * 33]); o.w = cvt_pk_bf16(s[6 * 33], s[7 * 33]);
            *(u32x4*)(t.dst + ((size_t)n * t.ldk + 8 * c) * 2) = o; } }
    LDS_WAIT(); asm volatile("" ::: "memory");
}
__device__ __forceinline__ void p0_prologue(const Frame& F_, CArgs& args_) {
    Frame F = F_; F.lane = lane_id_asm(); F.tid = F.wave * 64 + F.lane;
    ARGS_LAUNDER(args_);
    const int gw = F.vcu * 8 + F.wave, NGW = F.G * 8, lane = F.lane;
    for (int cg = F.vcu; cg < 96; cg += F.G) {
        const int j = cg * 64 + lane, k0 = F.wave * 128;
        float acc[16];
#pragma unroll
        for (int b = 0; b < 16; ++b) acc[b] = 0.f;
#pragma unroll 8
        for (int kk = 0; kk < 128; ++kk) { const float w = (args.in[2])[(size_t)(k0 + kk) * 6144 + j];
#pragma unroll
            for (int b = 0; b < 16; ++b) acc[b] += (args.in[1])[b * 1024 + k0 + kk] * w; }
        LAS float* part = (LAS float*)F.lds;
#pragma unroll
        for (int b = 0; b < 16; ++b) part[(F.wave * 16 + b) * 64 + lane] = acc[b];
        WG_BAR();
        for (int o = F.tid; o < 1024; o += 512) { const int b = o >> 6, jj = o & 63; float s = (args.in[3])[cg * 64 + jj];
#pragma unroll
            for (int w = 0; w < 8; ++w) s += part[(w * 16 + b) * 64 + jj];
            ((float*)(args.ws + WS_MOD))[b * 6144 + cg * 64 + jj] = s; }
        WG_BAR();
    }
    LAS float* scr = (LAS float*)(F.lds + F.wave * 16384);
    constexpr int I_IN = 16 * 96, I_OUT = 16 * 32, I_E = NEX * 128;
    constexpr int NITEMS = I_IN + I_OUT + 3 * I_E;
    auto decode = [&](int it) -> TrIt { TrIt t; t.useks = 0; t.ks = (args.in[12]); t.f8 = 0; int r = it;
        if (r < I_IN) { const int kb = r / 96, nb = r % 96; t.src = (args.in[5]) + (size_t)(kb * 64) * LDWIN + nb * 32; t.ldw = LDWIN; t.dst = (unsigned char*)(((bf16*)(args.ws + WS_WIN)) + (size_t)(nb * 32) * 1024 + kb * 64); t.ldk = 1024; return t; } r -= I_IN;
        if (r < I_OUT) { const int kb = r / 32, nb = r % 32, k0 = kb * 64; const int dc = k0 < 512 ? k0 + 512 : k0 - 512;
            t.src = (args.in[13]) + (size_t)k0 * 1024 + nb * 32; t.ldw = 1024; t.dst = (unsigned char*)(((bf16*)(args.ws + WS_WOUT)) + (size_t)(nb * 32) * 1024 + dc); t.ldk = 1024; if (k0 >= 512) { t.useks = 1; t.ks = (args.in[12]) + (k0 - 512); } return t; } r -= I_OUT;
        t.f8 = 1;
        if (r < 2 * I_E) { const int up = r >= I_E; if (up) r -= I_E; const int e = r / 128, q = r % 128, kb = q / 8, nb = q % 8, n0 = nb * 32;
            const float* W = up ? (e < NE ? (args.in[18]) + (size_t)e * 262144 : (args.in[21])) : (e < NE ? (args.in[17]) + (size_t)e * 262144 : (args.in[20]));
            const int drow = (n0 / 128) * 256 + up * 128 + (n0 % 128);
            t.src = W + (size_t)(kb * 64) * 256 + n0; t.ldw = 256; t.dst = (unsigned char*)(args.ws + WS_WGU) + ((size_t)e * 512 + drow) * 1024 + kb * 64; t.ldk = 1024; return t; } r -= 2 * I_E;
        { const int e = r / 128, q = r % 128, kb = q / 32, nb = q % 32; const float* W = e < NE ? (args.in[19]) + (size_t)e * 262144 : (args.in[22]);
            t.src = W + (size_t)(kb * 64) * 1024 + nb * 32; t.ldw = 1024; t.dst = (unsigned char*)(args.ws + WS_WD) + ((size_t)e * 1024 + nb * 32) * 256 + kb * 64; t.ldk = 256; return t; } };
    if (gw < NITEMS) {
        TrIt nxt = decode(gw); f32x4 nv[8]; float nk[8];
        tr_load(nxt, nv, nk, lane);
#pragma unroll 1
        for (int it = gw; it < NITEMS; it += NGW) {
            const TrIt cur = nxt; f32x4 cv[8]; float ck[8];
#pragma unroll
            for (int i = 0; i < 8; ++i) { cv[i] = nv[i]; ck[i] = nk[i]; }
            nxt = decode(it + NGW < NITEMS ? it + NGW : it);
            tr_load(nxt, nv, nk, lane);
            tr_store(cur, cv, ck, scr, lane);
        }
    }
    for (int e = blockIdx.x * 512 + F.tid; e < 4096; e += F.G * 512) { const int p = e >> 3, hh = e & 7;
        ((unsigned*)(args.ws + WS_WDT))[e] = cvt_pk_bf16((args.in[5])[(size_t)(2 * p) * LDWIN + NPROJ + hh], (args.in[5])[(size_t)(2 * p + 1) * LDWIN + NPROJ + hh]); }
}

template <bool WITH_DT, bool XBF>
__device__ __forceinline__ void p_norm_mod(const Frame& F_, CArgs& args_, const void* xin_, const float* gain, int shift_off, int scale_off, bf16* hout, unsigned char* h8out) {
    Frame F = F_; F.lane = lane_id_asm(); F.tid = F.wave * 64 + F.lane;
    ARGS_LAUNDER(args_);
    const int gw = F.vcu * 8 + F.wave, NGW = F.G * 8, lane = F.lane;
    for (int blk = gw; blk < T / 32; blk += NGW) {
        const int row0 = blk * 32, b = row0 / SEQ;
        f32x4 sc[4], sh[4];
#pragma unroll
        for (int j = 0; j < 4; ++j) { const int col = 4 * lane + 256 * j; const f32x4 g = *(const f32x4*)(gain + col); const f32x4 s1 = *(const f32x4*)(((float*)(args.ws + WS_MOD)) + b * 6144 + scale_off + col);
            sc[j] = g * (s1 + 1.0f); sh[j] = *(const f32x4*)(((float*)(args.ws + WS_MOD)) + b * 6144 + shift_off + col); }
        unsigned wdt[WITH_DT ? 4 : 1][2][WITH_DT ? 8 : 1];
        if constexpr (WITH_DT) {
#pragma unroll
            for (int j = 0; j < 4; ++j)
#pragma unroll
                for (int pr = 0; pr < 2; ++pr) { const u32x4* wp = (const u32x4*)(args.ws + WS_WDT) + (size_t)(2 * lane + 128 * j + pr) * 2; const u32x4 a = wp[0], c = wp[1];
                    wdt[j][pr][0] = a.x; wdt[j][pr][1] = a.y; wdt[j][pr][2] = a.z; wdt[j][pr][3] = a.w; wdt[j][pr][4] = c.x; wdt[j][pr][5] = c.y; wdt[j][pr][6] = c.z; wdt[j][pr][7] = c.w; }
        }
        float dtb = 0.f; if constexpr (WITH_DT) dtb = (args.in[9])[lane & 7];
        f32x4 nx[2][4];
#pragma unroll
        for (int p = 0; p < 2; ++p)
#pragma unroll
            for (int j = 0; j < 4; ++j) {
                if constexpr (XBF) { const u32x2 w = ((const u32x2*)((const bf16*)xin_ + (size_t)(row0 + p) * D) + lane)[64 * j]; nx[p][j] = (f32x4){bflo(w.x), bfhi(w.x), bflo(w.y), bfhi(w.y)}; }
                else nx[p][j] = ((const f32x4*)((const float*)xin_ + (size_t)(row0 + p) * D) + lane)[64 * j]; }
#pragma unroll 2
        for (int r = 0; r < 32; ++r) {
            const int row = row0 + r;
            f32x4 v[4]; float s = 0.f;
#pragma unroll
            for (int j = 0; j < 4; ++j) v[j] = nx[r & 1][j];
            { const int rn = row0 + (r + 2 < 32 ? r + 2 : 31);
#pragma unroll
                for (int j = 0; j < 4; ++j) {
                    if constexpr (XBF) { const u32x2 w = ((const u32x2*)((const bf16*)xin_ + (size_t)rn * D) + lane)[64 * j]; nx[r & 1][j] = (f32x4){bflo(w.x), bfhi(w.x), bflo(w.y), bfhi(w.y)}; }
                    else nx[r & 1][j] = ((const f32x4*)((const float*)xin_ + (size_t)rn * D) + lane)[64 * j]; } }
#pragma unroll
            for (int j = 0; j < 4; ++j) s += (v[j].x * v[j].x + v[j].y * v[j].y) + (v[j].z * v[j].z + v[j].w * v[j].w);
            const float rstd = rsqrtf(wave_sum(s) * (1.0f / D) + EPS);
            u32x2* o8 = (u32x2*)(hout + (size_t)row * D) + lane;
            float dv[8] = {0.f, 0.f, 0.f, 0.f, 0.f, 0.f, 0.f, 0.f};
#pragma unroll
            for (int j = 0; j < 4; ++j) { const f32x4 h = v[j] * rstd * sc[j] + sh[j];
                if constexpr (!WITH_DT) { int q8 = __builtin_amdgcn_cvt_pk_fp8_f32(h.x, h.y, 0, false); q8 = __builtin_amdgcn_cvt_pk_fp8_f32(h.z, h.w, q8, true); ((unsigned*)(h8out + (size_t)row * D))[lane + 64 * j] = (unsigned)q8; }
                const unsigned wx = cvt_pk_bf16(h.x, h.y), wy = cvt_pk_bf16(h.z, h.w); if (WITH_DT) o8[64 * j] = (u32x2){wx, wy};
                if constexpr (WITH_DT) {
                    typedef __bf16 bf2 __attribute__((ext_vector_type(2)));
#pragma unroll
                    for (int hh = 0; hh < 8; ++hh) { dv[hh] = __builtin_amdgcn_fdot2_f32_bf16(__builtin_bit_cast(bf2, wx), __builtin_bit_cast(bf2, wdt[j][0][hh]), dv[hh], false);
                        dv[hh] = __builtin_amdgcn_fdot2_f32_bf16(__builtin_bit_cast(bf2, wy), __builtin_bit_cast(bf2, wdt[j][1][hh]), dv[hh], false); } } }
            if constexpr (WITH_DT) {
#pragma unroll
                for (int hh = 0; hh < 8; ++hh) dv[hh] = wave_sum(dv[hh]);
                float mine = dv[0];
#pragma unroll
                for (int hh = 1; hh < 8; ++hh) mine = (lane == hh) ? dv[hh] : mine;
                if (lane < 8) { const float a = mine + dtb; ((float*)(args.ws + WS_DT))[(size_t)row * 8 + lane] = a > 20.f ? a : log1pf(__expf(a)); }
            }
        }
    }
}

__device__ __forceinline__ void p3_conv(const Frame& F_, CArgs& args_) {
    Frame F = F_; F.lane = lane_id_asm(); F.tid = F.wave * 64 + F.lane;
    ARGS_LAUNDER(args_);
    const int q = F.tid & 63, seg = F.tid >> 6;
    for (int tile = F.vcu; tile < T / 256; tile += F.G) {
        const int r0 = tile * 256 + seg * 32; const bool head = (r0 % SEQ) == 0;
        {
            float w0[8], w1[8], w2[8], pm2[8], pm1[8];
#pragma unroll
            for (int i = 0; i < 8; ++i) { w0[i] = (args.in[6])[0 * 512 + 8 * q + i]; w1[i] = (args.in[6])[1 * 512 + 8 * q + i]; w2[i] = (args.in[6])[2 * 512 + 8 * q + i]; pm2[i] = 0.f; pm1[i] = 0.f; }
            if (!head) {
                float a[8], b[8];
                unpack8(*(const u32x4*)(((bf16*)(args.ws + WS_A)) + pj((size_t)(r0 - 2), C_CC + 8 * q)), a); unpack8(*(const u32x4*)(((bf16*)(args.ws + WS_A)) + pj((size_t)(r0 - 2), C_CU + 8 * q)), b);
#pragma unroll
                for (int i = 0; i < 8; ++i) pm2[i] = a[i] * b[i];
                unpack8(*(const u32x4*)(((bf16*)(args.ws + WS_A)) + pj((size_t)(r0 - 1), C_CC + 8 * q)), a); unpack8(*(const u32x4*)(((bf16*)(args.ws + WS_A)) + pj((size_t)(r0 - 1), C_CU + 8 * q)), b);
#pragma unroll
                for (int i = 0; i < 8; ++i) pm1[i] = a[i] * b[i];
            }
            const bf16* pj0 = ((bf16*)(args.ws + WS_A));
            constexpr int YB = 4; u32x4 nb[YB][3];
#pragma unroll
            for (int j = 0; j < YB; ++j) { nb[j][0] = *(const u32x4*)(pj0 + pj((size_t)(r0 + j), C_CB + 8 * q)); nb[j][1] = *(const u32x4*)(pj0 + pj((size_t)(r0 + j), C_CC + 8 * q)); nb[j][2] = *(const u32x4*)(pj0 + pj((size_t)(r0 + j), C_CU + 8 * q)); }
#pragma unroll 1
            for (int r = 0; r < 32; r += YB) {
                u32x4 cur[YB][3];
#pragma unroll
                for (int j = 0; j < YB; ++j) { cur[j][0] = nb[j][0]; cur[j][1] = nb[j][1]; cur[j][2] = nb[j][2]; }
                {
#pragma unroll
                    for (int j = 0; j < YB; ++j) { const size_t rn = (size_t)(r0 + (r + YB + j < 32 ? r + YB + j : 31));
                        nb[j][0] = *(const u32x4*)(pj0 + pj(rn, C_CB + 8 * q)); nb[j][1] = *(const u32x4*)(pj0 + pj(rn, C_CC + 8 * q)); nb[j][2] = *(const u32x4*)(pj0 + pj(rn, C_CU + 8 * q)); } }
#pragma unroll
                for (int j = 0; j < YB; ++j) {
                    float cb[8], cc[8], cu[8], y[8];
                    unpack8(cur[j][0], cb); unpack8(cur[j][1], cc); unpack8(cur[j][2], cu);
#pragma unroll
                    for (int i = 0; i < 8; ++i) { const float p = cc[i] * cu[i]; y[i] = cb[i] * (w0[i] * pm2[i] + w1[i] * pm1[i] + w2[i] * p); pm2[i] = pm1[i]; pm1[i] = p; }
                    *(u32x4*)(((bf16*)(args.ws + WS_HB)) + (size_t)(r0 + r + j) * D + 512 + 8 * q) = pack8(y);
                }
            }
        }
#pragma unroll 1
        for (int jj = 0; jj < 2; ++jj) {
            const int ch0 = 8 * (q + 64 * jj);
            float w0[8], w1[8], w2[8], w3[8], bs[8], u3[8], u2[8], u1[8];
#pragma unroll
            for (int i = 0; i < 8; ++i) { w0[i] = (args.in[7])[0 * 1024 + ch0 + i]; w1[i] = (args.in[7])[1 * 1024 + ch0 + i]; w2[i] = (args.in[7])[2 * 1024 + ch0 + i]; w3[i] = (args.in[7])[3 * 1024 + ch0 + i];
                bs[i] = (args.in[8])[ch0 + i]; u3[i] = 0.f; u2[i] = 0.f; u1[i] = 0.f; }
            if (!head) { unpack8(*(const u32x4*)(((bf16*)(args.ws + WS_A)) + pj((size_t)(r0 - 3), C_XBC + ch0)), u3); unpack8(*(const u32x4*)(((bf16*)(args.ws + WS_A)) + pj((size_t)(r0 - 2), C_XBC + ch0)), u2);
                unpack8(*(const u32x4*)(((bf16*)(args.ws + WS_A)) + pj((size_t)(r0 - 1), C_XBC + ch0)), u1); }
            const bf16* pjx = ((bf16*)(args.ws + WS_A));
            constexpr int XB = 8; u32x4 nb[XB];
#pragma unroll
            for (int j = 0; j < XB; ++j) nb[j] = *(const u32x4*)(pjx + pj((size_t)(r0 + j), C_XBC + ch0));
#pragma unroll 1
            for (int r = 0; r < 32; r += XB) {
                u32x4 cur[XB];
#pragma unroll
                for (int j = 0; j < XB; ++j) cur[j] = nb[j];
#pragma unroll
                for (int j = 0; j < XB; ++j) nb[j] = *(const u32x4*)(pjx + pj((size_t)(r0 + (r + XB + j < 32 ? r + XB + j : 31)), C_XBC + ch0));
#pragma unroll
                for (int j = 0; j < XB; ++j) {
                    float u[8], y[8]; unpack8(cur[j], u);
#pragma unroll
                    for (int i = 0; i < 8; ++i) { y[i] = silu_f(bs[i] + w0[i] * u3[i] + w1[i] * u2[i] + w2[i] * u1[i] + w3[i] * u[i]); u3[i] = u2[i]; u2[i] = u1[i]; u1[i] = u[i]; }
                    *(u32x4*)(((bf16*)(args.ws + WS_XC)) + (size_t)(r0 + r + j) * D + ch0) = pack8(y);
                }
            }
        }
    }
}

constexpr int SD_SET = 55296, SD_BM = 0, SD_CM = 17408, SD_DX = 34816, SD_DXD = 39936, SD_XS = 45056, SD_ZR = 50176, SD_WM = 2 * SD_SET, SD_SB = SD_WM + 2 * 9216, SD_ACS = SD_SB + 8704, SD_DTS = SD_ACS + 768, SD_END = SD_DTS + 768;
static_assert(SD_END <= MISC_OFF, "SSD LDS map");
typedef short s16x4 __attribute__((ext_vector_type(4)));
__device__ __forceinline__ bf16x8 lds_tr8(const LAS unsigned char* p, int stride4) {
    const s16x4 a = __builtin_bit_cast(s16x4, __builtin_amdgcn_ds_read_tr16_b64_v4i16((LAS s16x4*)p));
    const s16x4 b = __builtin_bit_cast(s16x4, __builtin_amdgcn_ds_read_tr16_b64_v4i16((LAS s16x4*)(p + stride4)));
    return __builtin_shufflevector(a, b, 0, 1, 2, 3, 4, 5, 6, 7);
}
#define DPP_SHR_ADD(v, n) do { const int t_ = __builtin_amdgcn_update_dpp(0, __float_as_int(v), 0x110 + (n), 0xf, 0xf, true); (v) += __int_as_float(t_); } while (0)
__device__ __forceinline__ void p4_ssd(const Frame& F_, CArgs& args_) {
    Frame F = F_; F.lane = lane_id_asm(); F.tid = F.wave * 64 + F.lane;
    ARGS_LAUNDER(args_);
    LAS unsigned char* lds = F.lds; const int tid = F.tid, lane = F.lane, wave = F.wave, fr = lane & 15, fq = lane >> 4;
    const int tq = fr >> 2, tp = fr & 3;
    for (int uid = F.vcu; uid < 256; uid += F.G) {
        const int b = uid >> 4, h = (uid >> 1) & 7, ph = uid & 1, g = h >> 2;
        const float Ah = -__expf((args.in[10])[h]), Dh = (args.in[11])[h];
        const int xs_col = h * 64 + ph * 32, b_col = 512 + g * 128, c_col = 768 + g * 128, z_col = C_Z + h * 64 + ph * 32;
        f32x4 Sacc[2] = {(f32x4){0.f, 0.f, 0.f, 0.f}, (f32x4){0.f, 0.f, 0.f, 0.f}};
        for (int i = tid; i < 32 * 136 / 2; i += 512) ((LAS unsigned*)(lds + SD_SB))[i] = 0u;
        u32x4 pb[2][2], pc[2][2], px[2], pz[2]; float pdt[2] = {0.f, 0.f};
#pragma unroll
        for (int X = 0; X < 2; ++X) { px[X] = (u32x4){0u, 0u, 0u, 0u}; pz[X] = (u32x4){0u, 0u, 0u, 0u}; }
        const size_t trow0 = (size_t)b * SEQ;
        const bf16* XCp = ((const bf16*)(args.ws + WS_XC)); const bf16* PJ = ((const bf16*)(args.ws + WS_A)); const float* DTp = ((const float*)(args.ws + WS_DT));
        bf16* HBp = ((bf16*)(args.ws + WS_HB)); float* SQp = ((float*)(args.ws + WS_SSQ));
#define SSD_LOAD(cc, X) do { const size_t t0_ = trow0 + (size_t)(cc) * 64; \
            _Pragma("unroll") for (int k = 0; k < 2; ++k) { const int i_ = tid + 512 * k; pb[X][k] = *(const u32x4*)(XCp + (t0_ + (i_ >> 4)) * D + b_col + 8 * (i_ & 15)); pc[X][k] = *(const u32x4*)(XCp + (t0_ + (i_ >> 4)) * D + c_col + 8 * (i_ & 15)); } \
            if (wave < 4) { px[X] = *(const u32x4*)(XCp + (t0_ + (tid >> 2)) * D + xs_col + 8 * (tid & 3)); pz[X] = *(const u32x4*)(PJ + pj(t0_ + (tid >> 2), z_col + 8 * (tid & 3))); } \
            if (wave == 7) pdt[X] = DTp[(t0_ + lane) * 8 + h]; } while (0)
#define SSD_AUX(slot, X) do { if (wave == 7) { float a_ = pdt[X] * Ah; DPP_SHR_ADD(a_, 1); DPP_SHR_ADD(a_, 2); DPP_SHR_ADD(a_, 4); DPP_SHR_ADD(a_, 8); \
                const float r0_ = __int_as_float(__builtin_amdgcn_readlane(__float_as_int(a_), 15)), r1_ = __int_as_float(__builtin_amdgcn_readlane(__float_as_int(a_), 31)), r2_ = __int_as_float(__builtin_amdgcn_readlane(__float_as_int(a_), 47)); \
                a_ += (fq == 1) ? r0_ : (fq == 2) ? (r0_ + r1_) : (fq == 3) ? ((r0_ + r1_) + r2_) : 0.f; \
                ((LAS float*)(lds + SD_ACS))[(slot) * 64 + lane] = a_; ((LAS float*)(lds + SD_DTS))[(slot) * 64 + lane] = pdt[X]; } } while (0)
#define SSD_TILES(ts, X, slot) do { LAS unsigned char* tb_ = lds + (ts) * SD_SET; \
            _Pragma("unroll") for (int k = 0; k < 2; ++k) { const int i_ = tid + 512 * k; *(LAS u32x4*)(tb_ + SD_BM + ((i_ >> 4) * 136 + 8 * (i_ & 15)) * 2) = pb[X][k]; *(LAS u32x4*)(tb_ + SD_CM + ((i_ >> 4) * 136 + 8 * (i_ & 15)) * 2) = pc[X][k]; } \
            if (wave < 4) { const int l_ = tid >> 2, q_ = tid & 3; const LAS float* A_ = (const LAS float*)(lds + SD_ACS) + (slot) * 64; \
                *(LAS u32x4*)(tb_ + SD_XS + (l_ * 40 + 8 * q_) * 2) = px[X]; *(LAS u32x4*)(tb_ + SD_ZR + (l_ * 40 + 8 * q_) * 2) = pz[X]; \
                float f_[8], fd_[8]; unpack8(px[X], f_); const float dt_ = ((const LAS float*)(lds + SD_DTS))[(slot) * 64 + l_], dd_ = dt_ * __expf(A_[63] - A_[l_]); \
                _Pragma("unroll") for (int e = 0; e < 8; ++e) { fd_[e] = f_[e] * dd_; f_[e] *= dt_; } \
                *(LAS u32x4*)(tb_ + SD_DX + (l_ * 40 + 8 * q_) * 2) = pack8(f_); *(LAS u32x4*)(tb_ + SD_DXD + (l_ * 40 + 8 * q_) * 2) = pack8(fd_); } } while (0)
#define SSD_W(ts, slot) do { const LAS unsigned char* tb_ = lds + (ts) * SD_SET; const LAS float* A_ = (const LAS float*)(lds + SD_ACS) + (slot) * 64; \
            _Pragma("unroll") for (int jt = 0; jt < 2; ++jt) { const int id_ = 2 * wave + jt, lt_ = id_ >> 2, st_ = id_ & 3; f32x4 acc_ = (f32x4){0.f, 0.f, 0.f, 0.f}; \
                if (st_ <= lt_) { _Pragma("unroll") for (int kk = 0; kk < 4; ++kk) { const bf16x8 a_ = *(const LAS bf16x8*)(tb_ + SD_BM + ((st_ * 16 + fr) * 136 + kk * 32 + fq * 8) * 2); const bf16x8 b_ = *(const LAS bf16x8*)(tb_ + SD_CM + ((lt_ * 16 + fr) * 136 + kk * 32 + fq * 8) * 2); \
                        acc_ = __builtin_amdgcn_mfma_f32_16x16x32_bf16(a_, b_, acc_, 0, 0, 0); } } \
                const int l_ = lt_ * 16 + fr, s0_ = st_ * 16 + 4 * fq; const float al_ = A_[l_]; float w_[4]; const f32x4 as_ = *(const LAS f32x4*)(A_ + s0_);     \
                _Pragma("unroll") for (int r = 0; r < 4; ++r) { const int s_ = s0_ + r; const float e_ = acc_[r] * __expf(fminf(al_ - as_[r], 0.f)); w_[r] = (s_ <= l_) ? e_ : 0.f; } \
                u32x2 o_; o_.x = cvt_pk_bf16(w_[0], w_[1]); o_.y = cvt_pk_bf16(w_[2], w_[3]); *(LAS u32x2*)(lds + SD_WM + (ts) * 9216 + (l_ * 72 + s0_) * 2) = o_; } } while (0)
        SSD_LOAD(0, 0); SSD_LOAD(1, 1);
        SSD_AUX(0, 0); SSD_AUX(1, 1);
        WG_BAR();
        SSD_TILES(0, 0, 0);
        SSD_LOAD(2, 0);
        WG_BAR();
        SSD_W(0, 0);
        WG_BAR();
        int a0 = 0, a1 = 1, a2 = 2;
        u32x2 ypk = (u32x2){0u, 0u}; float yq = 0.f;
        for (int c2 = 0; c2 < 64; c2 += 2) {
#pragma unroll
        for (int par = 0; par < 2; ++par) {
            const int c = c2 + par; const size_t t0 = trow0 + (size_t)c * 64;
            const LAS unsigned char* tb = lds + par * SD_SET; const LAS float* ACS = (const LAS float*)(lds + SD_ACS) + a0 * 64;
            if (c + 1 < 64) SSD_TILES(par ^ 1, par ^ 1, a1);
            if (c + 2 < 64) SSD_AUX(a2, par);
            if (c > 0) { const int lt_ = wave >> 1, pt_ = wave & 1, l_ = lt_ * 16 + fr, p0_ = pt_ * 16 + 4 * fq; const size_t tp_ = t0 - 64;
                if (fq == 0) SQp[(size_t)((h * 2 + ph) * 2 + pt_) * T + tp_ + l_] = yq;
                *(u32x2*)(HBp + (tp_ + l_) * D + xs_col + p0_) = ypk; }
            if (c + 3 < 64) SSD_LOAD(c + 3, par ^ 1);
            const int lt = wave >> 1, pt = wave & 1, l = lt * 16 + fr, p0 = pt * 16 + 4 * fq;
            f32x4 yd = (f32x4){0.f, 0.f, 0.f, 0.f}, yo = (f32x4){0.f, 0.f, 0.f, 0.f};
#pragma unroll
            for (int kk = 0; kk < 2; ++kk) { const bf16x8 a = lds_tr8(tb + SD_DX + ((kk * 32 + 8 * fq + tq) * 40 + pt * 16 + 4 * tp) * 2, 4 * 80);
                const bf16x8 bb = *(const LAS bf16x8*)(lds + SD_WM + par * 9216 + ((lt * 16 + fr) * 72 + kk * 32 + fq * 8) * 2);
                yd = __builtin_amdgcn_mfma_f32_16x16x32_bf16(a, bb, yd, 0, 0, 0); }
#pragma unroll
            for (int kk = 0; kk < 4; ++kk) { const bf16x8 a = *(const LAS bf16x8*)(lds + SD_SB + ((pt * 16 + fr) * 136 + kk * 32 + fq * 8) * 2); const bf16x8 bb = *(const LAS bf16x8*)(tb + SD_CM + ((lt * 16 + fr) * 136 + kk * 32 + fq * 8) * 2);
                yo = __builtin_amdgcn_mfma_f32_16x16x32_bf16(a, bb, yo, 0, 0, 0); }
            const u32x2 xw = *(const LAS u32x2*)(tb + SD_XS + (l * 40 + p0) * 2), zw = *(const LAS u32x2*)(tb + SD_ZR + (l * 40 + p0) * 2);
            const float el = __expf(ACS[l]), cd = __expf(ACS[63]);
#pragma unroll
            for (int jt = 0; jt < 2; ++jt) { const int id = 2 * wave + jt, nt = id >> 1, pt2 = id & 1;
                Sacc[jt] = Sacc[jt] * cd;
#pragma unroll
                for (int kk = 0; kk < 2; ++kk) { const bf16x8 a = lds_tr8(tb + SD_BM + ((kk * 32 + 8 * fq + tq) * 136 + nt * 16 + 4 * tp) * 2, 4 * 272);
                    const bf16x8 bb = lds_tr8(tb + SD_DXD + ((kk * 32 + 8 * fq + tq) * 40 + pt2 * 16 + 4 * tp) * 2, 4 * 80);
                    Sacc[jt] = __builtin_amdgcn_mfma_f32_16x16x32_bf16(a, bb, Sacc[jt], 0, 0, 0); } }
            WG_BAR();
            {
                const float xs[4] = {bflo(xw.x), bfhi(xw.x), bflo(xw.y), bfhi(xw.y)}, zz[4] = {bflo(zw.x), bfhi(zw.x), bflo(zw.y), bfhi(zw.y)};
                float y[4], q2 = 0.f;
#pragma unroll
                for (int r = 0; r < 4; ++r) { y[r] = (yd[r] + el * yo[r] + Dh * xs[r]) * silu_f(zz[r]); q2 += y[r] * y[r]; }
                q2 += __shfl_xor(q2, 16); q2 += __shfl_xor(q2, 32);
                yq = q2; ypk.x = cvt_pk_bf16(y[0], y[1]); ypk.y = cvt_pk_bf16(y[2], y[3]);
            }
#pragma unroll
            for (int jt = 0; jt < 2; ++jt) { const int id = 2 * wave + jt, nt = id >> 1, pt2 = id & 1;
                u32x2 o; o.x = cvt_pk_bf16(Sacc[jt][0], Sacc[jt][1]); o.y = cvt_pk_bf16(Sacc[jt][2], Sacc[jt][3]);
                *(LAS u32x2*)(lds + SD_SB + ((pt2 * 16 + fr) * 136 + nt * 16 + 4 * fq) * 2) = o; }
            if (c + 1 < 64) SSD_W(par ^ 1, a1);
            WG_BAR();
            { const int t_ = a0; a0 = a1; a1 = a2; a2 = t_; }
        }
        }
#undef SSD_LOAD
#undef SSD_AUX
#undef SSD_TILES
#undef SSD_W
        { const int lt_ = wave >> 1, pt_ = wave & 1, l_ = lt_ * 16 + fr, p0_ = pt_ * 16 + 4 * fq; const size_t tp_ = trow0 + (size_t)63 * 64;
            if (fq == 0) SQp[(size_t)((h * 2 + ph) * 2 + pt_) * T + tp_ + l_] = yq;
            *(u32x2*)(HBp + (tp_ + l_) * D + xs_col + p0_) = ypk; }
        WG_BAR();
    }
}

__device__ __forceinline__ void p1_router_weights(const Frame& F_, CArgs& args_) {
    Frame F = F_; F.lane = lane_id_asm(); F.tid = F.wave * 64 + F.lane;
    ARGS_LAUNDER(args_);
    LAS float* red = (LAS float*)F.lds;
    for (int w = F.vcu; w < 256; w += F.G) {
        const int b = w >> 4, e0 = 4 * (w & 15); float bs[4] = {0.f, 0.f, 0.f, 0.f};
        const float* mod = (const float*)(args.ws + WS_MOD) + b * 6144;
#pragma unroll
        for (int kk = 0; kk < 2; ++kk) { const int k = F.tid + 512 * kk; const f32x4 wv = *(const f32x4*)((args.in[15]) + (size_t)k * 64 + e0);
            const float sc = (args.in[14])[k] * (1.0f + mod[4096 + k]), sh = mod[3072 + k];
#pragma unroll
            for (int j = 0; j < 4; ++j) { ((bf16*)(args.ws + WS_WR))[((size_t)b * 64 + e0 + j) * 1024 + k] = f2bf(wv[j] * sc); bs[j] += sh * wv[j]; } }
#pragma unroll
        for (int j = 0; j < 4; ++j) bs[j] = wave_sum(bs[j]);
        if (F.lane == 0) { red[F.wave * 4 + 0] = bs[0]; red[F.wave * 4 + 1] = bs[1]; red[F.wave * 4 + 2] = bs[2]; red[F.wave * 4 + 3] = bs[3]; }
        WG_BAR();
        if (F.tid < 4) { float s = 0.f;
#pragma unroll
            for (int q = 0; q < 8; ++q) s += red[q * 4 + F.tid];
            ((float*)(args.ws + WS_RB))[b * 64 + e0 + F.tid] = s; }
        WG_BAR();
    }
}
constexpr int RT_WST = 1032;
constexpr int RT_LOG = 0, RT_CNT = 65536, RT_BASE = 65536 + 256, RT_LE = 66560, RT_LW = 66560 + 8192;
constexpr int RT_RS = RT_LW + 8192;
static_assert(64 * RT_WST * 2 <= MISC_OFF && RT_RS + 1024 <= MISC_OFF, "router LDS map");
__device__ __forceinline__ void p7_router(const Frame& F_, CArgs& args_) {
    Frame F = F_; F.lane = lane_id_asm(); F.tid = F.wave * 64 + F.lane;
    ARGS_LAUNDER(args_);
    LAS unsigned char* lds = F.lds; const int tid = F.tid, lane = F.lane, wave = F.wave, fr = lane & 15, fq = lane >> 4;
    LAS int* lcnt = (LAS int*)(lds + RT_CNT); LAS int* lbase = (LAS int*)(lds + RT_BASE);
    LAS unsigned* le = (LAS unsigned*)(lds + RT_LE); LAS float* lw = (LAS float*)(lds + RT_LW);
    const float bias = (args.in[16])[lane];
    for (int tile = F.vcu; tile < T / 256; tile += F.G) {
        const int s = (tile * 256) / TS, b = (tile * 256) / SEQ;
        { const u32x4* wsrc = (const u32x4*)((const bf16*)(args.ws + WS_WR) + (size_t)b * 64 * 1024);
          u32x4 wt[16];
#pragma unroll
          for (int j = 0; j < 16; ++j) wt[j] = wsrc[tid + 512 * j];
#pragma unroll
          for (int j = 0; j < 16; ++j) { const int i = tid + 512 * j, e = i >> 7, c = i & 127; *(LAS u32x4*)(lds + (e * RT_WST + 8 * c) * 2) = wt[j]; } }
        WG_BAR();
        const bf16* xb = (const bf16*)(args.ws + WS_X1) + (size_t)(tile * 256 + wave * 32) * D;
        f32x4 acc[2][4]; float ssq[2] = {0.f, 0.f};
#pragma unroll
        for (int g = 0; g < 2; ++g)
#pragma unroll
            for (int n = 0; n < 4; ++n) acc[g][n] = (f32x4){0.f, 0.f, 0.f, 0.f};
        constexpr int XG = 2;
        u32x4 xs0[XG][2], xs1[XG][2], xs2[XG][2], xs3[XG][2];
#define RT_XLOAD(dst, k0_) do { _Pragma("unroll") for (int q = 0; q < XG; ++q) _Pragma("unroll") for (int g = 0; g < 2; ++g) dst[q][g] = *(const u32x4*)(xb + (size_t)(16 * g + fr) * D + 32 * ((k0_) + q) + 8 * fq); } while (0)
#define RT_XMMA(srcx, k0_) do { _Pragma("unroll") for (int q = 0; q < XG; ++q) { const int ks = (k0_) + q; bf16x8 bfr[2]; \
            _Pragma("unroll") for (int g = 0; g < 2; ++g) { const u32x4 xv = srcx[q][g]; bfr[g] = __builtin_bit_cast(bf16x8, xv); float f[8]; unpack8(xv, f); _Pragma("unroll") for (int j = 0; j < 8; ++j) ssq[g] += f[j] * f[j]; } \
            _Pragma("unroll") for (int n = 0; n < 4; ++n) { const bf16x8 afr = *(const LAS bf16x8*)(lds + ((16 * n + fr) * RT_WST + 32 * ks + 8 * fq) * 2); \
                _Pragma("unroll") for (int g = 0; g < 2; ++g) acc[g][n] = __builtin_amdgcn_mfma_f32_16x16x32_bf16(afr, bfr[g], acc[g][n], 0, 0, 0); } } } while (0)
        RT_XLOAD(xs0, 0); RT_XLOAD(xs1, XG); RT_XLOAD(xs2, 2 * XG); RT_XLOAD(xs3, 3 * XG);
#pragma unroll 1
        for (int k0 = 0; k0 < 32; k0 += 4 * XG) {
            const int kn = k0 + 4 * XG < 32 ? k0 + 4 * XG : k0;
            RT_XMMA(xs0, k0);          RT_XLOAD(xs0, kn);
            RT_XMMA(xs1, k0 + XG);     RT_XLOAD(xs1, kn + XG);
            RT_XMMA(xs2, k0 + 2 * XG); RT_XLOAD(xs2, kn + 2 * XG);
            RT_XMMA(xs3, k0 + 3 * XG); RT_XLOAD(xs3, kn + 3 * XG);
        }
#undef RT_XLOAD
#undef RT_XMMA
        WG_BAR();
        if (tid < 64) lcnt[tid] = 0;
#pragma unroll
        for (int g = 0; g < 2; ++g) { float q = ssq[g]; q += __shfl_xor(q, 16); q += __shfl_xor(q, 32); const float rstd = rsqrtf(q * (1.0f / D) + EPS);
            if (fq == 0) *(LAS float*)(lds + RT_RS + (wave * 32 + 16 * g + fr) * 4) = rstd;
#pragma unroll
            for (int n = 0; n < 4; ++n) { const f32x4 rb = *(const f32x4*)((const float*)(args.ws + WS_RB) + b * 64 + 16 * n + 4 * fq);
                *(LAS f32x4*)(lds + RT_LOG + ((wave * 32 + 16 * g + fr) * 64 + 16 * n + 4 * fq) * 4) = acc[g][n] * rstd + rb; } }
        WG_BAR();
        f32x4 hsc[4], hsh[4];
#pragma unroll
        for (int j = 0; j < 4; ++j) { const int col = 16 * lane + 4 * j; const float* mod = (const float*)(args.ws + WS_MOD) + b * 6144;
            hsc[j] = *(const f32x4*)((args.in[14]) + col) * (*(const f32x4*)(mod + 4096 + col) + 1.0f); hsh[j] = *(const f32x4*)(mod + 3072 + col); }
        const bf16* xrow = (const bf16*)(args.ws + WS_X1) + (size_t)(tile * 256 + wave * 32) * D + 16 * lane;
        unsigned char* hrow = (unsigned char*)(args.ws + WS_H8) + (size_t)(tile * 256 + wave * 32) * D + 16 * lane;
        u32x4 xn0 = *(const u32x4*)(xrow), xn1 = *(const u32x4*)(xrow + 8);
#pragma unroll 2
        for (int i = 0; i < 32; ++i) {
            const int tl = wave * 32 + i;
            const u32x4 xc0 = xn0, xc1 = xn1;
            if (i + 1 < 32) { xn0 = *(const u32x4*)(xrow + (size_t)(i + 1) * D); xn1 = *(const u32x4*)(xrow + (size_t)(i + 1) * D + 8); }
            { const float rs = *(const LAS float*)(lds + RT_RS + tl * 4); float f[16]; { float t8[8]; unpack8(xc0, t8);
#pragma unroll
                for (int j = 0; j < 8; ++j) f[j] = t8[j]; unpack8(xc1, t8);
#pragma unroll
                for (int j = 0; j < 8; ++j) f[8 + j] = t8[j]; }
                u32x4 hw; unsigned hv[4];
#pragma unroll
                for (int j = 0; j < 4; ++j) { const f32x4 h = (f32x4){f[4 * j], f[4 * j + 1], f[4 * j + 2], f[4 * j + 3]} * rs * hsc[j] + hsh[j];
                    int q8 = __builtin_amdgcn_cvt_pk_fp8_f32(h.x, h.y, 0, false); q8 = __builtin_amdgcn_cvt_pk_fp8_f32(h.z, h.w, q8, true); hv[j] = (unsigned)q8; }
                hw.x = hv[0]; hw.y = hv[1]; hw.z = hv[2]; hw.w = hv[3];
                *(u32x4*)(hrow + (size_t)i * D) = hw; }
            const float logit = *(const LAS float*)(lds + RT_LOG + (tl * 64 + lane) * 4);
            const float score = __builtin_amdgcn_rcpf(1.0f + __expf(-logit)), sel = score + bias;
            const float m1 = max8(sel);
            const unsigned long long eq = __ballot(sel == m1);
            const unsigned gm = (unsigned)(eq >> (lane & 56)) & 0xffu;
            const int first = gm ? __builtin_ctz(gm) : 0;
            const float m2 = max8(((lane & 7) == first) ? -INFINITY : sel);
            const float gs = m1 + m2; const int g = lane >> 3; int grank = 0;
            const unsigned ghi = f32_key(gs); const unsigned long long gme = ((unsigned long long)ghi << 32) | (unsigned)(7 - g);
#pragma unroll
            for (int j = 0; j < 8; ++j) { const unsigned long long go = ((unsigned long long)(unsigned)__builtin_amdgcn_readlane((int)ghi, 8 * j) << 32) | (unsigned)(7 - j); grank += (go > gme) ? 1 : 0; }
            const bool gsel = grank < 4; const unsigned long long gmask = __ballot(gsel);
            int rank = 0;
            const unsigned khi = f32_key(sel); const unsigned long long kme = ((unsigned long long)khi << 32) | (unsigned)(63 - lane);
#pragma unroll
            for (int j = 0; j < 8; ++j) if ((gmask >> (8 * j)) & 1ull) {
#pragma unroll
                for (int i = 0; i < 8; ++i) { const unsigned long long ko = ((unsigned long long)(unsigned)__builtin_amdgcn_readlane((int)khi, 8 * j + i) << 32) | (unsigned)(63 - (8 * j + i)); rank += (ko > kme) ? 1 : 0; } }
            const bool chosen = gsel && rank < TOPK;
            const float wsum = wave_sum(chosen ? score : 0.f);
            if (chosen) { const int pos = __hip_atomic_fetch_add(lcnt + lane, 1, __ATOMIC_RELAXED, __HIP_MEMORY_SCOPE_WORKGROUP);
                le[tl * 8 + rank] = (unsigned)lane | ((unsigned)pos << 8); lw[tl * 8 + rank] = score / wsum * 2.5f; }
        }
        WG_BAR();
        if (tid < 64) lbase[tid] = (int)__hip_atomic_fetch_add(((unsigned*)(args.ws + WS_CTL) + CW_CNT) + s * 80 + tid, (unsigned)lcnt[tid], RLX_AGENT);
        WG_BAR();
        for (int idx = tid; idx < 2048; idx += 512) { const unsigned v = le[idx]; const int e = v & 0xffu; const size_t o = (size_t)tile * 2048 + idx;
            const int pos = (int)(v >> 8) + lbase[e]; ((int*)(args.ws + WS_IDX))[o] = e; ((int*)(args.ws + WS_APOS))[o] = pos; ((float*)(args.ws + WS_WGT))[o] = lw[idx];
            ((int*)(args.ws + WS_LIST))[(size_t)e * T + pos] = tile * 256 + (idx >> 3); }
        WG_BAR();
    }
}
__device__ __forceinline__ void load_eoff(const Frame& F_, CArgs& args_) {
    Frame F = F_; F.lane = lane_id_asm(); F.tid = F.wave * 64 + F.lane;
    ARGS_LAUNDER(args_);
    LAS int* eoff = (LAS int*)(F.lds + EO_OFF); LAS int* ecnt = (LAS int*)(F.lds + EC_OFF);
    if (F.tid < S_SB) { const int s = F.tid; int acc = 0;
        for (int e = 0; e < NEX; ++e) { const int cnt = e < NE ? (int)((unsigned*)(args.ws + WS_CTL) + CW_CNT)[s * 80 + e] : TS; eoff[s * 72 + e] = acc; ecnt[s * 72 + e] = cnt; acc += (cnt + 255) & ~255; }
        eoff[s * 72 + NEX] = acc; }
    WG_BAR();
}
__device__ __forceinline__ int moe_tables(const Frame& F_, CArgs& args_, int s, bool gather) {
    Frame F = F_; F.lane = lane_id_asm(); F.tid = F.wave * 64 + F.lane;
    ARGS_LAUNDER(args_);
    asm volatile("" : "+s"(s));
    const LAS int* eoff = (const LAS int*)(F.lds + EO_OFF) + s * 72;
    LAS unsigned char* te = F.lds + TE_OFF;
    const int NT = eoff[NEX] >> 8;
    for (int e = F.wave; e < NEX; e += 8) { const int t0 = eoff[e] >> 8, t1 = eoff[e + 1] >> 8; for (int t = t0 + F.lane; t < t1; t += 64) te[t] = (unsigned char)e; }
    WG_BAR();
    if (gather) { LAS unsigned* tab = (LAS unsigned*)(F.lds + TAB_OFF);
        int nsl = (2 * NT - F.vcu + F.G - 1) / F.G; nsl = nsl < 0 ? 0 : (nsl > TAB_SLOTS ? TAB_SLOTS : nsl);
        const int nent = nsl * 256; const int* LISTp = (const int*)(args.ws + WS_LIST);
#pragma unroll 1
        for (int base = 0; base < nent; base += 2048) {
            int tokv[4], dflt[4]; bool fromlist[4];
#pragma unroll
            for (int j = 0; j < 4; ++j) { int idx = base + j * 512 + F.tid; idx = idx < nent ? idx : nent - 1; const int i = idx >> 8, r = idx & 255, rt = (i * F.G + F.vcu) >> 1;
                const int e = te[rt], pos = rt * 256 - eoff[e] + r;
                fromlist[j] = e < NE && pos < ((const LAS int*)(F.lds + EC_OFF))[s * 72 + e]; dflt[j] = e < NE ? 0 : s * TS + pos;
                tokv[j] = LISTp[fromlist[j] ? (size_t)e * T + pos : (size_t)0]; }
#pragma unroll
            for (int j = 0; j < 4; ++j) { const int idx = base + j * 512 + F.tid; if (idx < nent) tab[idx] = (unsigned)(fromlist[j] ? tokv[j] : dflt[j]) * 1024u; }
        } }
    WG_BAR();
    return NT;
}
__device__ __forceinline__ void pc_combine(const Frame& F_, CArgs& args_, int s) {
    Frame F = F_; F.lane = lane_id_asm(); F.tid = F.wave * 64 + F.lane;
    ARGS_LAUNDER(args_);
    asm volatile("" : "+s"(s));
    const LAS int* eoff = (const LAS int*)(F.lds + EO_OFF) + s * 72;
    const int shoff = eoff[NE];
    const int gw = F.vcu * 8 + F.wave, NGW = F.G * 8, lane = F.lane;
    constexpr int PER = 16;
    const unsigned char* Y8 = (const unsigned char*)(args.ws + WS_A); const bf16* x1b = (const bf16*)(args.ws + WS_X1);
    for (int blk = gw; blk < TS / PER; blk += NGW) {
        const int tl0 = blk * PER, b = (s * TS + tl0) / SEQ;
        f32x4 g2[4], nf[4];
#pragma unroll
        for (int i = 0; i < 4; ++i) { const int col = 256 * i + 4 * lane; g2[i] = *(const f32x4*)(((float*)(args.ws + WS_MOD)) + b * 6144 + 5120 + col); nf[i] = *(const f32x4*)((args.in[23]) + col); }
#pragma unroll 2
        for (int r = 0; r < PER; ++r) {
            const int tl = tl0 + r, t = s * TS + tl;
            f32x4 acc[4];
#pragma unroll
            for (int i = 0; i < 4; ++i) acc[i] = (f32x4){0.f, 0.f, 0.f, 0.f};
#pragma unroll
            for (int k = 0; k < 9; ++k) {
                const int row = k < 8 ? eoff[((int*)(args.ws + WS_IDX))[(size_t)t * 8 + k]] + ((int*)(args.ws + WS_APOS))[(size_t)t * 8 + k] : shoff + tl; const float w = (k < 8 ? ((float*)(args.ws + WS_WGT))[(size_t)t * 8 + k] : 1.0f) * (1.0f / 16.0f);
                unsigned yw[4];
#pragma unroll
                for (int i = 0; i < 4; ++i) yw[i] = *(const unsigned*)(Y8 + (size_t)row * D + 256 * i + 4 * lane);
#pragma unroll
                for (int i = 0; i < 4; ++i) { const f32x2 lo = __builtin_amdgcn_cvt_pk_f32_fp8((int)yw[i], false), hi = __builtin_amdgcn_cvt_pk_f32_fp8((int)yw[i], true);
                    acc[i] = acc[i] + (f32x4){lo.x, lo.y, hi.x, hi.y} * w; }
            }
            float* orow = (args.out) + (size_t)t * D + 4 * lane; float ss = 0.f; f32x4 xf[4];
#pragma unroll
            for (int i = 0; i < 4; ++i) { const u32x2 xw = *(const u32x2*)(x1b + (size_t)t * D + 256 * i + 4 * lane); const f32x4 x1 = (f32x4){bflo(xw.x), bfhi(xw.x), bflo(xw.y), bfhi(xw.y)}; const f32x4 v = x1 + g2[i] * acc[i]; xf[i] = v; ss += (v.x * v.x + v.y * v.y) + (v.z * v.z + v.w * v.w); }
            const float rstd = rsqrtf(wave_sum(ss) * (1.0f / D) + EPS);
#pragma unroll
            for (int i = 0; i < 4; ++i) *(f32x4*)(orow + 256 * i) = xf[i] * rstd * nf[i];
        }
    }
}

__device__ __forceinline__ void stagger(int quanta) { const int j = ((int)blockIdx.x >> 3) & 7; for (int i = 0; i < j * quanta; ++i) __builtin_amdgcn_s_sleep(16); }

constexpr int NPH = 10 + 3 * S_SB;
__global__ void __launch_bounds__(512, 2) fwd_kernel(Args args_k) {
    CArgs& kargs = *(CArgs*)__builtin_amdgcn_kernarg_segment_ptr();
    extern __shared__ __attribute__((aligned(16))) unsigned char lds_raw[];
    Frame F;
    F.lds = (LAS unsigned char*)lds_raw; F.MISC = (volatile LAS unsigned*)(F.lds + MISC_OFF);
    F.wave = __builtin_amdgcn_readfirstlane((int)threadIdx.x >> 6); F.lane = 0; F.tid = 0;
    F.G = gridDim.x; { const int bx = blockIdx.x; F.vcu = (F.G % 8 == 0) ? (bx % 8) * (F.G / 8) + bx / 8 : bx; }
    F.ctl = (unsigned*)(kargs.ws + WS_CTL);
    if (threadIdx.x < 64) ((LAS unsigned*)(F.lds + MISC_OFF))[threadIdx.x] = 0u;
    __syncthreads();
    XcdBarrier bar; bar.bar = F.ctl + CW_BAR; bar.x = 0; bar.st = nullptr;
    if (!MK_PER_PHASE) bar = xcd_barrier_post(F.ctl + CW_BAR, F.MISC);
    const int lo = MK_PER_PHASE ? kargs.ph_lo : 0, hi = MK_PER_PHASE ? kargs.ph_hi : NPH;
#ifndef PH_ENABLE
#define PH_ENABLE 0xffffffffu
#endif
#define IN(k) (((PH_ENABLE >> ((k) > 9 ? 10 + ((k) - 10) % 3 : (k))) & 1u) && lo <= (k) && (k) < hi)
#ifndef DUP_MASK
#define DUP_MASK 0u
#endif
#define REPEAT(k) _Pragma("unroll 1") for (int rep_ = 0; rep_ < 1 + (int)((DUP_MASK >> (k)) & 1u); ++rep_)
#define SEAM(k) do { if (!MK_PER_PHASE && IN(k) && IN((k) + 1)) xcd_barrier(bar, F.wave); } while (0)

    if (IN(0)) { REPEAT(0) { p0_prologue(F, kargs); } SEAM(0); }
    if (IN(1)) { ARGS_LAUNDER(kargs); p1_router_weights(F, kargs); REPEAT(1) { p_norm_mod<true, false>(F, kargs, (args.in[0]), (args.in[4]), 0, 1024, ((bf16*)(args.ws + WS_HB)), nullptr); } SEAM(1); }
    if (IN(2)) { ARGS_LAUNDER(kargs);
        pg8::PlainOrder S; S.init(((bf16*)(args.ws + WS_HB)), ((bf16*)(args.ws + WS_WIN)), T, NPROJ, D, F.G, (int)blockIdx.x); pg8::EpiBf16T E{((bf16*)(args.ws + WS_A)), NPROJ / 256};
        stagger(STG_P2); REPEAT(2) { pg8::gemm_phase<pg8::EpiBf16T, pg8::PlainOrder, true>(F.lds, F.wave, D, S, E); } SEAM(2); }
    if (IN(3)) { REPEAT(3) { p3_conv(F, kargs); } SEAM(3); }
    if (IN(4)) { REPEAT(4) { p4_ssd(F, kargs); } SEAM(4); }
    if (IN(5)) { ARGS_LAUNDER(kargs);
        pg8::PlainOrder S; S.init(((bf16*)(args.ws + WS_HB)), ((bf16*)(args.ws + WS_WOUT)), T, D, D, F.G, (int)blockIdx.x);
        {
            const int lane = lane_id_asm(), tid = F.wave * 64 + lane, r = tid & 255, hf = tid >> 8;
            LAS float* rstab = (LAS float*)(F.lds + TAB_OFF); LAS float* tmp = (LAS float*)(F.lds);
            pg8::Unit u;
            for (int i0 = 0; i0 < 16; i0 += 4) {
                float sv[4]; bool ok[4]; float pv[4][16];
#pragma unroll
                for (int j = 0; j < 4; ++j) { ok[j] = S.next(i0 + j, u); const int pm = ok[j] ? u.pm : 0;
                    const float* sp = ((const float*)(args.ws + WS_SSQ)) + (size_t)(16 * hf) * T + pm * 256 + r;
#pragma unroll
                    for (int q = 0; q < 16; ++q) pv[j][q] = sp[(size_t)q * T]; }
#pragma unroll
                for (int j = 0; j < 4; ++j) { float s = 0.f;
#pragma unroll
                    for (int q = 0; q < 16; ++q) s += pv[j][q];
                    sv[j] = s; if (hf) tmp[j * 256 + r] = s; }
                WG_BAR();
#pragma unroll
                for (int j = 0; j < 4; ++j) if (!hf && ok[j]) rstab[(i0 + j) * 256 + r] = rsqrtf((sv[j] + tmp[j * 256 + r]) * (1.0f / 512.0f) + EPS);
                WG_BAR();
                if (!ok[3]) break;
            }
        }
        pg8::EpiX1 E{(args.in[0]), (bf16*)(args.ws + WS_X1), ((float*)(args.ws + WS_MOD)) + 2048, (const LAS float*)(F.lds + TAB_OFF)};
        stagger(STG_P5); REPEAT(5) { pg8::gemm_phase<pg8::EpiX1, pg8::PlainOrder, false>(F.lds, F.wave, D, S, E); } SEAM(5); }
    if (IN(6)) { p7_router(F, kargs); SEAM(9); }
    load_eoff(F, kargs);
    for (int s = 0; s < S_SB; ++s) {
        const int k0 = 10 + 3 * s;
        if (IN(k0)) { ARGS_LAUNDER(kargs);
            const int NT = moe_tables(F, kargs, s, true);
            pg8::MoeOrder<1, true> S; S.NT = NT; S.G = F.G; S.c = F.vcu; S.A = (const char*)(args.ws + WS_H8); S.W = (const char*)(args.ws + WS_WGU); S.rowb = 0; S.w_exp = (size_t)512 * 1024; S.w_tile = (size_t)256 * 1024;
            S.te = F.lds + TE_OFF; S.tab = (const LAS unsigned*)(F.lds + TAB_OFF);
            pg8::EpiGU E{(unsigned char*)(args.ws + WS_HID)};
            stagger(STG_G); REPEAT(10) { pg8::gemm_phase<pg8::EpiGU, pg8::MoeOrder<1, true>, true, true>(F.lds, F.wave, D, S, E); } SEAM(k0); }
        if (IN(k0 + 1)) { ARGS_LAUNDER(kargs);
            const int NT = moe_tables(F, kargs, s, false);
            pg8::MoeOrder<2, false> S; S.NT = NT; S.G = F.G; S.c = F.vcu; S.A = (const char*)(args.ws + WS_HID); S.W = (const char*)(args.ws + WS_WD); S.rowb = 256u; S.w_exp = (size_t)1024 * 256; S.w_tile = (size_t)256 * 256;
            S.te = F.lds + TE_OFF; S.tab = (const LAS unsigned*)(F.lds + TAB_OFF);
            pg8::EpiFp8 E{(unsigned char*)(args.ws + WS_A), D, 1.0f};
            int Kd = 256; asm volatile("" : "+s"(Kd));
            stagger(STG_D); REPEAT(11) { pg8::gemm_phase<pg8::EpiFp8, pg8::MoeOrder<2, false>, true, true>(F.lds, F.wave, Kd, S, E); } SEAM(k0 + 1); }
        if (IN(k0 + 2)) { pc_combine(F, kargs, s); if (MK_PER_PHASE == 0 && s + 1 < S_SB) { asm volatile("s_waitcnt vmcnt(0)" ::: "memory"); __syncthreads(); } }
    }
#undef IN
#undef SEAM
}

extern "C" void kernel_launch(void* const* d_in, const int* in_sizes, int n_in, void* d_out, int out_size, void* d_ws, size_t ws_size, hipStream_t stream) {
    static int grid = 0;
    if (grid == 0) {
        if (n_in != 24 || in_sizes[0] != T * D || out_size != T * D || ws_size < WS_END) { fprintf(stderr, "kernel_launch: unexpected shapes / workspace (n_in %d, ws %zu, need %zu)\n", n_in, ws_size, (size_t)WS_END); grid = -1; return; }
        int dev = 0, cus = 0, per_cu = 0;
        if (hipGetDevice(&dev) != hipSuccess || hipDeviceGetAttribute(&cus, hipDeviceAttributeMultiprocessorCount, dev) != hipSuccess) { grid = -1; return; }
        if (hipFuncSetAttribute((const void*)fwd_kernel, hipFuncAttributeMaxDynamicSharedMemorySize, LDS_BYTES) != hipSuccess) { fprintf(stderr, "kernel_launch: hipFuncSetAttribute failed\n"); grid = -1; return; }
        if (hipOccupancyMaxActiveBlocksPerMultiprocessor(&per_cu, (const void*)fwd_kernel, 512, LDS_BYTES) != hipSuccess || per_cu < 1) fprintf(stderr, "kernel_launch: occupancy query says %d\n", per_cu);
        (void)hipGetLastError();
        grid = cus;
    }
    if (grid < 0) return;
    if (hipMemsetAsync((char*)d_ws + WS_CTL, 0, CTL_ZERO_BYTES, stream) != hipSuccess) return;
    Args a{};
    for (int i = 0; i < 24; ++i) a.in[i] = (const float*)d_in[i];
    a.out = (float*)d_out; a.ws = (unsigned char*)d_ws;
#if MK_PER_PHASE
    for (int p = 0; p < NPH; ++p) { a.ph_lo = p; a.ph_hi = p + 1; hipLaunchKernelGGL(fwd_kernel, dim3(grid), dim3(512), LDS_BYTES, stream, a); }
#else
    a.ph_lo = 0; a.ph_hi = NPH;
    hipLaunchKernelGGL(fwd_kernel, dim3(grid), dim3(512), LDS_BYTES, stream, a);
#endif
}
```

```cpp
#include <hip/hip_runtime.h>
#include <cstdio>
#include <cstdint>

#define LAS __attribute__((address_space(3)))
#define GAS __attribute__((address_space(1)))
typedef unsigned short bf16;
typedef short bf16x8 __attribute__((ext_vector_type(8)));
typedef float f32x4 __attribute__((ext_vector_type(4)));
typedef float f32x2 __attribute__((ext_vector_type(2)));
typedef unsigned u32x4 __attribute__((ext_vector_type(4)));
typedef unsigned u32x2 __attribute__((ext_vector_type(2)));

#define STG_P2 0
#define STG_P5 0
#define STG_G 0
#define STG_D 0
#ifndef MK_PER_PHASE
#define MK_PER_PHASE 0
#endif

constexpr int T = 65536, D = 1024, SEQ = 4096, NB = 16;
constexpr int NPROJ = 3072, LDWIN = 3080;
constexpr int C_CB = 0, C_CC = 512, C_CU = 1024, C_Z = 1536, C_XBC = 2048;
constexpr int NE = 64, NEX = 65, TOPK = 8;
constexpr int S_SB = 1, TS = T / S_SB;
constexpr int MAXT = (TS * 9) / 256 + 64;
constexpr int MAXROWS = MAXT * 256;
constexpr float EPS = 1e-6f;

constexpr size_t MiB = 1u << 20;
constexpr size_t WS_CTL = 0, CTL_ZERO_BYTES = 1 * MiB;
constexpr size_t WS_MOD = 128 * 1024;
constexpr size_t WS_WDT = 1 * MiB;
constexpr size_t WS_WIN = 2 * MiB, WS_WOUT = 8 * MiB, WS_WR = 10 * MiB;
constexpr size_t WS_RB = 1 * MiB + 64 * 1024;
constexpr size_t WS_WGU = 12 * MiB;
constexpr size_t WS_WD = 45 * MiB;
constexpr size_t WS_DT = 62 * MiB;
constexpr size_t WS_IDX = 64 * MiB, WS_WGT = 66 * MiB, WS_APOS = 68 * MiB, WS_ROWOF = 70 * MiB;
constexpr size_t WS_R2T = 72 * MiB;
constexpr size_t WS_HB = 76 * MiB;
constexpr size_t WS_HID = 76 * MiB;
constexpr size_t WS_A = 232 * MiB;
constexpr size_t WS_XC = 616 * MiB;
constexpr size_t WS_SSQ = 744 * MiB;
constexpr size_t WS_LOG = 752 * MiB;
constexpr size_t WS_H8 = 768 * MiB;
constexpr size_t WS_X1 = 832 * MiB;
constexpr size_t WS_LIST = 960 * MiB;
constexpr size_t WS_END = 976 * MiB;
static_assert(WS_WGU + (size_t)NEX * 512 * 1024 <= WS_WD && WS_WD + (size_t)NEX * 1024 * 256 <= WS_DT && WS_R2T + (size_t)S_SB * MAXROWS * 4 <= WS_HB && WS_HID + (size_t)MAXROWS * 256 <= WS_A && WS_HB + (size_t)T * D * 2 <= WS_A
              && WS_A + (size_t)T * NPROJ * 2 <= WS_XC && WS_A + (size_t)MAXROWS * 1024 <= WS_X1 && WS_XC + (size_t)T * D * 2 <= WS_SSQ && WS_SSQ + (size_t)32 * T * 4 <= WS_LOG && WS_LOG + (size_t)T * 64 * 4 <= WS_H8
              && WS_H8 + (size_t)T * D <= WS_X1 && WS_X1 + (size_t)T * D * 2 <= WS_LIST && WS_LIST + (size_t)NE * T * 4 <= WS_END, "ws map");
constexpr int CW_BAR = 4096;
constexpr int CW_CNT = 8192;

constexpr int RING_BYTES = 131072;
constexpr int TAB_SLOTS = 20;
constexpr int TAB_OFF = RING_BYTES, TAB_BYTES = TAB_SLOTS * 1024;
constexpr int TE_OFF = TAB_OFF + TAB_BYTES;
constexpr int EO_OFF = TE_OFF + ((MAXT + 63) / 64) * 64;
constexpr int EC_OFF = EO_OFF + S_SB * 72 * 4;
constexpr int MISC_OFF = EC_OFF + S_SB * 72 * 4;
constexpr int LDS_BYTES = ((MISC_OFF + 256 + 1023) / 1024) * 1024;
static_assert(LDS_BYTES <= 160 * 1024 && (2 * MAXT + 255) / 256 <= TAB_SLOTS, "LDS");

#define RLX_AGENT __ATOMIC_RELAXED, __HIP_MEMORY_SCOPE_AGENT
#define LDS_WAIT() asm volatile("s_waitcnt lgkmcnt(0)" ::: "memory")
#define WG_BAR() do { asm volatile("s_waitcnt lgkmcnt(0)" ::: "memory"); __builtin_amdgcn_s_barrier(); asm volatile("" ::: "memory"); } while (0)
__device__ __forceinline__ unsigned cvt_pk_bf16(float lo, float hi) { unsigned r; asm volatile("v_cvt_pk_bf16_f32 %0, %1, %2" : "=v"(r) : "v"(lo), "v"(hi)); return r; }
__device__ __forceinline__ float bflo(unsigned w) { return __uint_as_float(w << 16); }
__device__ __forceinline__ float bfhi(unsigned w) { return __uint_as_float(w & 0xffff0000u); }
__device__ __forceinline__ float bf2f(unsigned short h) { return __uint_as_float(((unsigned)h) << 16); }
__device__ __forceinline__ unsigned short f2bf(float f) { return (unsigned short)(cvt_pk_bf16(f, 0.f) & 0xffffu); }
__device__ __forceinline__ float silu_f(float x) { return x * __builtin_amdgcn_rcpf(1.0f + __expf(-x)); }
#define DPP_F(v, ctrl) __int_as_float(__builtin_amdgcn_update_dpp(0, __float_as_int(v), (ctrl), 0xf, 0xf, false))
__device__ __forceinline__ float wave_sum(float v) {
    v += DPP_F(v, 0xB1); v += DPP_F(v, 0x4E); v += DPP_F(v, 0x141); v += DPP_F(v, 0x140);
    const float r0 = __int_as_float(__builtin_amdgcn_readlane(__float_as_int(v), 0)), r1 = __int_as_float(__builtin_amdgcn_readlane(__float_as_int(v), 16)),
                r2 = __int_as_float(__builtin_amdgcn_readlane(__float_as_int(v), 32)), r3 = __int_as_float(__builtin_amdgcn_readlane(__float_as_int(v), 48));
    return (r0 + r1) + (r2 + r3);
}
__device__ __forceinline__ float max8(float v) {
    v = fmaxf(v, DPP_F(v, 0xB1)); v = fmaxf(v, DPP_F(v, 0x4E)); v = fmaxf(v, DPP_F(v, 0x141)); return v;
}
__device__ __forceinline__ unsigned f32_key(float f) { const unsigned b = __float_as_uint(f); return b ^ ((b >> 31) ? 0xffffffffu : 0x80000000u); }
__device__ __forceinline__ void unpack8(const u32x4 w, float (&f)[8]) {
    f[0] = bflo(w.x); f[1] = bfhi(w.x); f[2] = bflo(w.y); f[3] = bfhi(w.y); f[4] = bflo(w.z); f[5] = bfhi(w.z); f[6] = bflo(w.w); f[7] = bfhi(w.w);
}
__device__ __forceinline__ u32x4 pack8(const float (&f)[8]) {
    u32x4 w; w.x = cvt_pk_bf16(f[0], f[1]); w.y = cvt_pk_bf16(f[2], f[3]); w.z = cvt_pk_bf16(f[4], f[5]); w.w = cvt_pk_bf16(f[6], f[7]); return w;
}

__device__ __forceinline__ int lane_id_asm() { int l; asm volatile("v_mbcnt_lo_u32_b32 %0, -1, 0\n\tv_mbcnt_hi_u32_b32 %0, -1, %0" : "=v"(l)); return l; }

__device__ __forceinline__ size_t pj(size_t row, int col) { return ((row >> 8) * (NPROJ / 256) + (size_t)(col >> 8)) * 65536 + (row & 255) * 256 + (size_t)(col & 255); }

#define XB_TMO      128
#define XB_XCNT(j)  (256  + 64 * (j))
#define XB_XSUB(j)  (1280 + 64 * (j))
#define XB_XGEN(j)  (2304 + 64 * (j))
#define XB_TOP      3328
#define XB_TOPGEN   3392
#define XCD_BAR_WORDS 3456
#define XB_SPIN_CAP (1u << 18)
__device__ __forceinline__ unsigned xb_ld(unsigned* p)              { return __hip_atomic_load(p, __ATOMIC_RELAXED, __HIP_MEMORY_SCOPE_AGENT); }
__device__ __forceinline__ unsigned xb_add(unsigned* p, unsigned v) { return __hip_atomic_fetch_add(p, v, __ATOMIC_RELAXED, __HIP_MEMORY_SCOPE_AGENT); }
__device__ __forceinline__ unsigned xb_xcc_id() { return (unsigned)__builtin_amdgcn_s_getreg((3 << 11) | 20) & 0xFu; }
#define XB_SPIN(cond, bar) do { unsigned _sp = 0; while (cond) { __builtin_amdgcn_s_sleep(1); \
    if ((++_sp & 255u) == 0u) { if (xb_ld(&(bar)[XB_TMO])) break; if (_sp > XB_SPIN_CAP) { atomicAdd(&(bar)[XB_TMO], 1u); break; } } } } while (0)
struct XcdBarrier { unsigned* bar; unsigned x; volatile LAS unsigned* st; };
__device__ __forceinline__ XcdBarrier xcd_barrier_post(unsigned* bar, volatile LAS unsigned* st) {
    XcdBarrier b; b.bar = bar; b.x = xb_xcc_id(); b.st = st;
    if (threadIdx.x == 0) (void)xb_add(&bar[XB_XCNT(b.x)], 1u);
    return b;
}
__device__ __forceinline__ void xcd_barrier_complete(unsigned* bar, unsigned x, unsigned& nloc, unsigned& nx) {
    const unsigned G = gridDim.x * gridDim.y * gridDim.z;
    unsigned sum, cnt, mine, sp = 0u;
    for (;;) {
        sum = 0u; cnt = 0u; mine = 0u;
#pragma unroll
        for (unsigned j = 0; j < 16; ++j) { const unsigned c = xb_ld(&bar[XB_XCNT(j)]); sum += c; cnt += (c > 0u) ? 1u : 0u; mine = (j == x) ? c : mine; }
        if (sum == G) break;
        __builtin_amdgcn_s_sleep(1);
        if ((++sp & 255u) == 0u) { if (xb_ld(&bar[XB_TMO])) break; if (sp > XB_SPIN_CAP) { atomicAdd(&bar[XB_TMO], 1u); break; } }
    }
    nloc = mine > 0u ? mine : 1u; nx = cnt > 0u ? cnt : 1u;
}
__device__ __forceinline__ void xcd_barrier(const XcdBarrier& b, const int wave) {
    asm volatile("s_waitcnt vmcnt(0)" ::: "memory");
    __syncthreads();
    if (wave == 0 && lane_id_asm() == 0) {
        unsigned* bar = b.bar;
        __builtin_amdgcn_s_waitcnt(0);
        unsigned nloc = b.st[0], nx = b.st[1];
        if (nloc == 0u) { xcd_barrier_complete(bar, b.x, nloc, nx); b.st[0] = nloc; b.st[1] = nx; }
        const unsigned old = xb_add(&bar[XB_XSUB(b.x)], 1u);
        const unsigned gen = old / nloc;
        if (old + 1u == (gen + 1u) * nloc) {
            __builtin_amdgcn_fence(__ATOMIC_RELEASE, "agent");
            asm volatile("s_waitcnt vmcnt(0)" ::: "memory");
            const unsigned og = xb_add(&bar[XB_TOP], 1u);
            const unsigned tg = og / nx;
            if (og + 1u == (tg + 1u) * nx) xb_add(&bar[XB_TOPGEN], 1u);
            else XB_SPIN(xb_ld(&bar[XB_TOPGEN]) == tg, bar);
            __builtin_amdgcn_fence(__ATOMIC_ACQUIRE, "agent");
            xb_add(&bar[XB_XGEN(b.x)], 1u);
            asm volatile("s_waitcnt vmcnt(0)" ::: "memory");
        } else {
            XB_SPIN(xb_ld(&bar[XB_XGEN(b.x)]) == gen, bar);
            __builtin_amdgcn_fence(__ATOMIC_ACQUIRE, "agent");
            asm volatile("s_waitcnt vmcnt(0)" ::: "memory");
        }
    }
    __syncthreads();
}

namespace pg8 {
constexpr int BM = 256, BK = 64, HALF = 128, HTB = HALF * BK * 2, STAGE_BYTES = 8 * HTB, NXCD = 8, WGM = 8;
__host__ __device__ __forceinline__ int lds_byte(int r, int c) { const int st = (r >> 4) * 2 + (c >> 5), rr = r & 15, cc = c & 31, ob = rr * 64 + cc * 2; return st * 1024 + (ob ^ (((ob >> 9) & 1) << 5)); }
__host__ __device__ __forceinline__ void stage_rc(int b, int& R, int& C) { const int st = b / 1024, sb = b % 1024, swz = sb ^ (((sb >> 9) & 1) << 5); R = (st >> 1) * 16 + swz / 64; C = (st & 1) * 32 + (swz % 64) / 2; }
__host__ __device__ __forceinline__ int perm32(int rho) { const int n = rho >> 4, i = rho & 15; return 8 * (i >> 2) + 4 * n + (i & 3); }

struct Unit { int pm, pn, ord; const char* a; const char* b; };

struct PlainOrder {
    static constexpr bool GATHER = false;
    int nM, nN, nwg, G, c; const char* A; const char* Bt; size_t tstep;
    __device__ void init(const void* A_, const void* Bt_, int M, int N, int K, int G_, int c_) { nM = M / BM; nN = N / BM; nwg = nM * nN; G = G_; c = c_; A = (const char*)A_; Bt = (const char*)Bt_; tstep = (size_t)BM * K * 2; }
    __device__ bool next(int i, Unit& u) const {
#if defined(PROBE_PK)
        const long L = (long)(i >> 1) * G + c; if (L >= nwg) return false;
#else
        const long L = (long)i * G + c; if (L >= nwg) return false;
#endif
        int wgid = (int)L; { const int q = nwg / NXCD, r = nwg % NXCD, xcd = wgid % NXCD, off = wgid / NXCD; wgid = (xcd < r ? xcd * (q + 1) : r * (q + 1) + (xcd - r) * q) + off; }
        const int nig = WGM * nN, gid = wgid / nig, fm = gid * WGM, gsz = (nM - fm) < WGM ? (nM - fm) : WGM;
        u.pm = fm + ((wgid % nig) % gsz); u.pn = (wgid % nig) / gsz; u.ord = i; u.a = A + (size_t)u.pm * tstep; u.b = Bt + (size_t)u.pn * tstep; return true;
    }
    __device__ __forceinline__ unsigned aoff(int, int) const { return 0u; }
};
template <int SH, bool TAB> struct MoeOrder {
    static constexpr bool GATHER = true;
    int NT, G, c; const char* A; const char* W; unsigned rowb; size_t w_exp, w_tile; const LAS unsigned char* te; const LAS unsigned* tab;
    __device__ bool next(int i, Unit& u) const {
#if defined(PROBE_GK)
        const int L = (SH == 1 ? (i >> 1) : i) * G + c; const int rt = L >> SH; if (rt >= NT) return false;
#elif defined(PROBE_DK)
        const int L = (SH == 2 ? (i >> 1) : i) * G + c; const int rt = L >> SH; if (rt >= NT) return false;
#else
        const int L = i * G + c; const int rt = L >> SH; if (rt >= NT) return false;
#endif
        u.pm = rt; u.pn = L & ((1 << SH) - 1); u.ord = i; const int e = te[rt];
        u.a = A; u.b = W + (size_t)e * w_exp + (size_t)u.pn * w_tile; return true;
    }
    __device__ __forceinline__ unsigned aoff(int ord, int r) const { if constexpr (TAB) {
#if defined(PROBE_GK)
            return tab[(ord >> 1) * 256 + r];
#else
            return tab[ord * 256 + r];
#endif
        } else return (unsigned)((((ord * G + c) >> SH) << 8) + r) * rowb; }
};

struct MoeOrderD {
    static constexpr bool GATHER = false;
    int NT, G, c; const char* A; const char* W; unsigned rowb; size_t w_exp, w_tile; const LAS unsigned char* te;
    __device__ bool next(int i, Unit& u) const {
        const int L = i * G + c; const int rt = L >> 2; if (rt >= NT) return false;
        u.pm = rt; u.pn = L & 3; u.ord = i; const int e = te[rt];
        u.a = A + (size_t)rt * 256 * rowb; u.b = W + (size_t)e * w_exp + (size_t)u.pn * w_tile; return true;
    }
    __device__ __forceinline__ unsigned aoff(int, int) const { return 0u; }
};
__device__ __forceinline__ const GAS char* uni_ptr(const char* p) { const unsigned long long v = (unsigned long long)p; const unsigned lo = (unsigned)__builtin_amdgcn_readfirstlane((int)(unsigned)v), hi = (unsigned)__builtin_amdgcn_readfirstlane((int)(unsigned)(v >> 32)); return (const GAS char*)(((unsigned long long)hi << 32) | lo); }
template <class Epi, class Sched, bool ALIGN_EPI, bool F8 = false>
__device__ __forceinline__ void gemm_phase(LAS unsigned char* lds, const int wid, const int K, const Sched& S, const Epi& E) {
    const int lane = lane_id_asm(), tid = wid * 64 + lane,
        wr = wid >> 2, wc = wid & 3, fr = lane & 15, fq = lane >> 4;
    const int nt = F8 ? K / 128 : K / BK; const int RB = F8 ? K : 2 * K;
    unsigned voffA[2], voffB[2];
#pragma unroll
    for (int i = 0; i < 2; ++i) { int R, C; stage_rc(tid * 16 + i * 8192, R, C); const int Rb = (int)Epi::PERM == 2 ? (64 * (R >> 5) + 16 * ((R >> 2) & 3) + 4 * ((R >> 4) & 1) + (R & 3)) : (Epi::PERM ? ((R & ~31) + perm32(R & 31)) : R);
        voffA[i] = (unsigned)(R * RB + C * 2); voffB[i] = (unsigned)(Rb * RB + C * 2); }
    const size_t kstep = (size_t)(BK * 2);
    const size_t hstep = (size_t)HALF * RB;
    const size_t hstepB = (int)Epi::PERM == 2 ? (size_t)8 * RB : hstep;
    const unsigned ldsw = (unsigned)wid * 1024u;
    const int aoff = lds_byte(wr * 64 + fr, fq * 8), boff = lds_byte(wc * 32 + fr, fq * 8);
#define PG8_SA(b, h) (((b) * 2 + (h)) * HTB)
#define PG8_SB(b, h) ((4 + (b) * 2 + (h)) * HTB)
    const unsigned ldsbase = (unsigned)(unsigned long long)(const LAS void*)lds;
#define PG8_STAGE(bufoff, gbase, voff) do { _Pragma("unroll") for (int _i = 0; _i < 2; ++_i) { const unsigned m0v_ = ldsbase + (unsigned)(bufoff) + ldsw + (unsigned)_i * 8192u; \
        asm volatile("s_mov_b32 m0, %2\n\ts_nop 0\n\tglobal_load_lds_dwordx4 %0, %1" :: "v"((voff)[_i]), "s"(gbase), "s"(m0v_) : "memory", "m0"); } } while (0)
#define PG8_STAGE_A(bufoff, kb, h, GO) do { if constexpr (Sched::GATHER) { PG8_STAGE(bufoff, kb, GO[h]); } else { PG8_STAGE(bufoff, (kb) + (h) * hstep, voffA); } } while (0)
#define PG8_STAGE_A2(bufoff, kb, h) do { if constexpr (Sched::GATHER) { if (last) { PG8_STAGE(bufoff, kb, gN[h]); } else { PG8_STAGE(bufoff, kb, gC[h]); } } else { PG8_STAGE(bufoff, (kb) + (h) * hstep, voffA); } } while (0)
#define PG8_FR(p) (*(const LAS v4i_*)(p))
#define PG8_LDA(dst, b, h) do { _Pragma("unroll") for (int m = 0; m < 4; ++m) { if constexpr (F8) { dst##8[m] = __builtin_shufflevector(PG8_FR(lds + PG8_SA(b, h) + aoff + m * 2048), PG8_FR(lds + PG8_SA(b, h) + aoff + m * 2048 + 1024), 0, 1, 2, 3, 4, 5, 6, 7); } \
        else { _Pragma("unroll") for (int k = 0; k < 2; ++k) dst[m][k] = *(const LAS bf16x8*)(lds + PG8_SA(b, h) + aoff + m * 2048 + k * 1024); } } } while (0)
#define PG8_LDB(dst, b, h) do { _Pragma("unroll") for (int n = 0; n < 2; ++n) { if constexpr (F8) { dst##8[n] = __builtin_shufflevector(PG8_FR(lds + PG8_SB(b, h) + boff + n * 2048), PG8_FR(lds + PG8_SB(b, h) + boff + n * 2048 + 1024), 0, 1, 2, 3, 4, 5, 6, 7); } \
        else { _Pragma("unroll") for (int k = 0; k < 2; ++k) dst[n][k] = *(const LAS bf16x8*)(lds + PG8_SB(b, h) + boff + n * 2048 + k * 1024); } } } while (0)
#define PG8_MMA(ai, bj, At, Bt) do { __builtin_amdgcn_s_setprio(1); _Pragma("unroll") for (int m = 0; m < 4; ++m) _Pragma("unroll") for (int n = 0; n < 2; ++n) { \
        if constexpr (F8) { acc[ai][bj][m][n] = __builtin_amdgcn_mfma_scale_f32_16x16x128_f8f6f4(Bt##8[n], At##8[m], acc[ai][bj][m][n], 0, 0, 0, 0x7f7f7f7f, 0, Epi::MXSCALE); } \
        else { _Pragma("unroll") for (int k = 0; k < 2; ++k) acc[ai][bj][m][n] = __builtin_amdgcn_mfma_f32_16x16x32_bf16(Bt[n][k], At[m][k], acc[ai][bj][m][n], 0, 0, 0); } } \
        if constexpr (F8) { _Pragma("unroll") for (int m = 0; m < 4; ++m) asm volatile("" : "+v"(acc[ai][bj][m][0]), "+v"(acc[ai][bj][m][1])); }     \
        __builtin_amdgcn_s_setprio(0); } while (0)
#define PG8_WAIT_V(n) asm volatile("s_waitcnt vmcnt(" #n ")" ::: "memory")
#define PG8_WAIT_L(n) asm volatile("s_waitcnt lgkmcnt(" #n ")" ::: "memory")
#define PG8_WAIT_VR(relax) do { if (relax) asm volatile("s_waitcnt vmcnt(%0)" :: "n"(8 + Epi::NSTORE) : "memory"); else asm volatile("s_waitcnt vmcnt(8)" ::: "memory"); } while (0)
#define PG8_BAR do { __builtin_amdgcn_s_barrier(); if constexpr (F8) asm volatile("" ::: "memory"); } while (0)
#define PG8_SCHED __builtin_amdgcn_sched_barrier(0)
#define PG8_GLOAD(G_, u_) do { if constexpr (Sched::GATHER) { _Pragma("unroll") for (int _i = 0; _i < 2; ++_i) { int R_, C_; stage_rc(tid * 16 + _i * 8192, R_, C_); _Pragma("unroll") for (int _h = 0; _h < 2; ++_h) G_[_h][_i] = S.aoff((u_).ord, _h * HALF + R_) + (unsigned)C_ * 2u; } } } while (0)
    Unit cur, nxt;
    if (!S.next(0, cur)) return;
    f32x4 acc[2][2][4][2];
#pragma unroll
    for (int a = 0; a < 2; ++a)
#pragma unroll
        for (int b = 0; b < 2; ++b)
#pragma unroll
            for (int m = 0; m < 4; ++m)
#pragma unroll
                for (int n = 0; n < 2; ++n) acc[a][b][m][n] = (f32x4){0.f, 0.f, 0.f, 0.f};
    typedef int v4i_ __attribute__((ext_vector_type(4))); typedef int v8i_ __attribute__((ext_vector_type(8)));
    bf16x8 At[4][2], B0[2][2], B1[2][2];
    v8i_ At8[4], B08[2], B18[2];
    unsigned gC[2][2] = {{0u, 0u}, {0u, 0u}}, gN[2][2] = {{0u, 0u}, {0u, 0u}};
    u32x4 pw[8]; unsigned char* pdst = nullptr;
    if constexpr (Epi::DEFER) { pdst = E.addr0(wid);
#pragma unroll
        for (int j = 0; j < 8; ++j) pw[j] = (u32x4){0u, 0u, 0u, 0u}; }
    PG8_GLOAD(gC, cur);
    const GAS char* cA = uni_ptr(cur.a); const GAS char* cB = uni_ptr(cur.b);
    PG8_STAGE(PG8_SB(0, 0), cB, voffB); PG8_STAGE(PG8_SB(0, 1), cB + hstepB, voffB); PG8_STAGE_A(PG8_SA(0, 0), cA, 0, gC); PG8_STAGE_A(PG8_SA(0, 1), cA, 1, gC);
    if (wr == 1) PG8_BAR;
    PG8_WAIT_V(2); PG8_BAR;
    PG8_STAGE(PG8_SB(1, 0), cB + kstep, voffB); PG8_STAGE_A(PG8_SA(1, 0), cA + kstep, 0, gC); PG8_STAGE(PG8_SB(1, 1), cB + hstepB + kstep, voffB);
    PG8_WAIT_V(6); PG8_BAR;
    int ui = 0;
    for (;;) {
        const bool has_next = S.next(ui + 1, nxt);
        const GAS char* nA = has_next ? uni_ptr(nxt.a) : cA; const GAS char* nB = has_next ? uni_ptr(nxt.b) : cB;
        if constexpr (Sched::GATHER) { if (has_next) { PG8_GLOAD(gN, nxt); } else {
#pragma unroll
            for (int _h = 0; _h < 2; ++_h)
#pragma unroll
                for (int _i = 0; _i < 2; ++_i) gN[_h][_i] = gC[_h][_i]; } }
#pragma unroll 1
        for (int t = 0; t < nt; t += 2) {
            const bool last = (t == nt - 2);
            const GAS char* a1 = cA + (size_t)(t + 1) * kstep;
            const GAS char* a2 = last ? nA : cA + (size_t)(t + 2) * kstep; const GAS char* b2 = last ? nB : cB + (size_t)(t + 2) * kstep;
            const GAS char* a3 = a2 + kstep; const GAS char* b3 = b2 + kstep;
            if constexpr (Epi::HAS_MID) { if (t == nt / 2) E.mid(acc, cur, wr, fr); }
            const bool relax = Epi::NSTORE > 0 && t == 0 && ui > 0;
#define PG8_DEF(j0) do { if constexpr (Epi::DEFER) E.st2(pdst, pw, j0); } while (0)
#define PG8_WAIT_D(alt) do { if constexpr (Epi::DEFER) { if (ui > 0) asm volatile("s_waitcnt vmcnt(14)" ::: "memory"); else asm volatile("s_waitcnt vmcnt(8)" ::: "memory"); } else { alt; } } while (0)
            PG8_LDB(B0, 0, 0); PG8_LDB(B1, 0, 1); PG8_SCHED; PG8_LDA(At, 0, 0); if (!relax) PG8_STAGE_A(PG8_SA(1, 1), a1, 1, gC);
            PG8_DEF(0); PG8_WAIT_D(PG8_WAIT_VR(relax)); PG8_WAIT_L(0); PG8_BAR; PG8_MMA(0, 0, At, B0); PG8_MMA(0, 1, At, B1); PG8_BAR; PG8_SCHED;
            PG8_LDA(At, 0, 1); PG8_STAGE(PG8_SB(0, 0), b2, voffB); PG8_STAGE(PG8_SB(0, 1), b2 + hstepB, voffB); PG8_STAGE_A2(PG8_SA(0, 0), a2, 0);
            PG8_DEF(2); PG8_WAIT_D(PG8_WAIT_VR(relax)); PG8_WAIT_L(0); PG8_BAR; PG8_MMA(1, 0, At, B0); PG8_MMA(1, 1, At, B1); PG8_BAR; PG8_SCHED;
            PG8_LDB(B0, 1, 0); PG8_LDB(B1, 1, 1); PG8_SCHED; PG8_LDA(At, 1, 0); PG8_STAGE_A2(PG8_SA(0, 1), a2, 1);
            PG8_DEF(4); PG8_WAIT_D(PG8_WAIT_VR(relax)); PG8_WAIT_L(0); PG8_BAR; PG8_MMA(0, 0, At, B0); PG8_MMA(0, 1, At, B1); PG8_BAR; PG8_SCHED;
            PG8_LDA(At, 1, 1); PG8_STAGE(PG8_SB(1, 0), b3, voffB); PG8_STAGE(PG8_SB(1, 1), b3 + hstepB, voffB); PG8_STAGE_A2(PG8_SA(1, 0), a3, 0);
            PG8_DEF(6); PG8_WAIT_D(PG8_WAIT_V(8)); PG8_WAIT_L(0); PG8_BAR; PG8_MMA(1, 0, At, B0); PG8_MMA(1, 1, At, B1); PG8_BAR; PG8_SCHED;
#undef PG8_DEF
#undef PG8_WAIT_D
        }
        if constexpr (Epi::NSTORE > 0) { if (has_next) PG8_STAGE_A(PG8_SA(1, 1), nA + kstep, 1, gN); }
        if constexpr (ALIGN_EPI) { if (wr == 0) PG8_BAR; }
        if constexpr (Epi::DEFER) { E.pack(acc, pw); pdst = E.addr(cur, wr, wc);
            if (!has_next) { E.st2(pdst, pw, 0); E.st2(pdst, pw, 2); E.st2(pdst, pw, 4); E.st2(pdst, pw, 6); } }
        else E(acc, cur, wr, wc, fr, fq);
        if (!has_next) break;
#pragma unroll
        for (int a = 0; a < 2; ++a)
#pragma unroll
            for (int b = 0; b < 2; ++b)
#pragma unroll
                for (int m = 0; m < 4; ++m)
#pragma unroll
                    for (int n = 0; n < 2; ++n) acc[a][b][m][n] = (f32x4){0.f, 0.f, 0.f, 0.f};
        cur = nxt; cA = nA; cB = nB; ++ui;
#pragma unroll
        for (int _h = 0; _h < 2; ++_h)
#pragma unroll
            for (int _i = 0; _i < 2; ++_i) gC[_h][_i] = gN[_h][_i];
        if constexpr (ALIGN_EPI) { if (wr == 1) PG8_BAR; }
    }
    PG8_WAIT_V(0);
    if constexpr (!ALIGN_EPI) { if (wr == 0) PG8_BAR; }
    PG8_BAR;
#undef PG8_SA
#undef PG8_SB
#undef PG8_STAGE
#undef PG8_STAGE_A
#undef PG8_STAGE_A2
#undef PG8_LDA
#undef PG8_FR
#undef PG8_LDB
#undef PG8_MMA
#undef PG8_WAIT_V
#undef PG8_WAIT_L
#undef PG8_WAIT_VR
#undef PG8_BAR
#undef PG8_SCHED
#undef PG8_GLOAD
}

struct EpiBf16 {
    static constexpr bool PERM = true, HAS_MID = false; static constexpr int NSTORE = 16;
    static constexpr bool DEFER = false;
    static constexpr int MXSCALE = 0x7f7f7f7f;
    bf16* O; int ldc;
    __device__ __forceinline__ void operator()(const f32x4 (&acc)[2][2][4][2], const Unit& u, int wr, int wc, int fr, int fq) const {
#if defined(PROBE_PK)
        if ((u.ord & 1) == 0) return;
#endif
        const int row0 = u.pm * BM + wr * 64 + fr, col0 = u.pn * BM + wc * 32 + 8 * fq;
#pragma unroll
        for (int ai = 0; ai < 2; ++ai)
#pragma unroll
            for (int m = 0; m < 4; ++m) { bf16* rowp = O + (size_t)(row0 + ai * HALF + m * 16) * ldc + col0;
#pragma unroll
                for (int bj = 0; bj < 2; ++bj) { const f32x4 v0 = acc[ai][bj][m][0], v1 = acc[ai][bj][m][1];
                    u32x4 w; w.x = cvt_pk_bf16(v0[0], v0[1]); w.y = cvt_pk_bf16(v0[2], v0[3]); w.z = cvt_pk_bf16(v1[0], v1[1]); w.w = cvt_pk_bf16(v1[2], v1[3]);
                    *(u32x4*)(rowp + bj * HALF) = w; } }
    }
};
struct EpiBf16T {
    static constexpr bool PERM = true, HAS_MID = false; static constexpr int NSTORE = 16;
    static constexpr bool DEFER = false;
    static constexpr int MXSCALE = 0x7f7f7f7f;
    bf16* O; int ntn;
    __device__ __forceinline__ void operator()(const f32x4 (&acc)[2][2][4][2], const Unit& u, int wr, int wc, int fr, int fq) const {
        bf16* tile = O + ((size_t)u.pm * ntn + u.pn) * 65536 + (wr * 64 + fr) * 256 + wc * 32 + 8 * fq;
#pragma unroll
        for (int ai = 0; ai < 2; ++ai)
#pragma unroll
            for (int m = 0; m < 4; ++m) { bf16* rowp = tile + (ai * HALF + m * 16) * 256;
#pragma unroll
                for (int bj = 0; bj < 2; ++bj) { const f32x4 v0 = acc[ai][bj][m][0], v1 = acc[ai][bj][m][1];
                    u32x4 w; w.x = cvt_pk_bf16(v0[0], v0[1]); w.y = cvt_pk_bf16(v0[2], v0[3]); w.z = cvt_pk_bf16(v1[0], v1[1]); w.w = cvt_pk_bf16(v1[2], v1[3]);
                    *(u32x4*)(rowp + bj * HALF) = w; } }
    }
};
struct EpiGU {
    static constexpr bool PERM = true, HAS_MID = false; static constexpr int NSTORE = 8;
    static constexpr bool DEFER = false;
    static constexpr int MXSCALE = 0x7f7f7f7f;
    unsigned char* H;
    __device__ __forceinline__ void operator()(const f32x4 (&acc)[2][2][4][2], const Unit& u, int wr, int wc, int fr, int fq) const {
#if defined(PROBE_GK)
        if ((u.ord & 1) == 0) return;
#endif
        const int row0 = u.pm * BM + wr * 64 + fr, col0 = u.pn * HALF + wc * 32 + 8 * fq;
#pragma unroll
        for (int ai = 0; ai < 2; ++ai)
#pragma unroll
            for (int m = 0; m < 4; ++m) { unsigned char* rowp = H + (size_t)(row0 + ai * HALF + m * 16) * 256 + col0;
                float h[8];
#pragma unroll
                for (int n = 0; n < 2; ++n)
#pragma unroll
                    for (int i = 0; i < 4; i += 2) {
                        const f32x2 g = (f32x2){acc[ai][0][m][n][i], acc[ai][0][m][n][i + 1]}, u = (f32x2){acc[ai][1][m][n][i], acc[ai][1][m][n][i + 1]};
                        const f32x2 t = g * (-1.4426950408889634f / 64.0f); const f32x2 e = (f32x2){__builtin_amdgcn_exp2f(t.x), __builtin_amdgcn_exp2f(t.y)};
                        const f32x2 d = e * 1024.0f + 1024.0f;
                        const f32x2 r = (f32x2){__builtin_amdgcn_rcpf(d.x), __builtin_amdgcn_rcpf(d.y)}; const f32x2 hh = (g * u) * r;
                        h[4 * n + i] = hh.x; h[4 * n + i + 1] = hh.y; }
                int lo = __builtin_amdgcn_cvt_pk_fp8_f32(h[0], h[1], 0, false); lo = __builtin_amdgcn_cvt_pk_fp8_f32(h[2], h[3], lo, true);
                int hi = __builtin_amdgcn_cvt_pk_fp8_f32(h[4], h[5], 0, false); hi = __builtin_amdgcn_cvt_pk_fp8_f32(h[6], h[7], hi, true);
                *(u32x2*)rowp = (u32x2){(unsigned)lo, (unsigned)hi}; }
    }
};
struct EpiFp8 {
    static constexpr int PERM = 2; static constexpr bool HAS_MID = false; static constexpr int NSTORE = 8;
    static constexpr bool DEFER = true;
    static constexpr int MXSCALE = 0x7b7b7b7b;
    unsigned char* O; int ldc; float sc; unsigned char* dump;
    __device__ __forceinline__ void pack(const f32x4 (&acc)[2][2][4][2], u32x4 (&pw)[8]) const {
#pragma unroll
        for (int ai = 0; ai < 2; ++ai)
#pragma unroll
            for (int m = 0; m < 4; ++m) { u32x4 w;
#pragma unroll
                for (int bj = 0; bj < 2; ++bj) { const f32x4 v0 = acc[ai][bj][m][0], v1 = acc[ai][bj][m][1];
                    int lo = __builtin_amdgcn_cvt_pk_fp8_f32(v0[0], v0[1], 0, false); lo = __builtin_amdgcn_cvt_pk_fp8_f32(v0[2], v0[3], lo, true);
                    int hi = __builtin_amdgcn_cvt_pk_fp8_f32(v1[0], v1[1], 0, false); hi = __builtin_amdgcn_cvt_pk_fp8_f32(v1[2], v1[3], hi, true);
                    if (bj == 0) { w.x = (unsigned)lo; w.y = (unsigned)hi; } else { w.z = (unsigned)lo; w.w = (unsigned)hi; } }
                pw[ai * 4 + m] = w; }
    }
    __device__ __forceinline__ unsigned char* addr(const Unit& u, int wr, int wc) const { const int l_ = lane_id_asm(), fr = l_ & 15, fq = l_ >> 4;
        return O + (size_t)(u.pm * BM + wr * 64 + fr) * ldc + u.pn * BM + wc * 64 + 16 * fq; }
    __device__ __forceinline__ unsigned char* addr0(int wid) const { return dump + (size_t)(wid * 64 + lane_id_asm()) * 16; }
    __device__ __forceinline__ void st2(unsigned char* p, const u32x4 (&pw)[8], int j0) const {
#pragma unroll
        for (int j = j0; j < j0 + 2; ++j) *(u32x4*)(p + (size_t)((j >> 2) * HALF + (j & 3) * 16) * ldc) = pw[j]; }
    __device__ __forceinline__ void operator()(const f32x4 (&acc)[2][2][4][2], const Unit& u, int wr, int wc, int fr, int fq) const {
        const int row0 = u.pm * BM + wr * 64 + fr, col0 = u.pn * BM + wc * 64 + 16 * fq;
#pragma unroll
        for (int ai = 0; ai < 2; ++ai)
#pragma unroll
            for (int m = 0; m < 4; ++m) { u32x4 w;
#pragma unroll
                for (int bj = 0; bj < 2; ++bj) { const f32x4 v0 = acc[ai][bj][m][0], v1 = acc[ai][bj][m][1];
                    int lo = __builtin_amdgcn_cvt_pk_fp8_f32(v0[0], v0[1], 0, false); lo = __builtin_amdgcn_cvt_pk_fp8_f32(v0[2], v0[3], lo, true);
                    int hi = __builtin_amdgcn_cvt_pk_fp8_f32(v1[0], v1[1], 0, false); hi = __builtin_amdgcn_cvt_pk_fp8_f32(v1[2], v1[3], hi, true);
                    if (bj == 0) { w.x = (unsigned)lo; w.y = (unsigned)hi; } else { w.z = (unsigned)lo; w.w = (unsigned)hi; } }
                *(u32x4*)(O + (size_t)(row0 + ai * HALF + m * 16) * ldc + col0) = w; }
    }
};
struct EpiX1 {
    static constexpr bool PERM = true, HAS_MID = true; static constexpr int NSTORE = 0;
    static constexpr bool DEFER = false;
    static constexpr int MXSCALE = 0x7f7f7f7f;
    const float* x; bf16* o; const float* g1; const LAS float* rstab;
    __device__ __forceinline__ void mid(f32x4 (&acc)[2][2][4][2], const Unit& u, int wr, int fr) const {
#pragma unroll
        for (int ai = 0; ai < 2; ++ai)
#pragma unroll
            for (int m = 0; m < 4; ++m) { const float rs = rstab[u.ord * 256 + ai * HALF + wr * 64 + m * 16 + fr];
#pragma unroll
                for (int bj = 0; bj < 2; ++bj)
#pragma unroll
                    for (int n = 0; n < 2; ++n) acc[ai][bj][m][n] = acc[ai][bj][m][n] * rs; }
    }
    __device__ __forceinline__ void operator()(const f32x4 (&acc)[2][2][4][2], const Unit& u, int wr, int wc, int fr, int fq) const {
        const int row0 = u.pm * BM + wr * 64 + fr, col0 = u.pn * BM + wc * 32 + 8 * fq; const int b = (u.pm * BM) / SEQ;
        f32x4 gv[2][2];
#pragma unroll
        for (int bj = 0; bj < 2; ++bj)
#pragma unroll
            for (int n = 0; n < 2; ++n) gv[bj][n] = *(const f32x4*)(g1 + (size_t)b * 6144 + col0 + bj * HALF + 4 * n);
#pragma unroll
        for (int ai = 0; ai < 2; ++ai) {
            f32x4 xv[4][2][2];
#pragma unroll
            for (int m = 0; m < 4; ++m)
#pragma unroll
                for (int bj = 0; bj < 2; ++bj)
#pragma unroll
                    for (int n = 0; n < 2; ++n) xv[m][bj][n] = *(const f32x4*)(x + (size_t)(row0 + ai * HALF + m * 16) * D + col0 + bj * HALF + 4 * n);
#pragma unroll
            for (int m = 0; m < 4; ++m)
#pragma unroll
                for (int bj = 0; bj < 2; ++bj) { const f32x4 v0 = xv[m][bj][0] + gv[bj][0] * acc[ai][bj][m][0], v1 = xv[m][bj][1] + gv[bj][1] * acc[ai][bj][m][1];
                    u32x4 w; w.x = cvt_pk_bf16(v0[0], v0[1]); w.y = cvt_pk_bf16(v0[2], v0[3]); w.z = cvt_pk_bf16(v1[0], v1[1]); w.w = cvt_pk_bf16(v1[2], v1[3]);
                    *(u32x4*)(o + (size_t)(row0 + ai * HALF + m * 16) * D + col0 + bj * HALF) = w; }
            asm volatile("" ::: "memory"); }
    }
};
struct EpiLogits {
    static constexpr bool PERM = false, HAS_MID = false; static constexpr int NSTORE = 0;
    static constexpr bool DEFER = false;
    static constexpr int MXSCALE = 0x7f7f7f7f;
    float* L;
    __device__ __forceinline__ void operator()(const f32x4 (&acc)[2][2][4][2], const Unit& u, int wr, int wc, int fr, int fq) const {
        if (wc < 2 && u.pn == 0) {
            const int row0 = u.pm * BM + wr * 64 + fr, col0 = wc * 32 + 4 * fq;
#pragma unroll
            for (int ai = 0; ai < 2; ++ai)
#pragma unroll
                for (int m = 0; m < 4; ++m)
#pragma unroll
                    for (int n = 0; n < 2; ++n) *(f32x4*)(L + (size_t)(row0 + ai * HALF + m * 16) * 64 + col0 + n * 16) = acc[ai][0][m][n];
        }
    }
};
}

struct Args { const float* in[24]; float* out; unsigned char* ws; int ph_lo, ph_hi; };
typedef const Args __attribute__((address_space(4))) CArgs;
#define ARGS_LAUNDER(src_) CArgs* ap_ = &(src_); asm volatile("" : "+s"(ap_)); CArgs& args = *ap_
struct Frame {
    LAS unsigned char* lds; volatile LAS unsigned* MISC; unsigned* ctl;
    int tid, lane, wave, vcu, G;
};

struct TrIt { const float* src; unsigned char* dst; const float* ks; int ldw, ldk, useks, f8; };
__device__ __forceinline__ void tr_load(const TrIt& t, f32x4 (&tv)[8], float (&tk)[8], int lane) {
#pragma unroll
    for (int i = 0; i < 8; ++i) { const int kk = 8 * i + (lane >> 3), n4 = 4 * (lane & 7); tv[i] = *(const f32x4*)(t.src + (size_t)kk * t.ldw + n4); tk[i] = t.ks[kk]; }
}
__device__ __forceinline__ void tr_store(const TrIt& t, const f32x4 (&tv)[8], const float (&tk)[8], LAS float* scr, int lane) {
#pragma unroll
    for (int i = 0; i < 8; ++i) { const int kk = 8 * i + (lane >> 3), n4 = 4 * (lane & 7); const f32x4 v = tv[i] * (t.useks ? tk[i] : 1.0f);
        LAS float* d = scr + kk * 33 + n4; d[0] = v.x; d[1] = v.y; d[2] = v.z; d[3] = v.w; }
    LDS_WAIT(); asm volatile("" ::: "memory");
    const int c = lane & 7;
#pragma unroll
    for (int j = 0; j < 4; ++j) { const int n = (lane >> 3) + 8 * j; const LAS float* s = scr + (8 * c) * 33 + n;
        if (t.f8) {
            int lo = __builtin_amdgcn_cvt_pk_fp8_f32(s[0 * 33] * 64.f, s[1 * 33] * 64.f, 0, false); lo = __builtin_amdgcn_cvt_pk_fp8_f32(s[2 * 33] * 64.f, s[3 * 33] * 64.f, lo, true);
            int hi = __builtin_amdgcn_cvt_pk_fp8_f32(s[4 * 33] * 64.f, s[5 * 33] * 64.f, 0, false); hi = __builtin_amdgcn_cvt_pk_fp8_f32(s[6 * 33] * 64.f, s[7 * 33] * 64.f, hi, true);
            *(u32x2*)(t.dst + (size_t)n * t.ldk + 8 * c) = (u32x2){(unsigned)lo, (unsigned)hi};
        } else {
            u32x4 o; o.x = cvt_pk_bf16(s[0 * 33], s[1 * 33]); o.y = cvt_pk_bf16(s[2 * 33], s[3 * 33]); o.z = cvt_pk_bf16(s[4 * 33], s[5 * 33]); o.w = cvt_pk_bf16(s[6 * 33], s[7 * 33]);
            *(u32x4*)(t.dst + ((size_t)n * t.ldk + 8 * c) * 2) = o; } }
    LDS_WAIT(); asm volatile("" ::: "memory");
}
__device__ __forceinline__ void p0_prologue(const Frame& F_, CArgs& args_) {
    Frame F = F_; F.lane = lane_id_asm(); F.tid = F.wave * 64 + F.lane;
    ARGS_LAUNDER(args_);
    const int gw = F.vcu * 8 + F.wave, NGW = F.G * 8, lane = F.lane;
    for (int cg = F.vcu; cg < 96; cg += F.G) {
        const int j = cg * 64 + lane, k0 = F.wave * 128;
        float acc[16];
#pragma unroll
        for (int b = 0; b < 16; ++b) acc[b] = 0.f;
#pragma unroll 8
        for (int kk = 0; kk < 128; ++kk) { const float w = (args.in[2])[(size_t)(k0 + kk) * 6144 + j];
#pragma unroll
            for (int b = 0; b < 16; ++b) acc[b] += (args.in[1])[b * 1024 + k0 + kk] * w; }
        LAS float* part = (LAS float*)F.lds;
#pragma unroll
        for (int b = 0; b < 16; ++b) part[(F.wave * 16 + b) * 64 + lane] = acc[b];
        WG_BAR();
        for (int o = F.tid; o < 1024; o += 512) { const int b = o >> 6, jj = o & 63; float s = (args.in[3])[cg * 64 + jj];
#pragma unroll
            for (int w = 0; w < 8; ++w) s += part[(w * 16 + b) * 64 + jj];
            ((float*)(args.ws + WS_MOD))[b * 6144 + cg * 64 + jj] = s; }
        WG_BAR();
    }
    LAS float* scr = (LAS float*)(F.lds + F.wave * 16384);
    constexpr int I_IN = 16 * 96, I_OUT = 16 * 32, I_E = NEX * 128;
    constexpr int NITEMS = I_IN + I_OUT + 3 * I_E;
    auto decode = [&](int it) -> TrIt { TrIt t; t.useks = 0; t.ks = (args.in[12]); t.f8 = 0; int r = it;
        if (r < I_IN) { const int kb = r / 96, nb = r % 96; t.src = (args.in[5]) + (size_t)(kb * 64) * LDWIN + nb * 32; t.ldw = LDWIN; t.dst = (unsigned char*)(((bf16*)(args.ws + WS_WIN)) + (size_t)(nb * 32) * 1024 + kb * 64); t.ldk = 1024; return t; } r -= I_IN;
        if (r < I_OUT) { const int kb = r / 32, nb = r % 32, k0 = kb * 64; const int dc = k0 < 512 ? k0 + 512 : k0 - 512;
            t.src = (args.in[13]) + (size_t)k0 * 1024 + nb * 32; t.ldw = 1024; t.dst = (unsigned char*)(((bf16*)(args.ws + WS_WOUT)) + (size_t)(nb * 32) * 1024 + dc); t.ldk = 1024; if (k0 >= 512) { t.useks = 1; t.ks = (args.in[12]) + (k0 - 512); } return t; } r -= I_OUT;
        t.f8 = 1;
        if (r < 2 * I_E) { const int up = r >= I_E; if (up) r -= I_E; const int e = r / 128, q = r % 128, kb = q / 8, nb = q % 8, n0 = nb * 32;
            const float* W = up ? (e < NE ? (args.in[18]) + (size_t)e * 262144 : (args.in[21])) : (e < NE ? (args.in[17]) + (size_t)e * 262144 : (args.in[20]));
            const int drow = (n0 / 128) * 256 + up * 128 + (n0 % 128);
            t.src = W + (size_t)(kb * 64) * 256 + n0; t.ldw = 256; t.dst = (unsigned char*)(args.ws + WS_WGU) + ((size_t)e * 512 + drow) * 1024 + kb * 64; t.ldk = 1024; return t; } r -= 2 * I_E;
        { const int e = r / 128, q = r % 128, kb = q / 32, nb = q % 32; const float* W = e < NE ? (args.in[19]) + (size_t)e * 262144 : (args.in[22]);
            t.src = W + (size_t)(kb * 64) * 1024 + nb * 32; t.ldw = 1024; t.dst = (unsigned char*)(args.ws + WS_WD) + ((size_t)e * 1024 + nb * 32) * 256 + kb * 64; t.ldk = 256; return t; } };
    if (gw < NITEMS) {
        TrIt nxt = decode(gw); f32x4 nv[8]; float nk[8];
        tr_load(nxt, nv, nk, lane);
#pragma unroll 1
        for (int it = gw; it < NITEMS; it += NGW) {
            const TrIt cur = nxt; f32x4 cv[8]; float ck[8];
#pragma unroll
            for (int i = 0; i < 8; ++i) { cv[i] = nv[i]; ck[i] = nk[i]; }
            nxt = decode(it + NGW < NITEMS ? it + NGW : it);
            tr_load(nxt, nv, nk, lane);
            tr_store(cur, cv, ck, scr, lane);
        }
    }
    for (int e = blockIdx.x * 512 + F.tid; e < 4096; e += F.G * 512) { const int p = e >> 3, hh = e & 7;
        ((unsigned*)(args.ws + WS_WDT))[e] = cvt_pk_bf16((args.in[5])[(size_t)(2 * p) * LDWIN + NPROJ + hh], (args.in[5])[(size_t)(2 * p + 1) * LDWIN + NPROJ + hh]); }
}

template <bool WITH_DT, bool XBF>
__device__ __forceinline__ void p_norm_mod(const Frame& F_, CArgs& args_, const void* xin_, const float* gain, int shift_off, int scale_off, bf16* hout, unsigned char* h8out) {
    Frame F = F_; F.lane = lane_id_asm(); F.tid = F.wave * 64 + F.lane;
    ARGS_LAUNDER(args_);
    const int gw = F.vcu * 8 + F.wave, NGW = F.G * 8, lane = F.lane;
    for (int blk = gw; blk < T / 32; blk += NGW) {
        const int row0 = blk * 32, b = row0 / SEQ;
        f32x4 sc[4], sh[4];
#pragma unroll
        for (int j = 0; j < 4; ++j) { const int col = 4 * lane + 256 * j; const f32x4 g = *(const f32x4*)(gain + col); const f32x4 s1 = *(const f32x4*)(((float*)(args.ws + WS_MOD)) + b * 6144 + scale_off + col);
            sc[j] = g * (s1 + 1.0f); sh[j] = *(const f32x4*)(((float*)(args.ws + WS_MOD)) + b * 6144 + shift_off + col); }
        unsigned wdt[WITH_DT ? 4 : 1][2][WITH_DT ? 8 : 1];
        if constexpr (WITH_DT) {
#pragma unroll
            for (int j = 0; j < 4; ++j)
#pragma unroll
                for (int pr = 0; pr < 2; ++pr) { const u32x4* wp = (const u32x4*)(args.ws + WS_WDT) + (size_t)(2 * lane + 128 * j + pr) * 2; const u32x4 a = wp[0], c = wp[1];
                    wdt[j][pr][0] = a.x; wdt[j][pr][1] = a.y; wdt[j][pr][2] = a.z; wdt[j][pr][3] = a.w; wdt[j][pr][4] = c.x; wdt[j][pr][5] = c.y; wdt[j][pr][6] = c.z; wdt[j][pr][7] = c.w; }
        }
        float dtb = 0.f; if constexpr (WITH_DT) dtb = (args.in[9])[lane & 7];
        f32x4 nx[2][4];
#pragma unroll
        for (int p = 0; p < 2; ++p)
#pragma unroll
            for (int j = 0; j < 4; ++j) {
                if constexpr (XBF) { const u32x2 w = ((const u32x2*)((const bf16*)xin_ + (size_t)(row0 + p) * D) + lane)[64 * j]; nx[p][j] = (f32x4){bflo(w.x), bfhi(w.x), bflo(w.y), bfhi(w.y)}; }
                else nx[p][j] = ((const f32x4*)((const float*)xin_ + (size_t)(row0 + p) * D) + lane)[64 * j]; }
#pragma unroll 2
        for (int r = 0; r < 32; ++r) {
            const int row = row0 + r;
            f32x4 v[4]; float s = 0.f;
#pragma unroll
            for (int j = 0; j < 4; ++j) v[j] = nx[r & 1][j];
            { const int rn = row0 + (r + 2 < 32 ? r + 2 : 31);
#pragma unroll
                for (int j = 0; j < 4; ++j) {
                    if constexpr (XBF) { const u32x2 w = ((const u32x2*)((const bf16*)xin_ + (size_t)rn * D) + lane)[64 * j]; nx[r & 1][j] = (f32x4){bflo(w.x), bfhi(w.x), bflo(w.y), bfhi(w.y)}; }
                    else nx[r & 1][j] = ((const f32x4*)((const float*)xin_ + (size_t)rn * D) + lane)[64 * j]; } }
#pragma unroll
            for (int j = 0; j < 4; ++j) s += (v[j].x * v[j].x + v[j].y * v[j].y) + (v[j].z * v[j].z + v[j].w * v[j].w);
            const float rstd = rsqrtf(wave_sum(s) * (1.0f / D) + EPS);
            u32x2* o8 = (u32x2*)(hout + (size_t)row * D) + lane;
            float dv[8] = {0.f, 0.f, 0.f, 0.f, 0.f, 0.f, 0.f, 0.f};
#pragma unroll
            for (int j = 0; j < 4; ++j) { const f32x4 h = v[j] * rstd * sc[j] + sh[j];
                if constexpr (!WITH_DT) { int q8 = __builtin_amdgcn_cvt_pk_fp8_f32(h.x, h.y, 0, false); q8 = __builtin_amdgcn_cvt_pk_fp8_f32(h.z, h.w, q8, true); ((unsigned*)(h8out + (size_t)row * D))[lane + 64 * j] = (unsigned)q8; }
                const unsigned wx = cvt_pk_bf16(h.x, h.y), wy = cvt_pk_bf16(h.z, h.w); if (WITH_DT) o8[64 * j] = (u32x2){wx, wy};
                if constexpr (WITH_DT) {
                    typedef __bf16 bf2 __attribute__((ext_vector_type(2)));
#pragma unroll
                    for (int hh = 0; hh < 8; ++hh) { dv[hh] = __builtin_amdgcn_fdot2_f32_bf16(__builtin_bit_cast(bf2, wx), __builtin_bit_cast(bf2, wdt[j][0][hh]), dv[hh], false);
                        dv[hh] = __builtin_amdgcn_fdot2_f32_bf16(__builtin_bit_cast(bf2, wy), __builtin_bit_cast(bf2, wdt[j][1][hh]), dv[hh], false); } } }
            if constexpr (WITH_DT) {
#pragma unroll
                for (int hh = 0; hh < 8; ++hh) dv[hh] = wave_sum(dv[hh]);
                float mine = dv[0];
#pragma unroll
                for (int hh = 1; hh < 8; ++hh) mine = (lane == hh) ? dv[hh] : mine;
                if (lane < 8) { const float a = mine + dtb; ((float*)(args.ws + WS_DT))[(size_t)row * 8 + lane] = a > 20.f ? a : log1pf(__expf(a)); }
            }
        }
    }
}

__device__ __forceinline__ void p3_conv(const Frame& F_, CArgs& args_) {
    Frame F = F_; F.lane = lane_id_asm(); F.tid = F.wave * 64 + F.lane;
    ARGS_LAUNDER(args_);
    const int q = F.tid & 63, seg = F.tid >> 6;
    for (int tile = F.vcu; tile < T / 256; tile += F.G) {
        const int r0 = tile * 256 + seg * 32; const bool head = (r0 % SEQ) == 0;
        {
            float w0[8], w1[8], w2[8], pm2[8], pm1[8];
#pragma unroll
            for (int i = 0; i < 8; ++i) { w0[i] = (args.in[6])[0 * 512 + 8 * q + i]; w1[i] = (args.in[6])[1 * 512 + 8 * q + i]; w2[i] = (args.in[6])[2 * 512 + 8 * q + i]; pm2[i] = 0.f; pm1[i] = 0.f; }
            if (!head) {
                float a[8], b[8];
                unpack8(*(const u32x4*)(((bf16*)(args.ws + WS_A)) + pj((size_t)(r0 - 2), C_CC + 8 * q)), a); unpack8(*(const u32x4*)(((bf16*)(args.ws + WS_A)) + pj((size_t)(r0 - 2), C_CU + 8 * q)), b);
#pragma unroll
                for (int i = 0; i < 8; ++i) pm2[i] = a[i] * b[i];
                unpack8(*(const u32x4*)(((bf16*)(args.ws + WS_A)) + pj((size_t)(r0 - 1), C_CC + 8 * q)), a); unpack8(*(const u32x4*)(((bf16*)(args.ws + WS_A)) + pj((size_t)(r0 - 1), C_CU + 8 * q)), b);
#pragma unroll
                for (int i = 0; i < 8; ++i) pm1[i] = a[i] * b[i];
            }
            const bf16* pj0 = ((bf16*)(args.ws + WS_A));
            constexpr int YB = 4; u32x4 nb[YB][3];
#pragma unroll
            for (int j = 0; j < YB; ++j) { nb[j][0] = *(const u32x4*)(pj0 + pj((size_t)(r0 + j), C_CB + 8 * q)); nb[j][1] = *(const u32x4*)(pj0 + pj((size_t)(r0 + j), C_CC + 8 * q)); nb[j][2] = *(const u32x4*)(pj0 + pj((size_t)(r0 + j), C_CU + 8 * q)); }
#pragma unroll 1
            for (int r = 0; r < 32; r += YB) {
                u32x4 cur[YB][3];
#pragma unroll
                for (int j = 0; j < YB; ++j) { cur[j][0] = nb[j][0]; cur[j][1] = nb[j][1]; cur[j][2] = nb[j][2]; }
                {
#pragma unroll
                    for (int j = 0; j < YB; ++j) { const size_t rn = (size_t)(r0 + (r + YB + j < 32 ? r + YB + j : 31));
                        nb[j][0] = *(const u32x4*)(pj0 + pj(rn, C_CB + 8 * q)); nb[j][1] = *(const u32x4*)(pj0 + pj(rn, C_CC + 8 * q)); nb[j][2] = *(const u32x4*)(pj0 + pj(rn, C_CU + 8 * q)); } }
#pragma unroll
                for (int j = 0; j < YB; ++j) {
                    float cb[8], cc[8], cu[8], y[8];
                    unpack8(cur[j][0], cb); unpack8(cur[j][1], cc); unpack8(cur[j][2], cu);
#pragma unroll
                    for (int i = 0; i < 8; ++i) { const float p = cc[i] * cu[i]; y[i] = cb[i] * (w0[i] * pm2[i] + w1[i] * pm1[i] + w2[i] * p); pm2[i] = pm1[i]; pm1[i] = p; }
                    *(u32x4*)(((bf16*)(args.ws + WS_HB)) + (size_t)(r0 + r + j) * D + 512 + 8 * q) = pack8(y);
                }
            }
        }
#pragma unroll 1
        for (int jj = 0; jj < 2; ++jj) {
            const int ch0 = 8 * (q + 64 * jj);
            float w0[8], w1[8], w2[8], w3[8], bs[8], u3[8], u2[8], u1[8];
#pragma unroll
            for (int i = 0; i < 8; ++i) { w0[i] = (args.in[7])[0 * 1024 + ch0 + i]; w1[i] = (args.in[7])[1 * 1024 + ch0 + i]; w2[i] = (args.in[7])[2 * 1024 + ch0 + i]; w3[i] = (args.in[7])[3 * 1024 + ch0 + i];
                bs[i] = (args.in[8])[ch0 + i]; u3[i] = 0.f; u2[i] = 0.f; u1[i] = 0.f; }
            if (!head) { unpack8(*(const u32x4*)(((bf16*)(args.ws + WS_A)) + pj((size_t)(r0 - 3), C_XBC + ch0)), u3); unpack8(*(const u32x4*)(((bf16*)(args.ws + WS_A)) + pj((size_t)(r0 - 2), C_XBC + ch0)), u2);
                unpack8(*(const u32x4*)(((bf16*)(args.ws + WS_A)) + pj((size_t)(r0 - 1), C_XBC + ch0)), u1); }
            const bf16* pjx = ((bf16*)(args.ws + WS_A));
            constexpr int XB = 8; u32x4 nb[XB];
#pragma unroll
            for (int j = 0; j < XB; ++j) nb[j] = *(const u32x4*)(pjx + pj((size_t)(r0 + j), C_XBC + ch0));
#pragma unroll 1
            for (int r = 0; r < 32; r += XB) {
                u32x4 cur[XB];
#pragma unroll
                for (int j = 0; j < XB; ++j) cur[j] = nb[j];
#pragma unroll
                for (int j = 0; j < XB; ++j) nb[j] = *(const u32x4*)(pjx + pj((size_t)(r0 + (r + XB + j < 32 ? r + XB + j : 31)), C_XBC + ch0));
#pragma unroll
                for (int j = 0; j < XB; ++j) {
                    float u[8], y[8]; unpack8(cur[j], u);
#pragma unroll
                    for (int i = 0; i < 8; ++i) { y[i] = silu_f(bs[i] + w0[i] * u3[i] + w1[i] * u2[i] + w2[i] * u1[i] + w3[i] * u[i]); u3[i] = u2[i]; u2[i] = u1[i]; u1[i] = u[i]; }
                    *(u32x4*)(((bf16*)(args.ws + WS_XC)) + (size_t)(r0 + r + j) * D + ch0) = pack8(y);
                }
            }
        }
    }
}

constexpr int SD_SET = 55296, SD_BM = 0, SD_CM = 17408, SD_DX = 34816, SD_DXD = 39936, SD_XS = 45056, SD_ZR = 50176, SD_WM = 2 * SD_SET, SD_SB = SD_WM + 2 * 9216, SD_ACS = SD_SB + 8704, SD_DTS = SD_ACS + 768, SD_END = SD_DTS + 768;
static_assert(SD_END <= MISC_OFF, "SSD LDS map");
typedef short s16x4 __attribute__((ext_vector_type(4)));
__device__ __forceinline__ bf16x8 lds_tr8(const LAS unsigned char* p, int stride4) {
    const s16x4 a = __builtin_bit_cast(s16x4, __builtin_amdgcn_ds_read_tr16_b64_v4i16((LAS s16x4*)p));
    const s16x4 b = __builtin_bit_cast(s16x4, __builtin_amdgcn_ds_read_tr16_b64_v4i16((LAS s16x4*)(p + stride4)));
    return __builtin_shufflevector(a, b, 0, 1, 2, 3, 4, 5, 6, 7);
}
#define DPP_SHR_ADD(v, n) do { const int t_ = __builtin_amdgcn_update_dpp(0, __float_as_int(v), 0x110 + (n), 0xf, 0xf, true); (v) += __int_as_float(t_); } while (0)
__device__ __forceinline__ void p4_ssd(const Frame& F_, CArgs& args_) {
    Frame F = F_; F.lane = lane_id_asm(); F.tid = F.wave * 64 + F.lane;
    ARGS_LAUNDER(args_);
    LAS unsigned char* lds = F.lds; const int tid = F.tid, lane = F.lane, wave = F.wave, fr = lane & 15, fq = lane >> 4;
    const int tq = fr >> 2, tp = fr & 3;
    for (int uid = F.vcu; uid < 256; uid += F.G) {
        const int b = uid >> 4, h = (uid >> 1) & 7, ph = uid & 1, g = h >> 2;
        const float Ah = -__expf((args.in[10])[h]), Dh = (args.in[11])[h];
        const int xs_col = h * 64 + ph * 32, b_col = 512 + g * 128, c_col = 768 + g * 128, z_col = C_Z + h * 64 + ph * 32;
        f32x4 Sacc[2] = {(f32x4){0.f, 0.f, 0.f, 0.f}, (f32x4){0.f, 0.f, 0.f, 0.f}};
        for (int i = tid; i < 32 * 136 / 2; i += 512) ((LAS unsigned*)(lds + SD_SB))[i] = 0u;
        u32x4 pb[2][2], pc[2][2], px[2], pz[2]; float pdt[2] = {0.f, 0.f};
#pragma unroll
        for (int X = 0; X < 2; ++X) { px[X] = (u32x4){0u, 0u, 0u, 0u}; pz[X] = (u32x4){0u, 0u, 0u, 0u}; }
        const size_t trow0 = (size_t)b * SEQ;
        const bf16* XCp = ((const bf16*)(args.ws + WS_XC)); const bf16* PJ = ((const bf16*)(args.ws + WS_A)); const float* DTp = ((const float*)(args.ws + WS_DT));
        bf16* HBp = ((bf16*)(args.ws + WS_HB)); float* SQp = ((float*)(args.ws + WS_SSQ));
#define SSD_LOAD(cc, X) do { const size_t t0_ = trow0 + (size_t)(cc) * 64; \
            _Pragma("unroll") for (int k = 0; k < 2; ++k) { const int i_ = tid + 512 * k; pb[X][k] = *(const u32x4*)(XCp + (t0_ + (i_ >> 4)) * D + b_col + 8 * (i_ & 15)); pc[X][k] = *(const u32x4*)(XCp + (t0_ + (i_ >> 4)) * D + c_col + 8 * (i_ & 15)); } \
            if (wave < 4) { px[X] = *(const u32x4*)(XCp + (t0_ + (tid >> 2)) * D + xs_col + 8 * (tid & 3)); pz[X] = *(const u32x4*)(PJ + pj(t0_ + (tid >> 2), z_col + 8 * (tid & 3))); } \
            if (wave == 7) pdt[X] = DTp[(t0_ + lane) * 8 + h]; } while (0)
#define SSD_AUX(slot, X) do { if (wave == 7) { float a_ = pdt[X] * Ah; DPP_SHR_ADD(a_, 1); DPP_SHR_ADD(a_, 2); DPP_SHR_ADD(a_, 4); DPP_SHR_ADD(a_, 8); \
                const float r0_ = __int_as_float(__builtin_amdgcn_readlane(__float_as_int(a_), 15)), r1_ = __int_as_float(__builtin_amdgcn_readlane(__float_as_int(a_), 31)), r2_ = __int_as_float(__builtin_amdgcn_readlane(__float_as_int(a_), 47)); \
                a_ += (fq == 1) ? r0_ : (fq == 2) ? (r0_ + r1_) : (fq == 3) ? ((r0_ + r1_) + r2_) : 0.f; \
                ((LAS float*)(lds + SD_ACS))[(slot) * 64 + lane] = a_; ((LAS float*)(lds + SD_DTS))[(slot) * 64 + lane] = pdt[X]; } } while (0)
#define SSD_TILES(ts, X, slot) do { LAS unsigned char* tb_ = lds + (ts) * SD_SET; \
            _Pragma("unroll") for (int k = 0; k < 2; ++k) { const int i_ = tid + 512 * k; *(LAS u32x4*)(tb_ + SD_BM + ((i_ >> 4) * 136 + 8 * (i_ & 15)) * 2) = pb[X][k]; *(LAS u32x4*)(tb_ + SD_CM + ((i_ >> 4) * 136 + 8 * (i_ & 15)) * 2) = pc[X][k]; } \
            if (wave < 4) { const int l_ = tid >> 2, q_ = tid & 3; const LAS float* A_ = (const LAS float*)(lds + SD_ACS) + (slot) * 64; \
                *(LAS u32x4*)(tb_ + SD_XS + (l_ * 40 + 8 * q_) * 2) = px[X]; *(LAS u32x4*)(tb_ + SD_ZR + (l_ * 40 + 8 * q_) * 2) = pz[X]; \
                float f_[8], fd_[8]; unpack8(px[X], f_); const float dt_ = ((const LAS float*)(lds + SD_DTS))[(slot) * 64 + l_], dd_ = dt_ * __expf(A_[63] - A_[l_]); \
                _Pragma("unroll") for (int e = 0; e < 8; ++e) { fd_[e] = f_[e] * dd_; f_[e] *= dt_; } \
                *(LAS u32x4*)(tb_ + SD_DX + (l_ * 40 + 8 * q_) * 2) = pack8(f_); *(LAS u32x4*)(tb_ + SD_DXD + (l_ * 40 + 8 * q_) * 2) = pack8(fd_); } } while (0)
#define SSD_W(ts, slot) do { const LAS unsigned char* tb_ = lds + (ts) * SD_SET; const LAS float* A_ = (const LAS float*)(lds + SD_ACS) + (slot) * 64; \
            _Pragma("unroll") for (int jt = 0; jt < 2; ++jt) { const int id_ = 2 * wave + jt, lt_ = id_ >> 2, st_ = id_ & 3; f32x4 acc_ = (f32x4){0.f, 0.f, 0.f, 0.f}; \
                if (st_ <= lt_) { _Pragma("unroll") for (int kk = 0; kk < 4; ++kk) { const bf16x8 a_ = *(const LAS bf16x8*)(tb_ + SD_BM + ((st_ * 16 + fr) * 136 + kk * 32 + fq * 8) * 2); const bf16x8 b_ = *(const LAS bf16x8*)(tb_ + SD_CM + ((lt_ * 16 + fr) * 136 + kk * 32 + fq * 8) * 2); \
                        acc_ = __builtin_amdgcn_mfma_f32_16x16x32_bf16(a_, b_, acc_, 0, 0, 0); } } \
                const int l_ = lt_ * 16 + fr, s0_ = st_ * 16 + 4 * fq; const float al_ = A_[l_]; float w_[4]; const f32x4 as_ = *(const LAS f32x4*)(A_ + s0_);     \
                _Pragma("unroll") for (int r = 0; r < 4; ++r) { const int s_ = s0_ + r; const float e_ = acc_[r] * __expf(fminf(al_ - as_[r], 0.f)); w_[r] = (s_ <= l_) ? e_ : 0.f; } \
                u32x2 o_; o_.x = cvt_pk_bf16(w_[0], w_[1]); o_.y = cvt_pk_bf16(w_[2], w_[3]); *(LAS u32x2*)(lds + SD_WM + (ts) * 9216 + (l_ * 72 + s0_) * 2) = o_; } } while (0)
        SSD_LOAD(0, 0); SSD_LOAD(1, 1);
        SSD_AUX(0, 0); SSD_AUX(1, 1);
        WG_BAR();
        SSD_TILES(0, 0, 0);
        SSD_LOAD(2, 0);
        WG_BAR();
        SSD_W(0, 0);
        WG_BAR();
        int a0 = 0, a1 = 1, a2 = 2;
        u32x2 ypk = (u32x2){0u, 0u}; float yq = 0.f;
        for (int c2 = 0; c2 < 64; c2 += 2) {
#pragma unroll
        for (int par = 0; par < 2; ++par) {
            const int c = c2 + par; const size_t t0 = trow0 + (size_t)c * 64;
            const LAS unsigned char* tb = lds + par * SD_SET; const LAS float* ACS = (const LAS float*)(lds + SD_ACS) + a0 * 64;
            if (c + 1 < 64) SSD_TILES(par ^ 1, par ^ 1, a1);
            if (c + 2 < 64) SSD_AUX(a2, par);
            if (c > 0) { const int lt_ = wave >> 1, pt_ = wave & 1, l_ = lt_ * 16 + fr, p0_ = pt_ * 16 + 4 * fq; const size_t tp_ = t0 - 64;
                if (fq == 0) SQp[(size_t)((h * 2 + ph) * 2 + pt_) * T + tp_ + l_] = yq;
                *(u32x2*)(HBp + (tp_ + l_) * D + xs_col + p0_) = ypk; }
            if (c + 3 < 64) SSD_LOAD(c + 3, par ^ 1);
            const int lt = wave >> 1, pt = wave & 1, l = lt * 16 + fr, p0 = pt * 16 + 4 * fq;
            f32x4 yd = (f32x4){0.f, 0.f, 0.f, 0.f}, yo = (f32x4){0.f, 0.f, 0.f, 0.f};
#pragma unroll
            for (int kk = 0; kk < 2; ++kk) { const bf16x8 a = lds_tr8(tb + SD_DX + ((kk * 32 + 8 * fq + tq) * 40 + pt * 16 + 4 * tp) * 2, 4 * 80);
                const bf16x8 bb = *(const LAS bf16x8*)(lds + SD_WM + par * 9216 + ((lt * 16 + fr) * 72 + kk * 32 + fq * 8) * 2);
                yd = __builtin_amdgcn_mfma_f32_16x16x32_bf16(a, bb, yd, 0, 0, 0); }
#pragma unroll
            for (int kk = 0; kk < 4; ++kk) { const bf16x8 a = *(const LAS bf16x8*)(lds + SD_SB + ((pt * 16 + fr) * 136 + kk * 32 + fq * 8) * 2); const bf16x8 bb = *(const LAS bf16x8*)(tb + SD_CM + ((lt * 16 + fr) * 136 + kk * 32 + fq * 8) * 2);
                yo = __builtin_amdgcn_mfma_f32_16x16x32_bf16(a, bb, yo, 0, 0, 0); }
            const u32x2 xw = *(const LAS u32x2*)(tb + SD_XS + (l * 40 + p0) * 2), zw = *(const LAS u32x2*)(tb + SD_ZR + (l * 40 + p0) * 2);
            const float el = __expf(ACS[l]), cd = __expf(ACS[63]);
#pragma unroll
            for (int jt = 0; jt < 2; ++jt) { const int id = 2 * wave + jt, nt = id >> 1, pt2 = id & 1;
                Sacc[jt] = Sacc[jt] * cd;
#pragma unroll
                for (int kk = 0; kk < 2; ++kk) { const bf16x8 a = lds_tr8(tb + SD_BM + ((kk * 32 + 8 * fq + tq) * 136 + nt * 16 + 4 * tp) * 2, 4 * 272);
                    const bf16x8 bb = lds_tr8(tb + SD_DXD + ((kk * 32 + 8 * fq + tq) * 40 + pt2 * 16 + 4 * tp) * 2, 4 * 80);
                    Sacc[jt] = __builtin_amdgcn_mfma_f32_16x16x32_bf16(a, bb, Sacc[jt], 0, 0, 0); } }
            WG_BAR();
            {
                const float xs[4] = {bflo(xw.x), bfhi(xw.x), bflo(xw.y), bfhi(xw.y)}, zz[4] = {bflo(zw.x), bfhi(zw.x), bflo(zw.y), bfhi(zw.y)};
                float y[4], q2 = 0.f;
#pragma unroll
                for (int r = 0; r < 4; ++r) { y[r] = (yd[r] + el * yo[r] + Dh * xs[r]) * silu_f(zz[r]); q2 += y[r] * y[r]; }
                q2 += __shfl_xor(q2, 16); q2 += __shfl_xor(q2, 32);
                yq = q2; ypk.x = cvt_pk_bf16(y[0], y[1]); ypk.y = cvt_pk_bf16(y[2], y[3]);
            }
#pragma unroll
            for (int jt = 0; jt < 2; ++jt) { const int id = 2 * wave + jt, nt = id >> 1, pt2 = id & 1;
                u32x2 o; o.x = cvt_pk_bf16(Sacc[jt][0], Sacc[jt][1]); o.y = cvt_pk_bf16(Sacc[jt][2], Sacc[jt][3]);
                *(LAS u32x2*)(lds + SD_SB + ((pt2 * 16 + fr) * 136 + nt * 16 + 4 * fq) * 2) = o; }
            if (c + 1 < 64) SSD_W(par ^ 1, a1);
            WG_BAR();
            { const int t_ = a0; a0 = a1; a1 = a2; a2 = t_; }
        }
        }
#undef SSD_LOAD
#undef SSD_AUX
#undef SSD_TILES
#undef SSD_W
        { const int lt_ = wave >> 1, pt_ = wave & 1, l_ = lt_ * 16 + fr, p0_ = pt_ * 16 + 4 * fq; const size_t tp_ = trow0 + (size_t)63 * 64;
            if (fq == 0) SQp[(size_t)((h * 2 + ph) * 2 + pt_) * T + tp_ + l_] = yq;
            *(u32x2*)(HBp + (tp_ + l_) * D + xs_col + p0_) = ypk; }
        WG_BAR();
    }
}

__device__ __forceinline__ void p1_router_weights(const Frame& F_, CArgs& args_) {
    Frame F = F_; F.lane = lane_id_asm(); F.tid = F.wave * 64 + F.lane;
    ARGS_LAUNDER(args_);
    LAS float* red = (LAS float*)F.lds;
    for (int w = F.vcu; w < 256; w += F.G) {
        const int b = w >> 4, e0 = 4 * (w & 15); float bs[4] = {0.f, 0.f, 0.f, 0.f};
        const float* mod = (const float*)(args.ws + WS_MOD) + b * 6144;
#pragma unroll
        for (int kk = 0; kk < 2; ++kk) { const int k = F.tid + 512 * kk; const f32x4 wv = *(const f32x4*)((args.in[15]) + (size_t)k * 64 + e0);
            const float sc = (args.in[14])[k] * (1.0f + mod[4096 + k]), sh = mod[3072 + k];
#pragma unroll
            for (int j = 0; j < 4; ++j) { ((bf16*)(args.ws + WS_WR))[((size_t)b * 64 + e0 + j) * 1024 + k] = f2bf(wv[j] * sc); bs[j] += sh * wv[j]; } }
#pragma unroll
        for (int j = 0; j < 4; ++j) bs[j] = wave_sum(bs[j]);
        if (F.lane == 0) { red[F.wave * 4 + 0] = bs[0]; red[F.wave * 4 + 1] = bs[1]; red[F.wave * 4 + 2] = bs[2]; red[F.wave * 4 + 3] = bs[3]; }
        WG_BAR();
        if (F.tid < 4) { float s = 0.f;
#pragma unroll
            for (int q = 0; q < 8; ++q) s += red[q * 4 + F.tid];
            ((float*)(args.ws + WS_RB))[b * 64 + e0 + F.tid] = s; }
        WG_BAR();
    }
}
constexpr int RT_WST = 1032;
constexpr int RT_LOG = 0, RT_CNT = 65536, RT_BASE = 65536 + 256, RT_LE = 66560, RT_LW = 66560 + 8192;
constexpr int RT_RS = RT_LW + 8192;
static_assert(64 * RT_WST * 2 <= MISC_OFF && RT_RS + 1024 <= MISC_OFF, "router LDS map");
__device__ __forceinline__ void p7_router(const Frame& F_, CArgs& args_) {
    Frame F = F_; F.lane = lane_id_asm(); F.tid = F.wave * 64 + F.lane;
    ARGS_LAUNDER(args_);
    LAS unsigned char* lds = F.lds; const int tid = F.tid, lane = F.lane, wave = F.wave, fr = lane & 15, fq = lane >> 4;
    LAS int* lcnt = (LAS int*)(lds + RT_CNT); LAS int* lbase = (LAS int*)(lds + RT_BASE);
    LAS unsigned* le = (LAS unsigned*)(lds + RT_LE); LAS float* lw = (LAS float*)(lds + RT_LW);
    const float bias = (args.in[16])[lane];
    for (int tile = F.vcu; tile < T / 256; tile += F.G) {
        const int s = (tile * 256) / TS, b = (tile * 256) / SEQ;
        { const u32x4* wsrc = (const u32x4*)((const bf16*)(args.ws + WS_WR) + (size_t)b * 64 * 1024);
          u32x4 wt[16];
#pragma unroll
          for (int j = 0; j < 16; ++j) wt[j] = wsrc[tid + 512 * j];
#pragma unroll
          for (int j = 0; j < 16; ++j) { const int i = tid + 512 * j, e = i >> 7, c = i & 127; *(LAS u32x4*)(lds + (e * RT_WST + 8 * c) * 2) = wt[j]; } }
        WG_BAR();
        const bf16* xb = (const bf16*)(args.ws + WS_X1) + (size_t)(tile * 256 + wave * 32) * D;
        f32x4 acc[2][4]; float ssq[2] = {0.f, 0.f};
#pragma unroll
        for (int g = 0; g < 2; ++g)
#pragma unroll
            for (int n = 0; n < 4; ++n) acc[g][n] = (f32x4){0.f, 0.f, 0.f, 0.f};
        constexpr int XG = 2;
        u32x4 xs0[XG][2], xs1[XG][2], xs2[XG][2], xs3[XG][2];
#define RT_XLOAD(dst, k0_) do { _Pragma("unroll") for (int q = 0; q < XG; ++q) _Pragma("unroll") for (int g = 0; g < 2; ++g) dst[q][g] = *(const u32x4*)(xb + (size_t)(16 * g + fr) * D + 32 * ((k0_) + q) + 8 * fq); } while (0)
#define RT_XMMA(srcx, k0_) do { _Pragma("unroll") for (int q = 0; q < XG; ++q) { const int ks = (k0_) + q; bf16x8 bfr[2]; \
            _Pragma("unroll") for (int g = 0; g < 2; ++g) { const u32x4 xv = srcx[q][g]; bfr[g] = __builtin_bit_cast(bf16x8, xv); float f[8]; unpack8(xv, f); _Pragma("unroll") for (int j = 0; j < 8; ++j) ssq[g] += f[j] * f[j]; } \
            _Pragma("unroll") for (int n = 0; n < 4; ++n) { const bf16x8 afr = *(const LAS bf16x8*)(lds + ((16 * n + fr) * RT_WST + 32 * ks + 8 * fq) * 2); \
                _Pragma("unroll") for (int g = 0; g < 2; ++g) acc[g][n] = __builtin_amdgcn_mfma_f32_16x16x32_bf16(afr, bfr[g], acc[g][n], 0, 0, 0); } } } while (0)
        RT_XLOAD(xs0, 0); RT_XLOAD(xs1, XG); RT_XLOAD(xs2, 2 * XG); RT_XLOAD(xs3, 3 * XG);
#pragma unroll 1
        for (int k0 = 0; k0 < 32; k0 += 4 * XG) {
            const int kn = k0 + 4 * XG < 32 ? k0 + 4 * XG : k0;
            RT_XMMA(xs0, k0);          RT_XLOAD(xs0, kn);
            RT_XMMA(xs1, k0 + XG);     RT_XLOAD(xs1, kn + XG);
            RT_XMMA(xs2, k0 + 2 * XG); RT_XLOAD(xs2, kn + 2 * XG);
            RT_XMMA(xs3, k0 + 3 * XG); RT_XLOAD(xs3, kn + 3 * XG);
        }
#undef RT_XLOAD
#undef RT_XMMA
        WG_BAR();
        if (tid < 64) lcnt[tid] = 0;
#pragma unroll
        for (int g = 0; g < 2; ++g) { float q = ssq[g]; q += __shfl_xor(q, 16); q += __shfl_xor(q, 32); const float rstd = rsqrtf(q * (1.0f / D) + EPS);
            if (fq == 0) *(LAS float*)(lds + RT_RS + (wave * 32 + 16 * g + fr) * 4) = rstd;
#pragma unroll
            for (int n = 0; n < 4; ++n) { const f32x4 rb = *(const f32x4*)((const float*)(args.ws + WS_RB) + b * 64 + 16 * n + 4 * fq);
                *(LAS f32x4*)(lds + RT_LOG + ((wave * 32 + 16 * g + fr) * 64 + 16 * n + 4 * fq) * 4) = acc[g][n] * rstd + rb; } }
        WG_BAR();
        f32x4 hsc[4], hsh[4];
#pragma unroll
        for (int j = 0; j < 4; ++j) { const int col = 16 * lane + 4 * j; const float* mod = (const float*)(args.ws + WS_MOD) + b * 6144;
            hsc[j] = *(const f32x4*)((args.in[14]) + col) * (*(const f32x4*)(mod + 4096 + col) + 1.0f); hsh[j] = *(const f32x4*)(mod + 3072 + col); }
        const bf16* xrow = (const bf16*)(args.ws + WS_X1) + (size_t)(tile * 256 + wave * 32) * D + 16 * lane;
        unsigned char* hrow = (unsigned char*)(args.ws + WS_H8) + (size_t)(tile * 256 + wave * 32) * D + 16 * lane;
        u32x4 xn0 = *(const u32x4*)(xrow), xn1 = *(const u32x4*)(xrow + 8);
#pragma unroll 2
        for (int i = 0; i < 32; ++i) {
            const int tl = wave * 32 + i;
            const u32x4 xc0 = xn0, xc1 = xn1;
            if (i + 1 < 32) { xn0 = *(const u32x4*)(xrow + (size_t)(i + 1) * D); xn1 = *(const u32x4*)(xrow + (size_t)(i + 1) * D + 8); }
            { const float rs = *(const LAS float*)(lds + RT_RS + tl * 4); float f[16]; { float t8[8]; unpack8(xc0, t8);
#pragma unroll
                for (int j = 0; j < 8; ++j) f[j] = t8[j]; unpack8(xc1, t8);
#pragma unroll
                for (int j = 0; j < 8; ++j) f[8 + j] = t8[j]; }
                u32x4 hw; unsigned hv[4];
#pragma unroll
                for (int j = 0; j < 4; ++j) { const f32x4 h = (f32x4){f[4 * j], f[4 * j + 1], f[4 * j + 2], f[4 * j + 3]} * rs * hsc[j] + hsh[j];
                    int q8 = __builtin_amdgcn_cvt_pk_fp8_f32(h.x, h.y, 0, false); q8 = __builtin_amdgcn_cvt_pk_fp8_f32(h.z, h.w, q8, true); hv[j] = (unsigned)q8; }
                hw.x = hv[0]; hw.y = hv[1]; hw.z = hv[2]; hw.w = hv[3];
                *(u32x4*)(hrow + (size_t)i * D) = hw; }
            const float logit = *(const LAS float*)(lds + RT_LOG + (tl * 64 + lane) * 4);
            const float score = __builtin_amdgcn_rcpf(1.0f + __expf(-logit)), sel = score + bias;
            const float m1 = max8(sel);
            const unsigned long long eq = __ballot(sel == m1);
            const unsigned gm = (unsigned)(eq >> (lane & 56)) & 0xffu;
            const int first = gm ? __builtin_ctz(gm) : 0;
            const float m2 = max8(((lane & 7) == first) ? -INFINITY : sel);
            const float gs = m1 + m2; const int g = lane >> 3; int grank = 0;
            const unsigned ghi = f32_key(gs); const unsigned long long gme = ((unsigned long long)ghi << 32) | (unsigned)(7 - g);
#pragma unroll
            for (int j = 0; j < 8; ++j) { const unsigned long long go = ((unsigned long long)(unsigned)__builtin_amdgcn_readlane((int)ghi, 8 * j) << 32) | (unsigned)(7 - j); grank += (go > gme) ? 1 : 0; }
            const bool gsel = grank < 4; const unsigned long long gmask = __ballot(gsel);
            int rank = 0;
            const unsigned khi = f32_key(sel); const unsigned long long kme = ((unsigned long long)khi << 32) | (unsigned)(63 - lane);
#pragma unroll
            for (int j = 0; j < 8; ++j) if ((gmask >> (8 * j)) & 1ull) {
#pragma unroll
                for (int i = 0; i < 8; ++i) { const unsigned long long ko = ((unsigned long long)(unsigned)__builtin_amdgcn_readlane((int)khi, 8 * j + i) << 32) | (unsigned)(63 - (8 * j + i)); rank += (ko > kme) ? 1 : 0; } }
            const bool chosen = gsel && rank < TOPK;
            const float wsum = wave_sum(chosen ? score : 0.f);
            if (chosen) { const int pos = __hip_atomic_fetch_add(lcnt + lane, 1, __ATOMIC_RELAXED, __HIP_MEMORY_SCOPE_WORKGROUP);
                le[tl * 8 + rank] = (unsigned)lane | ((unsigned)pos << 8); lw[tl * 8 + rank] = score / wsum * 2.5f; }
        }
        WG_BAR();
        if (tid < 64) lbase[tid] = (int)__hip_atomic_fetch_add(((unsigned*)(args.ws + WS_CTL) + CW_CNT) + s * 80 + tid, (unsigned)lcnt[tid], RLX_AGENT);
        WG_BAR();
        for (int idx = tid; idx < 2048; idx += 512) { const unsigned v = le[idx]; const int e = v & 0xffu; const size_t o = (size_t)tile * 2048 + idx;
            const int pos = (int)(v >> 8) + lbase[e]; ((int*)(args.ws + WS_IDX))[o] = e; ((int*)(args.ws + WS_APOS))[o] = pos; ((float*)(args.ws + WS_WGT))[o] = lw[idx];
            ((int*)(args.ws + WS_LIST))[(size_t)e * T + pos] = tile * 256 + (idx >> 3); }
        WG_BAR();
    }
}
__device__ __forceinline__ void load_eoff(const Frame& F_, CArgs& args_) {
    Frame F = F_; F.lane = lane_id_asm(); F.tid = F.wave * 64 + F.lane;
    ARGS_LAUNDER(args_);
    LAS int* eoff = (LAS int*)(F.lds + EO_OFF); LAS int* ecnt = (LAS int*)(F.lds + EC_OFF);
    if (F.tid < S_SB) { const int s = F.tid; int acc = 0;
        for (int e = 0; e < NEX; ++e) { const int cnt = e < NE ? (int)((unsigned*)(args.ws + WS_CTL) + CW_CNT)[s * 80 + e] : TS; eoff[s * 72 + e] = acc; ecnt[s * 72 + e] = cnt; acc += (cnt + 255) & ~255; }
        eoff[s * 72 + NEX] = acc; }
    WG_BAR();
}
__device__ __forceinline__ int moe_tables(const Frame& F_, CArgs& args_, int s, bool gather) {
    Frame F = F_; F.lane = lane_id_asm(); F.tid = F.wave * 64 + F.lane;
    ARGS_LAUNDER(args_);
    asm volatile("" : "+s"(s));
    const LAS int* eoff = (const LAS int*)(F.lds + EO_OFF) + s * 72;
    LAS unsigned char* te = F.lds + TE_OFF;
    const int NT = eoff[NEX] >> 8;
    for (int e = F.wave; e < NEX; e += 8) { const int t0 = eoff[e] >> 8, t1 = eoff[e + 1] >> 8; for (int t = t0 + F.lane; t < t1; t += 64) te[t] = (unsigned char)e; }
    WG_BAR();
    if (gather) { LAS unsigned* tab = (LAS unsigned*)(F.lds + TAB_OFF);
        int nsl = (2 * NT - F.vcu + F.G - 1) / F.G; nsl = nsl < 0 ? 0 : (nsl > TAB_SLOTS ? TAB_SLOTS : nsl);
        const int nent = nsl * 256; const int* LISTp = (const int*)(args.ws + WS_LIST);
#pragma unroll 1
        for (int base = 0; base < nent; base += 2048) {
            int tokv[4], dflt[4]; bool fromlist[4];
#pragma unroll
            for (int j = 0; j < 4; ++j) { int idx = base + j * 512 + F.tid; idx = idx < nent ? idx : nent - 1; const int i = idx >> 8, r = idx & 255, rt = (i * F.G + F.vcu) >> 1;
                const int e = te[rt], pos = rt * 256 - eoff[e] + r;
                fromlist[j] = e < NE && pos < ((const LAS int*)(F.lds + EC_OFF))[s * 72 + e]; dflt[j] = e < NE ? 0 : s * TS + pos;
                tokv[j] = LISTp[fromlist[j] ? (size_t)e * T + pos : (size_t)0]; }
#pragma unroll
            for (int j = 0; j < 4; ++j) { const int idx = base + j * 512 + F.tid; if (idx < nent) tab[idx] = (unsigned)(fromlist[j] ? tokv[j] : dflt[j]) * 1024u; }
        } }
    WG_BAR();
    return NT;
}
__device__ __forceinline__ void pc_combine(const Frame& F_, CArgs& args_, int s) {
    Frame F = F_; F.lane = lane_id_asm(); F.tid = F.wave * 64 + F.lane;
    ARGS_LAUNDER(args_);
    asm volatile("" : "+s"(s));
    const LAS int* eoff = (const LAS int*)(F.lds + EO_OFF) + s * 72;
    const int shoff = eoff[NE];
    const int gw = F.vcu * 8 + F.wave, NGW = F.G * 8, lane = F.lane;
    constexpr int PER = 16;
    const unsigned char* Y8 = (const unsigned char*)(args.ws + WS_A); const bf16* x1b = (const bf16*)(args.ws + WS_X1);
    for (int blk = gw; blk < TS / PER; blk += NGW) {
        const int tl0 = blk * PER, b = (s * TS + tl0) / SEQ;
        f32x4 g2[4], nf[4];
#pragma unroll
        for (int i = 0; i < 4; ++i) { const int col = 256 * i + 4 * lane; g2[i] = *(const f32x4*)(((float*)(args.ws + WS_MOD)) + b * 6144 + 5120 + col); nf[i] = *(const f32x4*)((args.in[23]) + col); }
#pragma unroll 2
        for (int r = 0; r < PER; ++r) {
            const int tl = tl0 + r, t = s * TS + tl;
            f32x4 acc[4];
#pragma unroll
            for (int i = 0; i < 4; ++i) acc[i] = (f32x4){0.f, 0.f, 0.f, 0.f};
#pragma unroll
            for (int k = 0; k < 9; ++k) {
                const int row = k < 8 ? eoff[((int*)(args.ws + WS_IDX))[(size_t)t * 8 + k]] + ((int*)(args.ws + WS_APOS))[(size_t)t * 8 + k] : shoff + tl; const float w = (k < 8 ? ((float*)(args.ws + WS_WGT))[(size_t)t * 8 + k] : 1.0f) * (1.0f / 16.0f);
                unsigned yw[4];
#pragma unroll
                for (int i = 0; i < 4; ++i) yw[i] = *(const unsigned*)(Y8 + (size_t)row * D + 256 * i + 4 * lane);
#pragma unroll
                for (int i = 0; i < 4; ++i) { const f32x2 lo = __builtin_amdgcn_cvt_pk_f32_fp8((int)yw[i], false), hi = __builtin_amdgcn_cvt_pk_f32_fp8((int)yw[i], true);
                    acc[i] = acc[i] + (f32x4){lo.x, lo.y, hi.x, hi.y} * w; }
            }
            float* orow = (args.out) + (size_t)t * D + 4 * lane; float ss = 0.f; f32x4 xf[4];
#pragma unroll
            for (int i = 0; i < 4; ++i) { const u32x2 xw = *(const u32x2*)(x1b + (size_t)t * D + 256 * i + 4 * lane); const f32x4 x1 = (f32x4){bflo(xw.x), bfhi(xw.x), bflo(xw.y), bfhi(xw.y)}; const f32x4 v = x1 + g2[i] * acc[i]; xf[i] = v; ss += (v.x * v.x + v.y * v.y) + (v.z * v.z + v.w * v.w); }
            const float rstd = rsqrtf(wave_sum(ss) * (1.0f / D) + EPS);
#pragma unroll
            for (int i = 0; i < 4; ++i) *(f32x4*)(orow + 256 * i) = xf[i] * rstd * nf[i];
        }
    }
}

__device__ __forceinline__ void stagger(int quanta) { const int j = ((int)blockIdx.x >> 3) & 7; for (int i = 0; i < j * quanta; ++i) __builtin_amdgcn_s_sleep(16); }

constexpr int NPH = 10 + 3 * S_SB;
__global__ void __launch_bounds__(512, 2) fwd_kernel(Args args_k) {
    CArgs& kargs = *(CArgs*)__builtin_amdgcn_kernarg_segment_ptr();
    extern __shared__ __attribute__((aligned(16))) unsigned char lds_raw[];
    Frame F;
    F.lds = (LAS unsigned char*)lds_raw; F.MISC = (volatile LAS unsigned*)(F.lds + MISC_OFF);
    F.wave = __builtin_amdgcn_readfirstlane((int)threadIdx.x >> 6); F.lane = 0; F.tid = 0;
    F.G = gridDim.x; { const int bx = blockIdx.x; F.vcu = (F.G % 8 == 0) ? (bx % 8) * (F.G / 8) + bx / 8 : bx; }
    F.ctl = (unsigned*)(kargs.ws + WS_CTL);
    if (threadIdx.x < 64) ((LAS unsigned*)(F.lds + MISC_OFF))[threadIdx.x] = 0u;
    __syncthreads();
    XcdBarrier bar; bar.bar = F.ctl + CW_BAR; bar.x = 0; bar.st = nullptr;
    if (!MK_PER_PHASE) bar = xcd_barrier_post(F.ctl + CW_BAR, F.MISC);
    const int lo = MK_PER_PHASE ? kargs.ph_lo : 0, hi = MK_PER_PHASE ? kargs.ph_hi : NPH;
#ifndef PH_ENABLE
#define PH_ENABLE 0xffffffffu
#endif
#define IN(k) (((PH_ENABLE >> ((k) > 9 ? 10 + ((k) - 10) % 3 : (k))) & 1u) && lo <= (k) && (k) < hi)
#ifndef DUP_MASK
#define DUP_MASK 0u
#endif
#define REPEAT(k) _Pragma("unroll 1") for (int rep_ = 0; rep_ < 1 + (int)((DUP_MASK >> (k)) & 1u); ++rep_)
#define SEAM(k) do { if (!MK_PER_PHASE && IN(k) && IN((k) + 1)) xcd_barrier(bar, F.wave); } while (0)

    if (IN(0)) { REPEAT(0) { p0_prologue(F, kargs); } SEAM(0); }
    if (IN(1)) { ARGS_LAUNDER(kargs); p1_router_weights(F, kargs); REPEAT(1) { p_norm_mod<true, false>(F, kargs, (args.in[0]), (args.in[4]), 0, 1024, ((bf16*)(args.ws + WS_HB)), nullptr); } SEAM(1); }
    if (IN(2)) { ARGS_LAUNDER(kargs);
        pg8::PlainOrder S; S.init(((bf16*)(args.ws + WS_HB)), ((bf16*)(args.ws + WS_WIN)), T, NPROJ, D, F.G, (int)blockIdx.x); pg8::EpiBf16T E{((bf16*)(args.ws + WS_A)), NPROJ / 256};
        stagger(STG_P2); REPEAT(2) { pg8::gemm_phase<pg8::EpiBf16T, pg8::PlainOrder, true>(F.lds, F.wave, D, S, E); } SEAM(2); }
    if (IN(3)) { REPEAT(3) { p3_conv(F, kargs); } SEAM(3); }
    if (IN(4)) { REPEAT(4) { p4_ssd(F, kargs); } SEAM(4); }
    if (IN(5)) { ARGS_LAUNDER(kargs);
        pg8::PlainOrder S; S.init(((bf16*)(args.ws + WS_HB)), ((bf16*)(args.ws + WS_WOUT)), T, D, D, F.G, (int)blockIdx.x);
        {
            const int lane = lane_id_asm(), tid = F.wave * 64 + lane, r = tid & 255, hf = tid >> 8;
            LAS float* rstab = (LAS float*)(F.lds + TAB_OFF); LAS float* tmp = (LAS float*)(F.lds);
            pg8::Unit u;
            for (int i0 = 0; i0 < 16; i0 += 4) {
                float sv[4]; bool ok[4]; float pv[4][16];
#pragma unroll
                for (int j = 0; j < 4; ++j) { ok[j] = S.next(i0 + j, u); const int pm = ok[j] ? u.pm : 0;
                    const float* sp = ((const float*)(args.ws + WS_SSQ)) + (size_t)(16 * hf) * T + pm * 256 + r;
#pragma unroll
                    for (int q = 0; q < 16; ++q) pv[j][q] = sp[(size_t)q * T]; }
#pragma unroll
                for (int j = 0; j < 4; ++j) { float s = 0.f;
#pragma unroll
                    for (int q = 0; q < 16; ++q) s += pv[j][q];
                    sv[j] = s; if (hf) tmp[j * 256 + r] = s; }
                WG_BAR();
#pragma unroll
                for (int j = 0; j < 4; ++j) if (!hf && ok[j]) rstab[(i0 + j) * 256 + r] = rsqrtf((sv[j] + tmp[j * 256 + r]) * (1.0f / 512.0f) + EPS);
                WG_BAR();
                if (!ok[3]) break;
            }
        }
        pg8::EpiX1 E{(args.in[0]), (bf16*)(args.ws + WS_X1), ((float*)(args.ws + WS_MOD)) + 2048, (const LAS float*)(F.lds + TAB_OFF)};
        stagger(STG_P5); REPEAT(5) { pg8::gemm_phase<pg8::EpiX1, pg8::PlainOrder, false>(F.lds, F.wave, D, S, E); } SEAM(5); }
    if (IN(6)) { p7_router(F, kargs); SEAM(9); }
    load_eoff(F, kargs);
    for (int s = 0; s < S_SB; ++s) {
        const int k0 = 10 + 3 * s;
        if (IN(k0)) { ARGS_LAUNDER(kargs);
            const int NT = moe_tables(F, kargs, s, true);
            pg8::MoeOrder<1, true> S; S.NT = NT; S.G = F.G; S.c = F.vcu; S.A = (const char*)(args.ws + WS_H8); S.W = (const char*)(args.ws + WS_WGU); S.rowb = 0; S.w_exp = (size_t)512 * 1024; S.w_tile = (size_t)256 * 1024;
            S.te = F.lds + TE_OFF; S.tab = (const LAS unsigned*)(F.lds + TAB_OFF);
            pg8::EpiGU E{(unsigned char*)(args.ws + WS_HID)};
            stagger(STG_G); REPEAT(10) { pg8::gemm_phase<pg8::EpiGU, pg8::MoeOrder<1, true>, true, true>(F.lds, F.wave, D, S, E); } SEAM(k0); }
        if (IN(k0 + 1)) { ARGS_LAUNDER(kargs);
            const int NT = moe_tables(F, kargs, s, false);
            pg8::MoeOrderD S; S.NT = NT; S.G = F.G; S.c = F.vcu; S.A = (const char*)(args.ws + WS_HID); S.W = (const char*)(args.ws + WS_WD); S.rowb = 256u; S.w_exp = (size_t)1024 * 256; S.w_tile = (size_t)256 * 256;
            S.te = F.lds + TE_OFF;
            pg8::EpiFp8 E{(unsigned char*)(args.ws + WS_A), D, 1.0f, (unsigned char*)(args.ws + WS_LIST)};
            int Kd = 256; asm volatile("" : "+s"(Kd));
            stagger(STG_D); REPEAT(11) { pg8::gemm_phase<pg8::EpiFp8, pg8::MoeOrderD, true, true>(F.lds, F.wave, Kd, S, E); } SEAM(k0 + 1); }
        if (IN(k0 + 2)) { pc_combine(F, kargs, s); if (MK_PER_PHASE == 0 && s + 1 < S_SB) { asm volatile("s_waitcnt vmcnt(0)" ::: "memory"); __syncthreads(); } }
    }
#undef IN
#undef SEAM
}

extern "C" void kernel_launch(void* const* d_in, const int* in_sizes, int n_in, void* d_out, int out_size, void* d_ws, size_t ws_size, hipStream_t stream) {
    static int grid = 0;
    if (grid == 0) {
        if (n_in != 24 || in_sizes[0] != T * D || out_size != T * D || ws_size < WS_END) { fprintf(stderr, "kernel_launch: unexpected shapes / workspace (n_in %d, ws %zu, need %zu)\n", n_in, ws_size, (size_t)WS_END); grid = -1; return; }
        int dev = 0, cus = 0, per_cu = 0;
        if (hipGetDevice(&dev) != hipSuccess || hipDeviceGetAttribute(&cus, hipDeviceAttributeMultiprocessorCount, dev) != hipSuccess) { grid = -1; return; }
        if (hipFuncSetAttribute((const void*)fwd_kernel, hipFuncAttributeMaxDynamicSharedMemorySize, LDS_BYTES) != hipSuccess) { fprintf(stderr, "kernel_launch: hipFuncSetAttribute failed\n"); grid = -1; return; }
        if (hipOccupancyMaxActiveBlocksPerMultiprocessor(&per_cu, (const void*)fwd_kernel, 512, LDS_BYTES) != hipSuccess || per_cu < 1) fprintf(stderr, "kernel_launch: occupancy query says %d\n", per_cu);
        (void)hipGetLastError();
        grid = cus;
    }
    if (grid < 0) return;
    if (hipMemsetAsync((char*)d_ws + WS_CTL, 0, CTL_ZERO_BYTES, stream) != hipSuccess) return;
    Args a{};
    for (int i = 0; i < 24; ++i) a.in[i] = (const float*)d_in[i];
    a.out = (float*)d_out; a.ws = (unsigned char*)d_ws;
#if MK_PER_PHASE
    for (int p = 0; p < NPH; ++p) { a.ph_lo = p; a.ph_hi = p + 1; hipLaunchKernelGGL(fwd_kernel, dim3(grid), dim3(512), LDS_BYTES, stream, a); }
#else
    a.ph_lo = 0; a.ph_hi = NPH;
    hipLaunchKernelGGL(fwd_kernel, dim3(grid), dim3(512), LDS_BYTES, stream, a);
#endif
}
```

```cpp
#include <hip/hip_runtime.h>
#include <cstdio>
#include <cstdint>

#define LAS __attribute__((address_space(3)))
#define GAS __attribute__((address_space(1)))
typedef unsigned short bf16;
typedef short bf16x8 __attribute__((ext_vector_type(8)));
typedef float f32x4 __attribute__((ext_vector_type(4)));
typedef float f32x2 __attribute__((ext_vector_type(2)));
typedef unsigned u32x4 __attribute__((ext_vector_type(4)));
typedef unsigned u32x2 __attribute__((ext_vector_type(2)));

#define STG_P2 0
#define STG_P5 0
#define STG_G 0
#define STG_D 0
#ifndef MK_PER_PHASE
#define MK_PER_PHASE 0
#endif

constexpr int T = 65536, D = 1024, SEQ = 4096, NB = 16;
constexpr int NPROJ = 3072, LDWIN = 3080;
constexpr int NPJ = 2560;
constexpr int C_CB = 0, C_P = 512, C_Z = 1024, C_XBC = 1536;
constexpr int NE = 64, NEX = 65, TOPK = 8;
constexpr int S_SB = 1, TS = T / S_SB;
constexpr int MAXT = (TS * 9) / 256 + 64;
constexpr int MAXROWS = MAXT * 256;
constexpr float EPS = 1e-6f;

constexpr size_t MiB = 1u << 20;
constexpr size_t WS_CTL = 0, CTL_ZERO_BYTES = 1 * MiB;
constexpr size_t WS_MOD = 128 * 1024;
constexpr size_t WS_WDT = 1 * MiB;
constexpr size_t WS_WIN = 2 * MiB, WS_WOUT = 8 * MiB, WS_WR = 10 * MiB;
constexpr size_t WS_RB = 1 * MiB + 64 * 1024;
constexpr size_t WS_WGU = 12 * MiB;
constexpr size_t WS_WD = 45 * MiB;
constexpr size_t WS_DT = 62 * MiB;
constexpr size_t WS_IDX = 64 * MiB, WS_WGT = 66 * MiB, WS_APOS = 68 * MiB, WS_ROWOF = 70 * MiB;
constexpr size_t WS_R2T = 72 * MiB;
constexpr size_t WS_HB = 76 * MiB;
constexpr size_t WS_HID = 76 * MiB;
constexpr size_t WS_A = 232 * MiB;
constexpr size_t WS_XC = 616 * MiB;
constexpr size_t WS_SSQ = 744 * MiB;
constexpr size_t WS_LOG = 752 * MiB;
constexpr size_t WS_H8 = 768 * MiB;
constexpr size_t WS_X1 = 832 * MiB;
constexpr size_t WS_LIST = 960 * MiB;
constexpr size_t WS_END = 976 * MiB;
static_assert(WS_WGU + (size_t)NEX * 512 * 1024 <= WS_WD && WS_WD + (size_t)NEX * 1024 * 256 <= WS_DT && WS_R2T + (size_t)S_SB * MAXROWS * 4 <= WS_HB && WS_HID + (size_t)MAXROWS * 256 <= WS_A && WS_HB + (size_t)T * D * 2 <= WS_A
              && WS_A + (size_t)T * NPROJ * 2 <= WS_XC && WS_A + (size_t)MAXROWS * 1024 <= WS_X1 && WS_XC + (size_t)T * D * 2 <= WS_SSQ && WS_SSQ + (size_t)32 * T * 4 <= WS_LOG && WS_LOG + (size_t)T * 64 * 4 <= WS_H8
              && WS_H8 + (size_t)T * D <= WS_X1 && WS_X1 + (size_t)T * D * 2 <= WS_LIST && WS_LIST + (size_t)NE * T * 4 <= WS_END, "ws map");
constexpr int CW_BAR = 4096;
constexpr int CW_CNT = 8192;

constexpr int RING_BYTES = 131072;
constexpr int TAB_SLOTS = 20;
constexpr int TAB_OFF = RING_BYTES, TAB_BYTES = TAB_SLOTS * 1024;
constexpr int TE_OFF = TAB_OFF + TAB_BYTES;
constexpr int EO_OFF = TE_OFF + ((MAXT + 63) / 64) * 64;
constexpr int EC_OFF = EO_OFF + S_SB * 72 * 4;
constexpr int MISC_OFF = EC_OFF + S_SB * 72 * 4;
constexpr int LDS_BYTES = ((MISC_OFF + 256 + 1023) / 1024) * 1024;
static_assert(LDS_BYTES <= 160 * 1024 && (2 * MAXT + 255) / 256 <= TAB_SLOTS, "LDS");

#define RLX_AGENT __ATOMIC_RELAXED, __HIP_MEMORY_SCOPE_AGENT
#define LDS_WAIT() asm volatile("s_waitcnt lgkmcnt(0)" ::: "memory")
#define WG_BAR() do { asm volatile("s_waitcnt lgkmcnt(0)" ::: "memory"); __builtin_amdgcn_s_barrier(); asm volatile("" ::: "memory"); } while (0)
__device__ __forceinline__ unsigned cvt_pk_bf16(float lo, float hi) { unsigned r; asm volatile("v_cvt_pk_bf16_f32 %0, %1, %2" : "=v"(r) : "v"(lo), "v"(hi)); return r; }
__device__ __forceinline__ float bflo(unsigned w) { return __uint_as_float(w << 16); }
__device__ __forceinline__ float bfhi(unsigned w) { return __uint_as_float(w & 0xffff0000u); }
__device__ __forceinline__ float bf2f(unsigned short h) { return __uint_as_float(((unsigned)h) << 16); }
__device__ __forceinline__ unsigned short f2bf(float f) { return (unsigned short)(cvt_pk_bf16(f, 0.f) & 0xffffu); }
__device__ __forceinline__ float silu_f(float x) { return x * __builtin_amdgcn_rcpf(1.0f + __expf(-x)); }
#define DPP_F(v, ctrl) __int_as_float(__builtin_amdgcn_update_dpp(0, __float_as_int(v), (ctrl), 0xf, 0xf, false))
__device__ __forceinline__ float wave_sum(float v) {
    v += DPP_F(v, 0xB1); v += DPP_F(v, 0x4E); v += DPP_F(v, 0x141); v += DPP_F(v, 0x140);
    const float r0 = __int_as_float(__builtin_amdgcn_readlane(__float_as_int(v), 0)), r1 = __int_as_float(__builtin_amdgcn_readlane(__float_as_int(v), 16)),
                r2 = __int_as_float(__builtin_amdgcn_readlane(__float_as_int(v), 32)), r3 = __int_as_float(__builtin_amdgcn_readlane(__float_as_int(v), 48));
    return (r0 + r1) + (r2 + r3);
}
__device__ __forceinline__ float max8(float v) {
    v = fmaxf(v, DPP_F(v, 0xB1)); v = fmaxf(v, DPP_F(v, 0x4E)); v = fmaxf(v, DPP_F(v, 0x141)); return v;
}
__device__ __forceinline__ unsigned f32_key(float f) { const unsigned b = __float_as_uint(f); return b ^ ((b >> 31) ? 0xffffffffu : 0x80000000u); }
__device__ __forceinline__ void unpack8(const u32x4 w, float (&f)[8]) {
    f[0] = bflo(w.x); f[1] = bfhi(w.x); f[2] = bflo(w.y); f[3] = bfhi(w.y); f[4] = bflo(w.z); f[5] = bfhi(w.z); f[6] = bflo(w.w); f[7] = bfhi(w.w);
}
__device__ __forceinline__ u32x4 pack8(const float (&f)[8]) {
    u32x4 w; w.x = cvt_pk_bf16(f[0], f[1]); w.y = cvt_pk_bf16(f[2], f[3]); w.z = cvt_pk_bf16(f[4], f[5]); w.w = cvt_pk_bf16(f[6], f[7]); return w;
}

__device__ __forceinline__ int lane_id_asm() { int l; asm volatile("v_mbcnt_lo_u32_b32 %0, -1, 0\n\tv_mbcnt_hi_u32_b32 %0, -1, %0" : "=v"(l)); return l; }

__device__ __forceinline__ size_t pj(size_t row, int col) { return ((row >> 8) * (NPJ / 256) + (size_t)(col >> 8)) * 65536 + (row & 255) * 256 + (size_t)(col & 255); }

#define XB_TMO      128
#define XB_XCNT(j)  (256  + 64 * (j))
#define XB_XSUB(j)  (1280 + 64 * (j))
#define XB_XGEN(j)  (2304 + 64 * (j))
#define XB_TOP      3328
#define XB_TOPGEN   3392
#define XCD_BAR_WORDS 3456
#define XB_SPIN_CAP (1u << 18)
__device__ __forceinline__ unsigned xb_ld(unsigned* p)              { return __hip_atomic_load(p, __ATOMIC_RELAXED, __HIP_MEMORY_SCOPE_AGENT); }
__device__ __forceinline__ unsigned xb_add(unsigned* p, unsigned v) { return __hip_atomic_fetch_add(p, v, __ATOMIC_RELAXED, __HIP_MEMORY_SCOPE_AGENT); }
__device__ __forceinline__ unsigned xb_xcc_id() { return (unsigned)__builtin_amdgcn_s_getreg((3 << 11) | 20) & 0xFu; }
#define XB_SPIN(cond, bar) do { unsigned _sp = 0; while (cond) { __builtin_amdgcn_s_sleep(1); \
    if ((++_sp & 255u) == 0u) { if (xb_ld(&(bar)[XB_TMO])) break; if (_sp > XB_SPIN_CAP) { atomicAdd(&(bar)[XB_TMO], 1u); break; } } } } while (0)
struct XcdBarrier { unsigned* bar; unsigned x; volatile LAS unsigned* st; };
__device__ __forceinline__ XcdBarrier xcd_barrier_post(unsigned* bar, volatile LAS unsigned* st) {
    XcdBarrier b; b.bar = bar; b.x = xb_xcc_id(); b.st = st;
    if (threadIdx.x == 0) (void)xb_add(&bar[XB_XCNT(b.x)], 1u);
    return b;
}
__device__ __forceinline__ void xcd_barrier_complete(unsigned* bar, unsigned x, unsigned& nloc, unsigned& nx) {
    const unsigned G = gridDim.x * gridDim.y * gridDim.z;
    unsigned sum, cnt, mine, sp = 0u;
    for (;;) {
        sum = 0u; cnt = 0u; mine = 0u;
#pragma unroll
        for (unsigned j = 0; j < 16; ++j) { const unsigned c = xb_ld(&bar[XB_XCNT(j)]); sum += c; cnt += (c > 0u) ? 1u : 0u; mine = (j == x) ? c : mine; }
        if (sum == G) break;
        __builtin_amdgcn_s_sleep(1);
        if ((++sp & 255u) == 0u) { if (xb_ld(&bar[XB_TMO])) break; if (sp > XB_SPIN_CAP) { atomicAdd(&bar[XB_TMO], 1u); break; } }
    }
    nloc = mine > 0u ? mine : 1u; nx = cnt > 0u ? cnt : 1u;
}
__device__ __forceinline__ void xcd_barrier(const XcdBarrier& b, const int wave) {
    asm volatile("s_waitcnt vmcnt(0)" ::: "memory");
    __syncthreads();
    if (wave == 0 && lane_id_asm() == 0) {
        unsigned* bar = b.bar;
        __builtin_amdgcn_s_waitcnt(0);
        unsigned nloc = b.st[0], nx = b.st[1];
        if (nloc == 0u) { xcd_barrier_complete(bar, b.x, nloc, nx); b.st[0] = nloc; b.st[1] = nx; }
        const unsigned old = xb_add(&bar[XB_XSUB(b.x)], 1u);
        const unsigned gen = old / nloc;
        if (old + 1u == (gen + 1u) * nloc) {
            __builtin_amdgcn_fence(__ATOMIC_RELEASE, "agent");
            asm volatile("s_waitcnt vmcnt(0)" ::: "memory");
            const unsigned og = xb_add(&bar[XB_TOP], 1u);
            const unsigned tg = og / nx;
            if (og + 1u == (tg + 1u) * nx) xb_add(&bar[XB_TOPGEN], 1u);
            else XB_SPIN(xb_ld(&bar[XB_TOPGEN]) == tg, bar);
            __builtin_amdgcn_fence(__ATOMIC_ACQUIRE, "agent");
            xb_add(&bar[XB_XGEN(b.x)], 1u);
            asm volatile("s_waitcnt vmcnt(0)" ::: "memory");
        } else {
            XB_SPIN(xb_ld(&bar[XB_XGEN(b.x)]) == gen, bar);
            __builtin_amdgcn_fence(__ATOMIC_ACQUIRE, "agent");
            asm volatile("s_waitcnt vmcnt(0)" ::: "memory");
        }
    }
    __syncthreads();
}

namespace pg8 {
constexpr int BM = 256, BK = 64, HALF = 128, HTB = HALF * BK * 2, STAGE_BYTES = 8 * HTB, NXCD = 8, WGM = 8;
__host__ __device__ __forceinline__ int lds_byte(int r, int c) { const int st = (r >> 4) * 2 + (c >> 5), rr = r & 15, cc = c & 31, ob = rr * 64 + cc * 2; return st * 1024 + (ob ^ (((ob >> 9) & 1) << 5)); }
__host__ __device__ __forceinline__ void stage_rc(int b, int& R, int& C) { const int st = b / 1024, sb = b % 1024, swz = sb ^ (((sb >> 9) & 1) << 5); R = (st >> 1) * 16 + swz / 64; C = (st & 1) * 32 + (swz % 64) / 2; }
__host__ __device__ __forceinline__ int perm32(int rho) { const int n = rho >> 4, i = rho & 15; return 8 * (i >> 2) + 4 * n + (i & 3); }

struct Unit { int pm, pn, ord; const char* a; const char* b; };

struct PlainOrder {
    static constexpr bool GATHER = false;
    int nM, nN, nwg, G, c; const char* A; const char* Bt; size_t tstep;
    __device__ void init(const void* A_, const void* Bt_, int M, int N, int K, int G_, int c_) { nM = M / BM; nN = N / BM; nwg = nM * nN; G = G_; c = c_; A = (const char*)A_; Bt = (const char*)Bt_; tstep = (size_t)BM * K * 2; }
    __device__ bool next(int i, Unit& u) const {
#if defined(PROBE_PK)
        const long L = (long)(i >> 1) * G + c; if (L >= nwg) return false;
#else
        const long L = (long)i * G + c; if (L >= nwg) return false;
#endif
        int wgid = (int)L; { const int q = nwg / NXCD, r = nwg % NXCD, xcd = wgid % NXCD, off = wgid / NXCD; wgid = (xcd < r ? xcd * (q + 1) : r * (q + 1) + (xcd - r) * q) + off; }
        const int nig = WGM * nN, gid = wgid / nig, fm = gid * WGM, gsz = (nM - fm) < WGM ? (nM - fm) : WGM;
        u.pm = fm + ((wgid % nig) % gsz); u.pn = (wgid % nig) / gsz; u.ord = i; u.a = A + (size_t)u.pm * tstep; u.b = Bt + (size_t)u.pn * tstep; return true;
    }
    __device__ __forceinline__ unsigned aoff(int, int) const { return 0u; }
};
template <int SH, bool TAB> struct MoeOrder {
    static constexpr bool GATHER = true;
    int NT, G, c; const char* A; const char* W; unsigned rowb; size_t w_exp, w_tile; const LAS unsigned char* te; const LAS unsigned* tab;
    __device__ bool next(int i, Unit& u) const {
#if defined(PROBE_GK)
        const int L = (SH == 1 ? (i >> 1) : i) * G + c; const int rt = L >> SH; if (rt >= NT) return false;
#elif defined(PROBE_DK)
        const int L = (SH == 2 ? (i >> 1) : i) * G + c; const int rt = L >> SH; if (rt >= NT) return false;
#else
        const int L = i * G + c; const int rt = L >> SH; if (rt >= NT) return false;
#endif
        u.pm = rt; u.pn = L & ((1 << SH) - 1); u.ord = i; const int e = te[rt];
        u.a = A; u.b = W + (size_t)e * w_exp + (size_t)u.pn * w_tile; return true;
    }
    __device__ __forceinline__ unsigned aoff(int ord, int r) const { if constexpr (TAB) {
#if defined(PROBE_GK)
            return tab[(ord >> 1) * 256 + r];
#else
            return tab[ord * 256 + r];
#endif
        } else return (unsigned)((((ord * G + c) >> SH) << 8) + r) * rowb; }
};

struct MoeOrderD {
    static constexpr bool GATHER = false;
    int NT, G, c; const char* A; const char* W; unsigned rowb; size_t w_exp, w_tile; const LAS unsigned char* te;
    __device__ bool next(int i, Unit& u) const {
        const int L = i * G + c; const int rt = L >> 2; if (rt >= NT) return false;
        u.pm = rt; u.pn = L & 3; u.ord = i; const int e = te[rt];
        u.a = A + (size_t)rt * 256 * rowb; u.b = W + (size_t)e * w_exp + (size_t)u.pn * w_tile; return true;
    }
    __device__ __forceinline__ unsigned aoff(int, int) const { return 0u; }
};
__device__ __forceinline__ const GAS char* uni_ptr(const char* p) { const unsigned long long v = (unsigned long long)p; const unsigned lo = (unsigned)__builtin_amdgcn_readfirstlane((int)(unsigned)v), hi = (unsigned)__builtin_amdgcn_readfirstlane((int)(unsigned)(v >> 32)); return (const GAS char*)(((unsigned long long)hi << 32) | lo); }
template <class Epi, class Sched, bool ALIGN_EPI, bool F8 = false>
__device__ __forceinline__ void gemm_phase(LAS unsigned char* lds, const int wid, const int K, const Sched& S, const Epi& E) {
    const int lane = lane_id_asm(), tid = wid * 64 + lane,
        wr = wid >> 2, wc = wid & 3, fr = lane & 15, fq = lane >> 4;
    const int nt = F8 ? K / 128 : K / BK; const int RB = F8 ? K : 2 * K;
    unsigned voffA[2], voffB[2];
#pragma unroll
    for (int i = 0; i < 2; ++i) { int R, C; stage_rc(tid * 16 + i * 8192, R, C); const int Rb = (int)Epi::PERM == 2 ? (64 * (R >> 5) + 16 * ((R >> 2) & 3) + 4 * ((R >> 4) & 1) + (R & 3)) : (Epi::PERM ? ((R & ~31) + perm32(R & 31)) : R);
        voffA[i] = (unsigned)(R * RB + C * 2); voffB[i] = (unsigned)(Rb * RB + C * 2); }
    const size_t kstep = (size_t)(BK * 2);
    const size_t hstep = (size_t)HALF * RB;
    const size_t hstepB = (int)Epi::PERM == 2 ? (size_t)8 * RB : hstep;
    const unsigned ldsw = (unsigned)wid * 1024u;
    const int aoff = lds_byte(wr * 64 + fr, fq * 8), boff = lds_byte(wc * 32 + fr, fq * 8);
#define PG8_SA(b, h) (((b) * 2 + (h)) * HTB)
#define PG8_SB(b, h) ((4 + (b) * 2 + (h)) * HTB)
    const unsigned ldsbase = (unsigned)(unsigned long long)(const LAS void*)lds;
#define PG8_STAGE(bufoff, gbase, voff) do { _Pragma("unroll") for (int _i = 0; _i < 2; ++_i) { const unsigned m0v_ = ldsbase + (unsigned)(bufoff) + ldsw + (unsigned)_i * 8192u; \
        asm volatile("s_mov_b32 m0, %2\n\ts_nop 0\n\tglobal_load_lds_dwordx4 %0, %1" :: "v"((voff)[_i]), "s"(gbase), "s"(m0v_) : "memory", "m0"); } } while (0)
#define PG8_STAGE_A(bufoff, kb, h, GO) do { if constexpr (Sched::GATHER) { PG8_STAGE(bufoff, kb, GO[h]); } else { PG8_STAGE(bufoff, (kb) + (h) * hstep, voffA); } } while (0)
#define PG8_STAGE_A2(bufoff, kb, h) do { if constexpr (Sched::GATHER) { if (last) { PG8_STAGE(bufoff, kb, gN[h]); } else { PG8_STAGE(bufoff, kb, gC[h]); } } else { PG8_STAGE(bufoff, (kb) + (h) * hstep, voffA); } } while (0)
#define PG8_FR(p) (*(const LAS v4i_*)(p))
#define PG8_LDA(dst, b, h) do { _Pragma("unroll") for (int m = 0; m < 4; ++m) { if constexpr (F8) { dst##8[m] = __builtin_shufflevector(PG8_FR(lds + PG8_SA(b, h) + aoff + m * 2048), PG8_FR(lds + PG8_SA(b, h) + aoff + m * 2048 + 1024), 0, 1, 2, 3, 4, 5, 6, 7); } \
        else { _Pragma("unroll") for (int k = 0; k < 2; ++k) dst[m][k] = *(const LAS bf16x8*)(lds + PG8_SA(b, h) + aoff + m * 2048 + k * 1024); } } } while (0)
#define PG8_LDB(dst, b, h) do { _Pragma("unroll") for (int n = 0; n < 2; ++n) { if constexpr (F8) { dst##8[n] = __builtin_shufflevector(PG8_FR(lds + PG8_SB(b, h) + boff + n * 2048), PG8_FR(lds + PG8_SB(b, h) + boff + n * 2048 + 1024), 0, 1, 2, 3, 4, 5, 6, 7); } \
        else { _Pragma("unroll") for (int k = 0; k < 2; ++k) dst[n][k] = *(const LAS bf16x8*)(lds + PG8_SB(b, h) + boff + n * 2048 + k * 1024); } } } while (0)
#define PG8_MMA(ai, bj, At, Bt) do { __builtin_amdgcn_s_setprio(1); _Pragma("unroll") for (int m = 0; m < 4; ++m) _Pragma("unroll") for (int n = 0; n < 2; ++n) { \
        if constexpr (F8) { acc[ai][bj][m][n] = __builtin_amdgcn_mfma_scale_f32_16x16x128_f8f6f4(Bt##8[n], At##8[m], acc[ai][bj][m][n], 0, 0, 0, 0x7f7f7f7f, 0, Epi::MXSCALE); } \
        else { _Pragma("unroll") for (int k = 0; k < 2; ++k) acc[ai][bj][m][n] = __builtin_amdgcn_mfma_f32_16x16x32_bf16(Bt[n][k], At[m][k], acc[ai][bj][m][n], 0, 0, 0); } } \
        if constexpr (F8) { _Pragma("unroll") for (int m = 0; m < 4; ++m) asm volatile("" : "+v"(acc[ai][bj][m][0]), "+v"(acc[ai][bj][m][1])); }     \
        __builtin_amdgcn_s_setprio(0); } while (0)
#define PG8_WAIT_V(n) asm volatile("s_waitcnt vmcnt(" #n ")" ::: "memory")
#define PG8_WAIT_L(n) asm volatile("s_waitcnt lgkmcnt(" #n ")" ::: "memory")
#define PG8_WAIT_VR(relax) do { if (relax) asm volatile("s_waitcnt vmcnt(%0)" :: "n"(8 + Epi::NSTORE) : "memory"); else asm volatile("s_waitcnt vmcnt(8)" ::: "memory"); } while (0)
#define PG8_BAR do { __builtin_amdgcn_s_barrier(); if constexpr (F8) asm volatile("" ::: "memory"); } while (0)
#define PG8_SCHED __builtin_amdgcn_sched_barrier(0)
#define PG8_GLOAD(G_, u_) do { if constexpr (Sched::GATHER) { _Pragma("unroll") for (int _i = 0; _i < 2; ++_i) { int R_, C_; stage_rc(tid * 16 + _i * 8192, R_, C_); _Pragma("unroll") for (int _h = 0; _h < 2; ++_h) G_[_h][_i] = S.aoff((u_).ord, _h * HALF + R_) + (unsigned)C_ * 2u; } } } while (0)
    Unit cur, nxt;
    if (!S.next(0, cur)) return;
    f32x4 acc[2][2][4][2];
#pragma unroll
    for (int a = 0; a < 2; ++a)
#pragma unroll
        for (int b = 0; b < 2; ++b)
#pragma unroll
            for (int m = 0; m < 4; ++m)
#pragma unroll
                for (int n = 0; n < 2; ++n) acc[a][b][m][n] = (f32x4){0.f, 0.f, 0.f, 0.f};
    typedef int v4i_ __attribute__((ext_vector_type(4))); typedef int v8i_ __attribute__((ext_vector_type(8)));
    bf16x8 At[4][2], B0[2][2], B1[2][2];
    v8i_ At8[4], B08[2], B18[2];
    unsigned gC[2][2] = {{0u, 0u}, {0u, 0u}}, gN[2][2] = {{0u, 0u}, {0u, 0u}};
    u32x4 pw[8]; unsigned char* pdst = nullptr;
    if constexpr (Epi::DEFER) { pdst = E.addr0(wid);
#pragma unroll
        for (int j = 0; j < 8; ++j) pw[j] = (u32x4){0u, 0u, 0u, 0u}; }
    PG8_GLOAD(gC, cur);
    const GAS char* cA = uni_ptr(cur.a); const GAS char* cB = uni_ptr(cur.b);
    PG8_STAGE(PG8_SB(0, 0), cB, voffB); PG8_STAGE(PG8_SB(0, 1), cB + hstepB, voffB); PG8_STAGE_A(PG8_SA(0, 0), cA, 0, gC); PG8_STAGE_A(PG8_SA(0, 1), cA, 1, gC);
    if (wr == 1) PG8_BAR;
    PG8_WAIT_V(2); PG8_BAR;
    PG8_STAGE(PG8_SB(1, 0), cB + kstep, voffB); PG8_STAGE_A(PG8_SA(1, 0), cA + kstep, 0, gC); PG8_STAGE(PG8_SB(1, 1), cB + hstepB + kstep, voffB);
    PG8_WAIT_V(6); PG8_BAR;
    int ui = 0;
    for (;;) {
        const bool has_next = S.next(ui + 1, nxt);
        const GAS char* nA = has_next ? uni_ptr(nxt.a) : cA; const GAS char* nB = has_next ? uni_ptr(nxt.b) : cB;
        if constexpr (Sched::GATHER) { if (has_next) { PG8_GLOAD(gN, nxt); } else {
#pragma unroll
            for (int _h = 0; _h < 2; ++_h)
#pragma unroll
                for (int _i = 0; _i < 2; ++_i) gN[_h][_i] = gC[_h][_i]; } }
#pragma unroll 1
        for (int t = 0; t < nt; t += 2) {
            const bool last = (t == nt - 2);
            const GAS char* a1 = cA + (size_t)(t + 1) * kstep;
            const GAS char* a2 = last ? nA : cA + (size_t)(t + 2) * kstep; const GAS char* b2 = last ? nB : cB + (size_t)(t + 2) * kstep;
            const GAS char* a3 = a2 + kstep; const GAS char* b3 = b2 + kstep;
            if constexpr (Epi::HAS_MID) { if (t == nt / 2) E.mid(acc, cur, wr, fr); }
            const bool relax = Epi::NSTORE > 0 && t == 0 && ui > 0;
#define PG8_DEF(j0) do { if constexpr (Epi::DEFER) E.st2(pdst, pw, j0); } while (0)
#define PG8_WAIT_D(alt) do { if constexpr (Epi::DEFER) { if (ui > 0) asm volatile("s_waitcnt vmcnt(14)" ::: "memory"); else asm volatile("s_waitcnt vmcnt(8)" ::: "memory"); } else { alt; } } while (0)
            PG8_LDB(B0, 0, 0); PG8_LDB(B1, 0, 1); PG8_SCHED; PG8_LDA(At, 0, 0); if (!relax) PG8_STAGE_A(PG8_SA(1, 1), a1, 1, gC);
            PG8_DEF(0); PG8_WAIT_D(PG8_WAIT_VR(relax)); PG8_WAIT_L(0); PG8_BAR; PG8_MMA(0, 0, At, B0); PG8_MMA(0, 1, At, B1); PG8_BAR; PG8_SCHED;
            PG8_LDA(At, 0, 1); PG8_STAGE(PG8_SB(0, 0), b2, voffB); PG8_STAGE(PG8_SB(0, 1), b2 + hstepB, voffB); PG8_STAGE_A2(PG8_SA(0, 0), a2, 0);
            PG8_DEF(2); PG8_WAIT_D(PG8_WAIT_VR(relax)); PG8_WAIT_L(0); PG8_BAR; PG8_MMA(1, 0, At, B0); PG8_MMA(1, 1, At, B1); PG8_BAR; PG8_SCHED;
            PG8_LDB(B0, 1, 0); PG8_LDB(B1, 1, 1); PG8_SCHED; PG8_LDA(At, 1, 0); PG8_STAGE_A2(PG8_SA(0, 1), a2, 1);
            PG8_DEF(4); PG8_WAIT_D(PG8_WAIT_VR(relax)); PG8_WAIT_L(0); PG8_BAR; PG8_MMA(0, 0, At, B0); PG8_MMA(0, 1, At, B1); PG8_BAR; PG8_SCHED;
            PG8_LDA(At, 1, 1); PG8_STAGE(PG8_SB(1, 0), b3, voffB); PG8_STAGE(PG8_SB(1, 1), b3 + hstepB, voffB); PG8_STAGE_A2(PG8_SA(1, 0), a3, 0);
            PG8_DEF(6); PG8_WAIT_D(PG8_WAIT_V(8)); PG8_WAIT_L(0); PG8_BAR; PG8_MMA(1, 0, At, B0); PG8_MMA(1, 1, At, B1); PG8_BAR; PG8_SCHED;
#undef PG8_DEF
#undef PG8_WAIT_D
        }
        if constexpr (Epi::NSTORE > 0) { if (has_next) PG8_STAGE_A(PG8_SA(1, 1), nA + kstep, 1, gN); }
        if constexpr (ALIGN_EPI) { if (wr == 0) PG8_BAR; }
        if constexpr (Epi::DEFER) { E.pack(acc, pw); pdst = E.addr(cur, wr, wc);
            if (!has_next) { E.st2(pdst, pw, 0); E.st2(pdst, pw, 2); E.st2(pdst, pw, 4); E.st2(pdst, pw, 6); } }
        else E(acc, cur, wr, wc, fr, fq);
        if (!has_next) break;
#pragma unroll
        for (int a = 0; a < 2; ++a)
#pragma unroll
            for (int b = 0; b < 2; ++b)
#pragma unroll
                for (int m = 0; m < 4; ++m)
#pragma unroll
                    for (int n = 0; n < 2; ++n) acc[a][b][m][n] = (f32x4){0.f, 0.f, 0.f, 0.f};
        cur = nxt; cA = nA; cB = nB; ++ui;
#pragma unroll
        for (int _h = 0; _h < 2; ++_h)
#pragma unroll
            for (int _i = 0; _i < 2; ++_i) gC[_h][_i] = gN[_h][_i];
        if constexpr (ALIGN_EPI) { if (wr == 1) PG8_BAR; }
    }
    PG8_WAIT_V(0);
    if constexpr (!ALIGN_EPI) { if (wr == 0) PG8_BAR; }
    PG8_BAR;
#undef PG8_SA
#undef PG8_SB
#undef PG8_STAGE
#undef PG8_STAGE_A
#undef PG8_STAGE_A2
#undef PG8_LDA
#undef PG8_FR
#undef PG8_LDB
#undef PG8_MMA
#undef PG8_WAIT_V
#undef PG8_WAIT_L
#undef PG8_WAIT_VR
#undef PG8_BAR
#undef PG8_SCHED
#undef PG8_GLOAD
}

struct EpiBf16 {
    static constexpr bool PERM = true, HAS_MID = false; static constexpr int NSTORE = 16;
    static constexpr bool DEFER = false;
    static constexpr int MXSCALE = 0x7f7f7f7f;
    bf16* O; int ldc;
    __device__ __forceinline__ void operator()(const f32x4 (&acc)[2][2][4][2], const Unit& u, int wr, int wc, int fr, int fq) const {
#if defined(PROBE_PK)
        if ((u.ord & 1) == 0) return;
#endif
        const int row0 = u.pm * BM + wr * 64 + fr, col0 = u.pn * BM + wc * 32 + 8 * fq;
#pragma unroll
        for (int ai = 0; ai < 2; ++ai)
#pragma unroll
            for (int m = 0; m < 4; ++m) { bf16* rowp = O + (size_t)(row0 + ai * HALF + m * 16) * ldc + col0;
#pragma unroll
                for (int bj = 0; bj < 2; ++bj) { const f32x4 v0 = acc[ai][bj][m][0], v1 = acc[ai][bj][m][1];
                    u32x4 w; w.x = cvt_pk_bf16(v0[0], v0[1]); w.y = cvt_pk_bf16(v0[2], v0[3]); w.z = cvt_pk_bf16(v1[0], v1[1]); w.w = cvt_pk_bf16(v1[2], v1[3]);
                    *(u32x4*)(rowp + bj * HALF) = w; } }
    }
};
struct EpiBf16T {
    static constexpr bool PERM = true, HAS_MID = false; static constexpr int NSTORE = 16;
    static constexpr bool DEFER = false;
    static constexpr int MXSCALE = 0x7f7f7f7f;
    bf16* O; int ntn;
    __device__ __forceinline__ void operator()(const f32x4 (&acc)[2][2][4][2], const Unit& u, int wr, int wc, int fr, int fq) const {
        if (u.pn >= 2 && u.pn < 6) {
            bf16* tile = O + ((size_t)u.pm * ntn + 2 + ((u.pn - 2) >> 1)) * 65536 + (wr * 64 + fr) * 256 + ((u.pn - 2) & 1) * HALF + wc * 16 + 4 * fq;
#pragma unroll
            for (int ai = 0; ai < 2; ++ai)
#pragma unroll
                for (int m = 0; m < 4; ++m) { bf16* rowp = tile + (ai * HALF + m * 16) * 256;
#pragma unroll
                    for (int bj = 0; bj < 2; ++bj) { const f32x4 v0 = acc[ai][bj][m][0], v1 = acc[ai][bj][m][1];
                        u32x2 w; w.x = cvt_pk_bf16(v0[0] * v0[1], v0[2] * v0[3]); w.y = cvt_pk_bf16(v1[0] * v1[1], v1[2] * v1[3]);
                        *(u32x2*)(rowp + bj * 64) = w; } }
            return; }
        bf16* tile = O + ((size_t)u.pm * ntn + (u.pn < 2 ? u.pn : u.pn - 2)) * 65536 + (wr * 64 + fr) * 256 + wc * 32 + 8 * fq;
#pragma unroll
        for (int ai = 0; ai < 2; ++ai)
#pragma unroll
            for (int m = 0; m < 4; ++m) { bf16* rowp = tile + (ai * HALF + m * 16) * 256;
#pragma unroll
                for (int bj = 0; bj < 2; ++bj) { const f32x4 v0 = acc[ai][bj][m][0], v1 = acc[ai][bj][m][1];
                    u32x4 w; w.x = cvt_pk_bf16(v0[0], v0[1]); w.y = cvt_pk_bf16(v0[2], v0[3]); w.z = cvt_pk_bf16(v1[0], v1[1]); w.w = cvt_pk_bf16(v1[2], v1[3]);
                    *(u32x4*)(rowp + bj * HALF) = w; } }
    }
};
struct EpiGU {
    static constexpr bool PERM = true, HAS_MID = false; static constexpr int NSTORE = 8;
    static constexpr bool DEFER = false;
    static constexpr int MXSCALE = 0x7f7f7f7f;
    unsigned char* H;
    __device__ __forceinline__ void operator()(const f32x4 (&acc)[2][2][4][2], const Unit& u, int wr, int wc, int fr, int fq) const {
#if defined(PROBE_GK)
        if ((u.ord & 1) == 0) return;
#endif
        const int row0 = u.pm * BM + wr * 64 + fr, col0 = u.pn * HALF + wc * 32 + 8 * fq;
#pragma unroll
        for (int ai = 0; ai < 2; ++ai)
#pragma unroll
            for (int m = 0; m < 4; ++m) { unsigned char* rowp = H + (size_t)(row0 + ai * HALF + m * 16) * 256 + col0;
                float h[8];
#pragma unroll
                for (int n = 0; n < 2; ++n)
#pragma unroll
                    for (int i = 0; i < 4; i += 2) {
                        const f32x2 g = (f32x2){acc[ai][0][m][n][i], acc[ai][0][m][n][i + 1]}, u = (f32x2){acc[ai][1][m][n][i], acc[ai][1][m][n][i + 1]};
                        const f32x2 t = g * (-1.4426950408889634f / 64.0f); const f32x2 e = (f32x2){__builtin_amdgcn_exp2f(t.x), __builtin_amdgcn_exp2f(t.y)};
                        const f32x2 d = e * 1024.0f + 1024.0f;
                        const f32x2 r = (f32x2){__builtin_amdgcn_rcpf(d.x), __builtin_amdgcn_rcpf(d.y)}; const f32x2 hh = (g * u) * r;
                        h[4 * n + i] = hh.x; h[4 * n + i + 1] = hh.y; }
                int lo = __builtin_amdgcn_cvt_pk_fp8_f32(h[0], h[1], 0, false); lo = __builtin_amdgcn_cvt_pk_fp8_f32(h[2], h[3], lo, true);
                int hi = __builtin_amdgcn_cvt_pk_fp8_f32(h[4], h[5], 0, false); hi = __builtin_amdgcn_cvt_pk_fp8_f32(h[6], h[7], hi, true);
                *(u32x2*)rowp = (u32x2){(unsigned)lo, (unsigned)hi}; }
    }
};
struct EpiFp8 {
    static constexpr int PERM = 2; static constexpr bool HAS_MID = false; static constexpr int NSTORE = 8;
    static constexpr bool DEFER = true;
    static constexpr int MXSCALE = 0x7b7b7b7b;
    unsigned char* O; int ldc; float sc; unsigned char* dump;
    __device__ __forceinline__ void pack(const f32x4 (&acc)[2][2][4][2], u32x4 (&pw)[8]) const {
#pragma unroll
        for (int ai = 0; ai < 2; ++ai)
#pragma unroll
            for (int m = 0; m < 4; ++m) { u32x4 w;
#pragma unroll
                for (int bj = 0; bj < 2; ++bj) { const f32x4 v0 = acc[ai][bj][m][0], v1 = acc[ai][bj][m][1];
                    int lo = __builtin_amdgcn_cvt_pk_fp8_f32(v0[0], v0[1], 0, false); lo = __builtin_amdgcn_cvt_pk_fp8_f32(v0[2], v0[3], lo, true);
                    int hi = __builtin_amdgcn_cvt_pk_fp8_f32(v1[0], v1[1], 0, false); hi = __builtin_amdgcn_cvt_pk_fp8_f32(v1[2], v1[3], hi, true);
                    if (bj == 0) { w.x = (unsigned)lo; w.y = (unsigned)hi; } else { w.z = (unsigned)lo; w.w = (unsigned)hi; } }
                pw[ai * 4 + m] = w; }
    }
    __device__ __forceinline__ unsigned char* addr(const Unit& u, int wr, int wc) const { const int l_ = lane_id_asm(), fr = l_ & 15, fq = l_ >> 4;
        return O + (size_t)(u.pm * BM + wr * 64 + fr) * ldc + u.pn * BM + wc * 64 + 16 * fq; }
    __device__ __forceinline__ unsigned char* addr0(int wid) const { return dump + (size_t)(wid * 64 + lane_id_asm()) * 16; }
    __device__ __forceinline__ void st2(unsigned char* p, const u32x4 (&pw)[8], int j0) const {
#pragma unroll
        for (int j = j0; j < j0 + 2; ++j) *(u32x4*)(p + (size_t)((j >> 2) * HALF + (j & 3) * 16) * ldc) = pw[j]; }
    __device__ __forceinline__ void operator()(const f32x4 (&acc)[2][2][4][2], const Unit& u, int wr, int wc, int fr, int fq) const {
        const int row0 = u.pm * BM + wr * 64 + fr, col0 = u.pn * BM + wc * 64 + 16 * fq;
#pragma unroll
        for (int ai = 0; ai < 2; ++ai)
#pragma unroll
            for (int m = 0; m < 4; ++m) { u32x4 w;
#pragma unroll
                for (int bj = 0; bj < 2; ++bj) { const f32x4 v0 = acc[ai][bj][m][0], v1 = acc[ai][bj][m][1];
                    int lo = __builtin_amdgcn_cvt_pk_fp8_f32(v0[0], v0[1], 0, false); lo = __builtin_amdgcn_cvt_pk_fp8_f32(v0[2], v0[3], lo, true);
                    int hi = __builtin_amdgcn_cvt_pk_fp8_f32(v1[0], v1[1], 0, false); hi = __builtin_amdgcn_cvt_pk_fp8_f32(v1[2], v1[3], hi, true);
                    if (bj == 0) { w.x = (unsigned)lo; w.y = (unsigned)hi; } else { w.z = (unsigned)lo; w.w = (unsigned)hi; } }
                *(u32x4*)(O + (size_t)(row0 + ai * HALF + m * 16) * ldc + col0) = w; }
    }
};
struct EpiX1 {
    static constexpr bool PERM = true, HAS_MID = true; static constexpr int NSTORE = 0;
    static constexpr bool DEFER = false;
    static constexpr int MXSCALE = 0x7f7f7f7f;
    const float* x; bf16* o; const float* g1; const LAS float* rstab;
    __device__ __forceinline__ void mid(f32x4 (&acc)[2][2][4][2], const Unit& u, int wr, int fr) const {
#pragma unroll
        for (int ai = 0; ai < 2; ++ai)
#pragma unroll
            for (int m = 0; m < 4; ++m) { const float rs = rstab[u.ord * 256 + ai * HALF + wr * 64 + m * 16 + fr];
#pragma unroll
                for (int bj = 0; bj < 2; ++bj)
#pragma unroll
                    for (int n = 0; n < 2; ++n) acc[ai][bj][m][n] = acc[ai][bj][m][n] * rs; }
    }
    __device__ __forceinline__ void operator()(const f32x4 (&acc)[2][2][4][2], const Unit& u, int wr, int wc, int fr, int fq) const {
        const int row0 = u.pm * BM + wr * 64 + fr, col0 = u.pn * BM + wc * 32 + 8 * fq; const int b = (u.pm * BM) / SEQ;
        f32x4 gv[2][2];
#pragma unroll
        for (int bj = 0; bj < 2; ++bj)
#pragma unroll
            for (int n = 0; n < 2; ++n) gv[bj][n] = *(const f32x4*)(g1 + (size_t)b * 6144 + col0 + bj * HALF + 4 * n);
#pragma unroll
        for (int ai = 0; ai < 2; ++ai) {
            f32x4 xv[4][2][2];
#pragma unroll
            for (int m = 0; m < 4; ++m)
#pragma unroll
                for (int bj = 0; bj < 2; ++bj)
#pragma unroll
                    for (int n = 0; n < 2; ++n) xv[m][bj][n] = *(const f32x4*)(x + (size_t)(row0 + ai * HALF + m * 16) * D + col0 + bj * HALF + 4 * n);
#pragma unroll
            for (int m = 0; m < 4; ++m)
#pragma unroll
                for (int bj = 0; bj < 2; ++bj) { const f32x4 v0 = xv[m][bj][0] + gv[bj][0] * acc[ai][bj][m][0], v1 = xv[m][bj][1] + gv[bj][1] * acc[ai][bj][m][1];
                    u32x4 w; w.x = cvt_pk_bf16(v0[0], v0[1]); w.y = cvt_pk_bf16(v0[2], v0[3]); w.z = cvt_pk_bf16(v1[0], v1[1]); w.w = cvt_pk_bf16(v1[2], v1[3]);
                    *(u32x4*)(o + (size_t)(row0 + ai * HALF + m * 16) * D + col0 + bj * HALF) = w; }
            asm volatile("" ::: "memory"); }
    }
};
struct EpiLogits {
    static constexpr bool PERM = false, HAS_MID = false; static constexpr int NSTORE = 0;
    static constexpr bool DEFER = false;
    static constexpr int MXSCALE = 0x7f7f7f7f;
    float* L;
    __device__ __forceinline__ void operator()(const f32x4 (&acc)[2][2][4][2], const Unit& u, int wr, int wc, int fr, int fq) const {
        if (wc < 2 && u.pn == 0) {
            const int row0 = u.pm * BM + wr * 64 + fr, col0 = wc * 32 + 4 * fq;
#pragma unroll
            for (int ai = 0; ai < 2; ++ai)
#pragma unroll
                for (int m = 0; m < 4; ++m)
#pragma unroll
                    for (int n = 0; n < 2; ++n) *(f32x4*)(L + (size_t)(row0 + ai * HALF + m * 16) * 64 + col0 + n * 16) = acc[ai][0][m][n];
        }
    }
};
}

struct Args { const float* in[24]; float* out; unsigned char* ws; int ph_lo, ph_hi; };
typedef const Args __attribute__((address_space(4))) CArgs;
#define ARGS_LAUNDER(src_) CArgs* ap_ = &(src_); asm volatile("" : "+s"(ap_)); CArgs& args = *ap_
struct Frame {
    LAS unsigned char* lds; volatile LAS unsigned* MISC; unsigned* ctl;
    int tid, lane, wave, vcu, G;
};

struct TrIt { const float* src; unsigned char* dst; const float* ks; int ldw, ldk, useks, f8; };
__device__ __forceinline__ void tr_load(const TrIt& t, f32x4 (&tv)[8], float (&tk)[8], int lane) {
#pragma unroll
    for (int i = 0; i < 8; ++i) { const int kk = 8 * i + (lane >> 3), n4 = 4 * (lane & 7); tv[i] = *(const f32x4*)(t.src + (size_t)kk * t.ldw + n4); tk[i] = t.ks[kk]; }
}
__device__ __forceinline__ void tr_store(const TrIt& t, const f32x4 (&tv)[8], const float (&tk)[8], LAS float* scr, int lane) {
#pragma unroll
    for (int i = 0; i < 8; ++i) { const int kk = 8 * i + (lane >> 3), n4 = 4 * (lane & 7); const f32x4 v = tv[i] * (t.useks ? tk[i] : 1.0f);
        LAS float* d = scr + kk * 33 + n4; d[0] = v.x; d[1] = v.y; d[2] = v.z; d[3] = v.w; }
    LDS_WAIT(); asm volatile("" ::: "memory");
    const int c = lane & 7;
#pragma unroll
    for (int j = 0; j < 4; ++j) { const int n = (lane >> 3) + 8 * j; const LAS float* s = scr + (8 * c) * 33 + n;
        if (t.f8) {
            int lo = __builtin_amdgcn_cvt_pk_fp8_f32(s[0 * 33] * 64.f, s[1 * 33] * 64.f, 0, false); lo = __builtin_amdgcn_cvt_pk_fp8_f32(s[2 * 33] * 64.f, s[3 * 33] * 64.f, lo, true);
            int hi = __builtin_amdgcn_cvt_pk_fp8_f32(s[4 * 33] * 64.f, s[5 * 33] * 64.f, 0, false); hi = __builtin_amdgcn_cvt_pk_fp8_f32(s[6 * 33] * 64.f, s[7 * 33] * 64.f, hi, true);
            *(u32x2*)(t.dst + (size_t)n * t.ldk + 8 * c) = (u32x2){(unsigned)lo, (unsigned)hi};
        } else {
            u32x4 o; o.x = cvt_pk_bf16(s[0 * 33], s[1 * 33]); o.y = cvt_pk_bf16(s[2 * 33], s[3 * 33]); o.z = cvt_pk_bf16(s[4 * 33], s[5 * 33]); o.w = cvt_pk_bf16(s[6 * 33], s[7 * 33]);
            *(u32x4*)(t.dst + ((size_t)n * t.ldk + 8 * c) * 2) = o; } }
    LDS_WAIT(); asm volatile("" ::: "memory");
}
__device__ __forceinline__ void p0_prologue(const Frame& F_, CArgs& args_) {
    Frame F = F_; F.lane = lane_id_asm(); F.tid = F.wave * 64 + F.lane;
    ARGS_LAUNDER(args_);
    const int gw = F.vcu * 8 + F.wave, NGW = F.G * 8, lane = F.lane;
    for (int cg = F.vcu; cg < 96; cg += F.G) {
        const int j = cg * 64 + lane, k0 = F.wave * 128;
        float acc[16];
#pragma unroll
        for (int b = 0; b < 16; ++b) acc[b] = 0.f;
#pragma unroll 8
        for (int kk = 0; kk < 128; ++kk) { const float w = (args.in[2])[(size_t)(k0 + kk) * 6144 + j];
#pragma unroll
            for (int b = 0; b < 16; ++b) acc[b] += (args.in[1])[b * 1024 + k0 + kk] * w; }
        LAS float* part = (LAS float*)F.lds;
#pragma unroll
        for (int b = 0; b < 16; ++b) part[(F.wave * 16 + b) * 64 + lane] = acc[b];
        WG_BAR();
        for (int o = F.tid; o < 1024; o += 512) { const int b = o >> 6, jj = o & 63; float s = (args.in[3])[cg * 64 + jj];
#pragma unroll
            for (int w = 0; w < 8; ++w) s += part[(w * 16 + b) * 64 + jj];
            ((float*)(args.ws + WS_MOD))[b * 6144 + cg * 64 + jj] = s; }
        WG_BAR();
    }
    LAS float* scr = (LAS float*)(F.lds + F.wave * 16384);
    constexpr int I_IN = 16 * 96, I_OUT = 16 * 32, I_E = NEX * 128;
    constexpr int NITEMS = I_IN + I_OUT + 3 * I_E;
    auto decode = [&](int it) -> TrIt { TrIt t; t.useks = 0; t.ks = (args.in[12]); t.f8 = 0; int r = it;
        if (r < I_IN) { const int kb = r / 96, nb = r % 96; t.src = (args.in[5]) + (size_t)(kb * 64) * LDWIN + nb * 32; t.ldw = LDWIN; { const int n0 = nb * 32; int drow = n0, dstr = 1;
              if (n0 >= 512 && n0 < 1024) { drow = 512 + 2 * (n0 - 512); dstr = 2; } else if (n0 >= 1024 && n0 < 1536) { drow = 513 + 2 * (n0 - 1024); dstr = 2; }
              t.dst = (unsigned char*)(((bf16*)(args.ws + WS_WIN)) + (size_t)drow * 1024 + kb * 64); t.ldk = 1024 * dstr; } return t; } r -= I_IN;
        if (r < I_OUT) { const int kb = r / 32, nb = r % 32, k0 = kb * 64; const int dc = k0 < 512 ? k0 + 512 : k0 - 512;
            t.src = (args.in[13]) + (size_t)k0 * 1024 + nb * 32; t.ldw = 1024; t.dst = (unsigned char*)(((bf16*)(args.ws + WS_WOUT)) + (size_t)(nb * 32) * 1024 + dc); t.ldk = 1024; if (k0 >= 512) { t.useks = 1; t.ks = (args.in[12]) + (k0 - 512); } return t; } r -= I_OUT;
        t.f8 = 1;
        if (r < 2 * I_E) { const int up = r >= I_E; if (up) r -= I_E; const int e = r / 128, q = r % 128, kb = q / 8, nb = q % 8, n0 = nb * 32;
            const float* W = up ? (e < NE ? (args.in[18]) + (size_t)e * 262144 : (args.in[21])) : (e < NE ? (args.in[17]) + (size_t)e * 262144 : (args.in[20]));
            const int drow = (n0 / 128) * 256 + up * 128 + (n0 % 128);
            t.src = W + (size_t)(kb * 64) * 256 + n0; t.ldw = 256; t.dst = (unsigned char*)(args.ws + WS_WGU) + ((size_t)e * 512 + drow) * 1024 + kb * 64; t.ldk = 1024; return t; } r -= 2 * I_E;
        { const int e = r / 128, q = r % 128, kb = q / 32, nb = q % 32; const float* W = e < NE ? (args.in[19]) + (size_t)e * 262144 : (args.in[22]);
            t.src = W + (size_t)(kb * 64) * 1024 + nb * 32; t.ldw = 1024; t.dst = (unsigned char*)(args.ws + WS_WD) + ((size_t)e * 1024 + nb * 32) * 256 + kb * 64; t.ldk = 256; return t; } };
    if (gw < NITEMS) {
        TrIt nxt = decode(gw); f32x4 nv[8]; float nk[8];
        tr_load(nxt, nv, nk, lane);
#pragma unroll 1
        for (int it = gw; it < NITEMS; it += NGW) {
            const TrIt cur = nxt; f32x4 cv[8]; float ck[8];
#pragma unroll
            for (int i = 0; i < 8; ++i) { cv[i] = nv[i]; ck[i] = nk[i]; }
            nxt = decode(it + NGW < NITEMS ? it + NGW : it);
            tr_load(nxt, nv, nk, lane);
            tr_store(cur, cv, ck, scr, lane);
        }
    }
    for (int e = blockIdx.x * 512 + F.tid; e < 4096; e += F.G * 512) { const int p = e >> 3, hh = e & 7;
        ((unsigned*)(args.ws + WS_WDT))[e] = cvt_pk_bf16((args.in[5])[(size_t)(2 * p) * LDWIN + NPROJ + hh], (args.in[5])[(size_t)(2 * p + 1) * LDWIN + NPROJ + hh]); }
}

template <bool WITH_DT, bool XBF>
__device__ __forceinline__ void p_norm_mod(const Frame& F_, CArgs& args_, const void* xin_, const float* gain, int shift_off, int scale_off, bf16* hout, unsigned char* h8out) {
    Frame F = F_; F.lane = lane_id_asm(); F.tid = F.wave * 64 + F.lane;
    ARGS_LAUNDER(args_);
    const int gw = F.vcu * 8 + F.wave, NGW = F.G * 8, lane = F.lane;
    for (int blk = gw; blk < T / 32; blk += NGW) {
        const int row0 = blk * 32, b = row0 / SEQ;
        f32x4 sc[4], sh[4];
#pragma unroll
        for (int j = 0; j < 4; ++j) { const int col = 4 * lane + 256 * j; const f32x4 g = *(const f32x4*)(gain + col); const f32x4 s1 = *(const f32x4*)(((float*)(args.ws + WS_MOD)) + b * 6144 + scale_off + col);
            sc[j] = g * (s1 + 1.0f); sh[j] = *(const f32x4*)(((float*)(args.ws + WS_MOD)) + b * 6144 + shift_off + col); }
        unsigned wdt[WITH_DT ? 4 : 1][2][WITH_DT ? 8 : 1];
        if constexpr (WITH_DT) {
#pragma unroll
            for (int j = 0; j < 4; ++j)
#pragma unroll
                for (int pr = 0; pr < 2; ++pr) { const u32x4* wp = (const u32x4*)(args.ws + WS_WDT) + (size_t)(2 * lane + 128 * j + pr) * 2; const u32x4 a = wp[0], c = wp[1];
                    wdt[j][pr][0] = a.x; wdt[j][pr][1] = a.y; wdt[j][pr][2] = a.z; wdt[j][pr][3] = a.w; wdt[j][pr][4] = c.x; wdt[j][pr][5] = c.y; wdt[j][pr][6] = c.z; wdt[j][pr][7] = c.w; }
        }
        float dtb = 0.f; if constexpr (WITH_DT) dtb = (args.in[9])[lane & 7];
        f32x4 nx[2][4];
#pragma unroll
        for (int p = 0; p < 2; ++p)
#pragma unroll
            for (int j = 0; j < 4; ++j) {
                if constexpr (XBF) { const u32x2 w = ((const u32x2*)((const bf16*)xin_ + (size_t)(row0 + p) * D) + lane)[64 * j]; nx[p][j] = (f32x4){bflo(w.x), bfhi(w.x), bflo(w.y), bfhi(w.y)}; }
                else nx[p][j] = ((const f32x4*)((const float*)xin_ + (size_t)(row0 + p) * D) + lane)[64 * j]; }
#pragma unroll 2
        for (int r = 0; r < 32; ++r) {
            const int row = row0 + r;
            f32x4 v[4]; float s = 0.f;
#pragma unroll
            for (int j = 0; j < 4; ++j) v[j] = nx[r & 1][j];
            { const int rn = row0 + (r + 2 < 32 ? r + 2 : 31);
#pragma unroll
                for (int j = 0; j < 4; ++j) {
                    if constexpr (XBF) { const u32x2 w = ((const u32x2*)((const bf16*)xin_ + (size_t)rn * D) + lane)[64 * j]; nx[r & 1][j] = (f32x4){bflo(w.x), bfhi(w.x), bflo(w.y), bfhi(w.y)}; }
                    else nx[r & 1][j] = ((const f32x4*)((const float*)xin_ + (size_t)rn * D) + lane)[64 * j]; } }
#pragma unroll
            for (int j = 0; j < 4; ++j) s += (v[j].x * v[j].x + v[j].y * v[j].y) + (v[j].z * v[j].z + v[j].w * v[j].w);
            const float rstd = rsqrtf(wave_sum(s) * (1.0f / D) + EPS);
            u32x2* o8 = (u32x2*)(hout + (size_t)row * D) + lane;
            float dv[8] = {0.f, 0.f, 0.f, 0.f, 0.f, 0.f, 0.f, 0.f};
#pragma unroll
            for (int j = 0; j < 4; ++j) { const f32x4 h = v[j] * rstd * sc[j] + sh[j];
                if constexpr (!WITH_DT) { int q8 = __builtin_amdgcn_cvt_pk_fp8_f32(h.x, h.y, 0, false); q8 = __builtin_amdgcn_cvt_pk_fp8_f32(h.z, h.w, q8, true); ((unsigned*)(h8out + (size_t)row * D))[lane + 64 * j] = (unsigned)q8; }
                const unsigned wx = cvt_pk_bf16(h.x, h.y), wy = cvt_pk_bf16(h.z, h.w); if (WITH_DT) o8[64 * j] = (u32x2){wx, wy};
                if constexpr (WITH_DT) {
                    typedef __bf16 bf2 __attribute__((ext_vector_type(2)));
#pragma unroll
                    for (int hh = 0; hh < 8; ++hh) { dv[hh] = __builtin_amdgcn_fdot2_f32_bf16(__builtin_bit_cast(bf2, wx), __builtin_bit_cast(bf2, wdt[j][0][hh]), dv[hh], false);
                        dv[hh] = __builtin_amdgcn_fdot2_f32_bf16(__builtin_bit_cast(bf2, wy), __builtin_bit_cast(bf2, wdt[j][1][hh]), dv[hh], false); } } }
            if constexpr (WITH_DT) {
#pragma unroll
                for (int hh = 0; hh < 8; ++hh) dv[hh] = wave_sum(dv[hh]);
                float mine = dv[0];
#pragma unroll
                for (int hh = 1; hh < 8; ++hh) mine = (lane == hh) ? dv[hh] : mine;
                if (lane < 8) { const float a = mine + dtb; ((float*)(args.ws + WS_DT))[(size_t)row * 8 + lane] = a > 20.f ? a : log1pf(__expf(a)); }
            }
        }
    }
}

__device__ __forceinline__ void p3_conv(const Frame& F_, CArgs& args_) {
    Frame F = F_; F.lane = lane_id_asm(); F.tid = F.wave * 64 + F.lane;
    ARGS_LAUNDER(args_);
    const int q = F.tid & 63, seg = F.tid >> 6;
    for (int tile = F.vcu; tile < T / 256; tile += F.G) {
        const int r0 = tile * 256 + seg * 32; const bool head = (r0 % SEQ) == 0;
        {
            float w0[8], w1[8], w2[8], pm2[8], pm1[8];
#pragma unroll
            for (int i = 0; i < 8; ++i) { w0[i] = (args.in[6])[0 * 512 + 8 * q + i]; w1[i] = (args.in[6])[1 * 512 + 8 * q + i]; w2[i] = (args.in[6])[2 * 512 + 8 * q + i]; pm2[i] = 0.f; pm1[i] = 0.f; }
            if (!head) {
                unpack8(*(const u32x4*)(((bf16*)(args.ws + WS_A)) + pj((size_t)(r0 - 2), C_P + 8 * q)), pm2);
                unpack8(*(const u32x4*)(((bf16*)(args.ws + WS_A)) + pj((size_t)(r0 - 1), C_P + 8 * q)), pm1);
            }
            const bf16* pj0 = ((bf16*)(args.ws + WS_A));
            constexpr int YB = 4; u32x4 nb[YB][2];
#pragma unroll
            for (int j = 0; j < YB; ++j) { nb[j][0] = *(const u32x4*)(pj0 + pj((size_t)(r0 + j), C_CB + 8 * q)); nb[j][1] = *(const u32x4*)(pj0 + pj((size_t)(r0 + j), C_P + 8 * q)); }
#pragma unroll 1
            for (int r = 0; r < 32; r += YB) {
                u32x4 cur[YB][2];
#pragma unroll
                for (int j = 0; j < YB; ++j) { cur[j][0] = nb[j][0]; cur[j][1] = nb[j][1]; }
                {
#pragma unroll
                    for (int j = 0; j < YB; ++j) { const size_t rn = (size_t)(r0 + (r + YB + j < 32 ? r + YB + j : 31));
                        nb[j][0] = *(const u32x4*)(pj0 + pj(rn, C_CB + 8 * q)); nb[j][1] = *(const u32x4*)(pj0 + pj(rn, C_P + 8 * q)); } }
#pragma unroll
                for (int j = 0; j < YB; ++j) {
                    float cb[8], pp[8], y[8];
                    unpack8(cur[j][0], cb); unpack8(cur[j][1], pp);
#pragma unroll
                    for (int i = 0; i < 8; ++i) { const float p = pp[i]; y[i] = cb[i] * (w0[i] * pm2[i] + w1[i] * pm1[i] + w2[i] * p); pm2[i] = pm1[i]; pm1[i] = p; }
                    *(u32x4*)(((bf16*)(args.ws + WS_HB)) + (size_t)(r0 + r + j) * D + 512 + 8 * q) = pack8(y);
                }
            }
        }
#pragma unroll 1
        for (int jj = 0; jj < 2; ++jj) {
            const int ch0 = 8 * (q + 64 * jj);
            float w0[8], w1[8], w2[8], w3[8], bs[8], u3[8], u2[8], u1[8];
#pragma unroll
            for (int i = 0; i < 8; ++i) { w0[i] = (args.in[7])[0 * 1024 + ch0 + i]; w1[i] = (args.in[7])[1 * 1024 + ch0 + i]; w2[i] = (args.in[7])[2 * 1024 + ch0 + i]; w3[i] = (args.in[7])[3 * 1024 + ch0 + i];
                bs[i] = (args.in[8])[ch0 + i]; u3[i] = 0.f; u2[i] = 0.f; u1[i] = 0.f; }
            if (!head) { unpack8(*(const u32x4*)(((bf16*)(args.ws + WS_A)) + pj((size_t)(r0 - 3), C_XBC + ch0)), u3); unpack8(*(const u32x4*)(((bf16*)(args.ws + WS_A)) + pj((size_t)(r0 - 2), C_XBC + ch0)), u2);
                unpack8(*(const u32x4*)(((bf16*)(args.ws + WS_A)) + pj((size_t)(r0 - 1), C_XBC + ch0)), u1); }
            const bf16* pjx = ((bf16*)(args.ws + WS_A));
            constexpr int XB = 8; u32x4 nb[XB];
#pragma unroll
            for (int j = 0; j < XB; ++j) nb[j] = *(const u32x4*)(pjx + pj((size_t)(r0 + j), C_XBC + ch0));
#pragma unroll 1
            for (int r = 0; r < 32; r += XB) {
                u32x4 cur[XB];
#pragma unroll
                for (int j = 0; j < XB; ++j) cur[j] = nb[j];
#pragma unroll
                for (int j = 0; j < XB; ++j) nb[j] = *(const u32x4*)(pjx + pj((size_t)(r0 + (r + XB + j < 32 ? r + XB + j : 31)), C_XBC + ch0));
#pragma unroll
                for (int j = 0; j < XB; ++j) {
                    float u[8], y[8]; unpack8(cur[j], u);
#pragma unroll
                    for (int i = 0; i < 8; ++i) { y[i] = silu_f(bs[i] + w0[i] * u3[i] + w1[i] * u2[i] + w2[i] * u1[i] + w3[i] * u[i]); u3[i] = u2[i]; u2[i] = u1[i]; u1[i] = u[i]; }
                    *(u32x4*)(((bf16*)(args.ws + WS_XC)) + (size_t)(r0 + r + j) * D + ch0) = pack8(y);
                }
            }
        }
    }
}

constexpr int SD_SET = 55296, SD_BM = 0, SD_CM = 17408, SD_DX = 34816, SD_DXD = 39936, SD_XS = 45056, SD_ZR = 50176, SD_WM = 2 * SD_SET, SD_SB = SD_WM + 2 * 9216, SD_ACS = SD_SB + 8704, SD_DTS = SD_ACS + 768, SD_END = SD_DTS + 768;
static_assert(SD_END <= MISC_OFF, "SSD LDS map");
typedef short s16x4 __attribute__((ext_vector_type(4)));
__device__ __forceinline__ bf16x8 lds_tr8(const LAS unsigned char* p, int stride4) {
    const s16x4 a = __builtin_bit_cast(s16x4, __builtin_amdgcn_ds_read_tr16_b64_v4i16((LAS s16x4*)p));
    const s16x4 b = __builtin_bit_cast(s16x4, __builtin_amdgcn_ds_read_tr16_b64_v4i16((LAS s16x4*)(p + stride4)));
    return __builtin_shufflevector(a, b, 0, 1, 2, 3, 4, 5, 6, 7);
}
#define DPP_SHR_ADD(v, n) do { const int t_ = __builtin_amdgcn_update_dpp(0, __float_as_int(v), 0x110 + (n), 0xf, 0xf, true); (v) += __int_as_float(t_); } while (0)
__device__ __forceinline__ void p4_ssd(const Frame& F_, CArgs& args_) {
    Frame F = F_; F.lane = lane_id_asm(); F.tid = F.wave * 64 + F.lane;
    ARGS_LAUNDER(args_);
    LAS unsigned char* lds = F.lds; const int tid = F.tid, lane = F.lane, wave = F.wave, fr = lane & 15, fq = lane >> 4;
    const int tq = fr >> 2, tp = fr & 3;
    for (int uid = F.vcu; uid < 256; uid += F.G) {
        const int b = uid >> 4, h = (uid >> 1) & 7, ph = uid & 1, g = h >> 2;
        const float Ah = -__expf((args.in[10])[h]), Dh = (args.in[11])[h];
        const int xs_col = h * 64 + ph * 32, b_col = 512 + g * 128, c_col = 768 + g * 128, z_col = C_Z + h * 64 + ph * 32;
        f32x4 Sacc[2] = {(f32x4){0.f, 0.f, 0.f, 0.f}, (f32x4){0.f, 0.f, 0.f, 0.f}};
        for (int i = tid; i < 32 * 136 / 2; i += 512) ((LAS unsigned*)(lds + SD_SB))[i] = 0u;
        u32x4 pb[2][2], pc[2][2], px[2], pz[2]; float pdt[2] = {0.f, 0.f};
#pragma unroll
        for (int X = 0; X < 2; ++X) { px[X] = (u32x4){0u, 0u, 0u, 0u}; pz[X] = (u32x4){0u, 0u, 0u, 0u}; }
        const size_t trow0 = (size_t)b * SEQ;
        const bf16* XCp = ((const bf16*)(args.ws + WS_XC)); const bf16* PJ = ((const bf16*)(args.ws + WS_A)); const float* DTp = ((const float*)(args.ws + WS_DT));
        bf16* HBp = ((bf16*)(args.ws + WS_HB)); float* SQp = ((float*)(args.ws + WS_SSQ));
#define SSD_LOAD(cc, X) do { const size_t t0_ = trow0 + (size_t)(cc) * 64; \
            _Pragma("unroll") for (int k = 0; k < 2; ++k) { const int i_ = tid + 512 * k; pb[X][k] = *(const u32x4*)(XCp + (t0_ + (i_ >> 4)) * D + b_col + 8 * (i_ & 15)); pc[X][k] = *(const u32x4*)(XCp + (t0_ + (i_ >> 4)) * D + c_col + 8 * (i_ & 15)); } \
            if (wave < 4) { px[X] = *(const u32x4*)(XCp + (t0_ + (tid >> 2)) * D + xs_col + 8 * (tid & 3)); pz[X] = *(const u32x4*)(PJ + pj(t0_ + (tid >> 2), z_col + 8 * (tid & 3))); } \
            if (wave == 7) pdt[X] = DTp[(t0_ + lane) * 8 + h]; } while (0)
#define SSD_AUX(slot, X) do { if (wave == 7) { float a_ = pdt[X] * Ah; DPP_SHR_ADD(a_, 1); DPP_SHR_ADD(a_, 2); DPP_SHR_ADD(a_, 4); DPP_SHR_ADD(a_, 8); \
                const float r0_ = __int_as_float(__builtin_amdgcn_readlane(__float_as_int(a_), 15)), r1_ = __int_as_float(__builtin_amdgcn_readlane(__float_as_int(a_), 31)), r2_ = __int_as_float(__builtin_amdgcn_readlane(__float_as_int(a_), 47)); \
                a_ += (fq == 1) ? r0_ : (fq == 2) ? (r0_ + r1_) : (fq == 3) ? ((r0_ + r1_) + r2_) : 0.f; \
                ((LAS float*)(lds + SD_ACS))[(slot) * 64 + lane] = a_; ((LAS float*)(lds + SD_DTS))[(slot) * 64 + lane] = pdt[X]; } } while (0)
#define SSD_TILES(ts, X, slot) do { LAS unsigned char* tb_ = lds + (ts) * SD_SET; \
            _Pragma("unroll") for (int k = 0; k < 2; ++k) { const int i_ = tid + 512 * k; *(LAS u32x4*)(tb_ + SD_BM + ((i_ >> 4) * 136 + 8 * (i_ & 15)) * 2) = pb[X][k]; *(LAS u32x4*)(tb_ + SD_CM + ((i_ >> 4) * 136 + 8 * (i_ & 15)) * 2) = pc[X][k]; } \
            if (wave < 4) { const int l_ = tid >> 2, q_ = tid & 3; const LAS float* A_ = (const LAS float*)(lds + SD_ACS) + (slot) * 64; \
                *(LAS u32x4*)(tb_ + SD_XS + (l_ * 40 + 8 * q_) * 2) = px[X]; *(LAS u32x4*)(tb_ + SD_ZR + (l_ * 40 + 8 * q_) * 2) = pz[X]; \
                float f_[8], fd_[8]; unpack8(px[X], f_); const float dt_ = ((const LAS float*)(lds + SD_DTS))[(slot) * 64 + l_], dd_ = dt_ * __expf(A_[63] - A_[l_]); \
                _Pragma("unroll") for (int e = 0; e < 8; ++e) { fd_[e] = f_[e] * dd_; f_[e] *= dt_; } \
                *(LAS u32x4*)(tb_ + SD_DX + (l_ * 40 + 8 * q_) * 2) = pack8(f_); *(LAS u32x4*)(tb_ + SD_DXD + (l_ * 40 + 8 * q_) * 2) = pack8(fd_); } } while (0)
#define SSD_W(ts, slot) do { const LAS unsigned char* tb_ = lds + (ts) * SD_SET; const LAS float* A_ = (const LAS float*)(lds + SD_ACS) + (slot) * 64; \
            _Pragma("unroll") for (int jt = 0; jt < 2; ++jt) { const int id_ = 2 * wave + jt, lt_ = id_ >> 2, st_ = id_ & 3; f32x4 acc_ = (f32x4){0.f, 0.f, 0.f, 0.f}; \
                if (st_ <= lt_) { _Pragma("unroll") for (int kk = 0; kk < 4; ++kk) { const bf16x8 a_ = *(const LAS bf16x8*)(tb_ + SD_BM + ((st_ * 16 + fr) * 136 + kk * 32 + fq * 8) * 2); const bf16x8 b_ = *(const LAS bf16x8*)(tb_ + SD_CM + ((lt_ * 16 + fr) * 136 + kk * 32 + fq * 8) * 2); \
                        acc_ = __builtin_amdgcn_mfma_f32_16x16x32_bf16(a_, b_, acc_, 0, 0, 0); } } \
                const int l_ = lt_ * 16 + fr, s0_ = st_ * 16 + 4 * fq; const float al_ = A_[l_]; float w_[4]; const f32x4 as_ = *(const LAS f32x4*)(A_ + s0_);     \
                _Pragma("unroll") for (int r = 0; r < 4; ++r) { const int s_ = s0_ + r; const float e_ = acc_[r] * __expf(fminf(al_ - as_[r], 0.f)); w_[r] = (s_ <= l_) ? e_ : 0.f; } \
                u32x2 o_; o_.x = cvt_pk_bf16(w_[0], w_[1]); o_.y = cvt_pk_bf16(w_[2], w_[3]); *(LAS u32x2*)(lds + SD_WM + (ts) * 9216 + (l_ * 72 + s0_) * 2) = o_; } } while (0)
        SSD_LOAD(0, 0); SSD_LOAD(1, 1);
        SSD_AUX(0, 0); SSD_AUX(1, 1);
        WG_BAR();
        SSD_TILES(0, 0, 0);
        SSD_LOAD(2, 0);
        WG_BAR();
        SSD_W(0, 0);
        WG_BAR();
        int a0 = 0, a1 = 1, a2 = 2;
        u32x2 ypk = (u32x2){0u, 0u}; float yq = 0.f;
        for (int c2 = 0; c2 < 64; c2 += 2) {
#pragma unroll
        for (int par = 0; par < 2; ++par) {
            const int c = c2 + par; const size_t t0 = trow0 + (size_t)c * 64;
            const LAS unsigned char* tb = lds + par * SD_SET; const LAS float* ACS = (const LAS float*)(lds + SD_ACS) + a0 * 64;
            if (c + 1 < 64) SSD_TILES(par ^ 1, par ^ 1, a1);
            if (c + 2 < 64) SSD_AUX(a2, par);
            if (c > 0) { const int lt_ = wave >> 1, pt_ = wave & 1, l_ = lt_ * 16 + fr, p0_ = pt_ * 16 + 4 * fq; const size_t tp_ = t0 - 64;
                if (fq == 0) SQp[(size_t)((h * 2 + ph) * 2 + pt_) * T + tp_ + l_] = yq;
                *(u32x2*)(HBp + (tp_ + l_) * D + xs_col + p0_) = ypk; }
            if (c + 3 < 64) SSD_LOAD(c + 3, par ^ 1);
            const int lt = wave >> 1, pt = wave & 1, l = lt * 16 + fr, p0 = pt * 16 + 4 * fq;
            f32x4 yd = (f32x4){0.f, 0.f, 0.f, 0.f}, yo = (f32x4){0.f, 0.f, 0.f, 0.f};
#pragma unroll
            for (int kk = 0; kk < 2; ++kk) { const bf16x8 a = lds_tr8(tb + SD_DX + ((kk * 32 + 8 * fq + tq) * 40 + pt * 16 + 4 * tp) * 2, 4 * 80);
                const bf16x8 bb = *(const LAS bf16x8*)(lds + SD_WM + par * 9216 + ((lt * 16 + fr) * 72 + kk * 32 + fq * 8) * 2);
                yd = __builtin_amdgcn_mfma_f32_16x16x32_bf16(a, bb, yd, 0, 0, 0); }
#pragma unroll
            for (int kk = 0; kk < 4; ++kk) { const bf16x8 a = *(const LAS bf16x8*)(lds + SD_SB + ((pt * 16 + fr) * 136 + kk * 32 + fq * 8) * 2); const bf16x8 bb = *(const LAS bf16x8*)(tb + SD_CM + ((lt * 16 + fr) * 136 + kk * 32 + fq * 8) * 2);
                yo = __builtin_amdgcn_mfma_f32_16x16x32_bf16(a, bb, yo, 0, 0, 0); }
            const u32x2 xw = *(const LAS u32x2*)(tb + SD_XS + (l * 40 + p0) * 2), zw = *(const LAS u32x2*)(tb + SD_ZR + (l * 40 + p0) * 2);
            const float el = __expf(ACS[l]), cd = __expf(ACS[63]);
#pragma unroll
            for (int jt = 0; jt < 2; ++jt) { const int id = 2 * wave + jt, nt = id >> 1, pt2 = id & 1;
                Sacc[jt] = Sacc[jt] * cd;
#pragma unroll
                for (int kk = 0; kk < 2; ++kk) { const bf16x8 a = lds_tr8(tb + SD_BM + ((kk * 32 + 8 * fq + tq) * 136 + nt * 16 + 4 * tp) * 2, 4 * 272);
                    const bf16x8 bb = lds_tr8(tb + SD_DXD + ((kk * 32 + 8 * fq + tq) * 40 + pt2 * 16 + 4 * tp) * 2, 4 * 80);
                    Sacc[jt] = __builtin_amdgcn_mfma_f32_16x16x32_bf16(a, bb, Sacc[jt], 0, 0, 0); } }
            WG_BAR();
            {
                const float xs[4] = {bflo(xw.x), bfhi(xw.x), bflo(xw.y), bfhi(xw.y)}, zz[4] = {bflo(zw.x), bfhi(zw.x), bflo(zw.y), bfhi(zw.y)};
                float y[4], q2 = 0.f;
#pragma unroll
                for (int r = 0; r < 4; ++r) { y[r] = (yd[r] + el * yo[r] + Dh * xs[r]) * silu_f(zz[r]); q2 += y[r] * y[r]; }
                q2 += __shfl_xor(q2, 16); q2 += __shfl_xor(q2, 32);
                yq = q2; ypk.x = cvt_pk_bf16(y[0], y[1]); ypk.y = cvt_pk_bf16(y[2], y[3]);
            }
#pragma unroll
            for (int jt = 0; jt < 2; ++jt) { const int id = 2 * wave + jt, nt = id >> 1, pt2 = id & 1;
                u32x2 o; o.x = cvt_pk_bf16(Sacc[jt][0], Sacc[jt][1]); o.y = cvt_pk_bf16(Sacc[jt][2], Sacc[jt][3]);
                *(LAS u32x2*)(lds + SD_SB + ((pt2 * 16 + fr) * 136 + nt * 16 + 4 * fq) * 2) = o; }
            if (c + 1 < 64) SSD_W(par ^ 1, a1);
            WG_BAR();
            { const int t_ = a0; a0 = a1; a1 = a2; a2 = t_; }
        }
        }
#undef SSD_LOAD
#undef SSD_AUX
#undef SSD_TILES
#undef SSD_W
        { const int lt_ = wave >> 1, pt_ = wave & 1, l_ = lt_ * 16 + fr, p0_ = pt_ * 16 + 4 * fq; const size_t tp_ = trow0 + (size_t)63 * 64;
            if (fq == 0) SQp[(size_t)((h * 2 + ph) * 2 + pt_) * T + tp_ + l_] = yq;
            *(u32x2*)(HBp + (tp_ + l_) * D + xs_col + p0_) = ypk; }
        WG_BAR();
    }
}

__device__ __forceinline__ void p1_router_weights(const Frame& F_, CArgs& args_) {
    Frame F = F_; F.lane = lane_id_asm(); F.tid = F.wave * 64 + F.lane;
    ARGS_LAUNDER(args_);
    LAS float* red = (LAS float*)F.lds;
    for (int w = F.vcu; w < 256; w += F.G) {
        const int b = w >> 4, e0 = 4 * (w & 15); float bs[4] = {0.f, 0.f, 0.f, 0.f};
        const float* mod = (const float*)(args.ws + WS_MOD) + b * 6144;
#pragma unroll
        for (int kk = 0; kk < 2; ++kk) { const int k = F.tid + 512 * kk; const f32x4 wv = *(const f32x4*)((args.in[15]) + (size_t)k * 64 + e0);
            const float sc = (args.in[14])[k] * (1.0f + mod[4096 + k]), sh = mod[3072 + k];
#pragma unroll
            for (int j = 0; j < 4; ++j) { ((bf16*)(args.ws + WS_WR))[((size_t)b * 64 + e0 + j) * 1024 + k] = f2bf(wv[j] * sc); bs[j] += sh * wv[j]; } }
#pragma unroll
        for (int j = 0; j < 4; ++j) bs[j] = wave_sum(bs[j]);
        if (F.lane == 0) { red[F.wave * 4 + 0] = bs[0]; red[F.wave * 4 + 1] = bs[1]; red[F.wave * 4 + 2] = bs[2]; red[F.wave * 4 + 3] = bs[3]; }
        WG_BAR();
        if (F.tid < 4) { float s = 0.f;
#pragma unroll
            for (int q = 0; q < 8; ++q) s += red[q * 4 + F.tid];
            ((float*)(args.ws + WS_RB))[b * 64 + e0 + F.tid] = s; }
        WG_BAR();
    }
}
constexpr int RT_WST = 1032;
constexpr int RT_LOG = 0, RT_CNT = 65536, RT_BASE = 65536 + 256, RT_LE = 66560, RT_LW = 66560 + 8192;
constexpr int RT_RS = RT_LW + 8192;
static_assert(64 * RT_WST * 2 <= MISC_OFF && RT_RS + 1024 <= MISC_OFF, "router LDS map");
__device__ __forceinline__ void p7_router(const Frame& F_, CArgs& args_) {
    Frame F = F_; F.lane = lane_id_asm(); F.tid = F.wave * 64 + F.lane;
    ARGS_LAUNDER(args_);
    LAS unsigned char* lds = F.lds; const int tid = F.tid, lane = F.lane, wave = F.wave, fr = lane & 15, fq = lane >> 4;
    LAS int* lcnt = (LAS int*)(lds + RT_CNT); LAS int* lbase = (LAS int*)(lds + RT_BASE);
    LAS unsigned* le = (LAS unsigned*)(lds + RT_LE); LAS float* lw = (LAS float*)(lds + RT_LW);
    const float bias = (args.in[16])[lane];
    for (int tile = F.vcu; tile < T / 256; tile += F.G) {
        const int s = (tile * 256) / TS, b = (tile * 256) / SEQ;
        { const u32x4* wsrc = (const u32x4*)((const bf16*)(args.ws + WS_WR) + (size_t)b * 64 * 1024);
          u32x4 wt[16];
#pragma unroll
          for (int j = 0; j < 16; ++j) wt[j] = wsrc[tid + 512 * j];
#pragma unroll
          for (int j = 0; j < 16; ++j) { const int i = tid + 512 * j, e = i >> 7, c = i & 127; *(LAS u32x4*)(lds + (e * RT_WST + 8 * c) * 2) = wt[j]; } }
        WG_BAR();
        const bf16* xb = (const bf16*)(args.ws + WS_X1) + (size_t)(tile * 256 + wave * 32) * D;
        f32x4 acc[2][4]; float ssq[2] = {0.f, 0.f};
#pragma unroll
        for (int g = 0; g < 2; ++g)
#pragma unroll
            for (int n = 0; n < 4; ++n) acc[g][n] = (f32x4){0.f, 0.f, 0.f, 0.f};
        constexpr int XG = 2;
        u32x4 xs0[XG][2], xs1[XG][2], xs2[XG][2], xs3[XG][2];
#define RT_XLOAD(dst, k0_) do { _Pragma("unroll") for (int q = 0; q < XG; ++q) _Pragma("unroll") for (int g = 0; g < 2; ++g) dst[q][g] = *(const u32x4*)(xb + (size_t)(16 * g + fr) * D + 32 * ((k0_) + q) + 8 * fq); } while (0)
#define RT_XMMA(srcx, k0_) do { _Pragma("unroll") for (int q = 0; q < XG; ++q) { const int ks = (k0_) + q; bf16x8 bfr[2]; \
            _Pragma("unroll") for (int g = 0; g < 2; ++g) { const u32x4 xv = srcx[q][g]; bfr[g] = __builtin_bit_cast(bf16x8, xv); float f[8]; unpack8(xv, f); _Pragma("unroll") for (int j = 0; j < 8; ++j) ssq[g] += f[j] * f[j]; } \
            _Pragma("unroll") for (int n = 0; n < 4; ++n) { const bf16x8 afr = *(const LAS bf16x8*)(lds + ((16 * n + fr) * RT_WST + 32 * ks + 8 * fq) * 2); \
                _Pragma("unroll") for (int g = 0; g < 2; ++g) acc[g][n] = __builtin_amdgcn_mfma_f32_16x16x32_bf16(afr, bfr[g], acc[g][n], 0, 0, 0); } } } while (0)
        RT_XLOAD(xs0, 0); RT_XLOAD(xs1, XG); RT_XLOAD(xs2, 2 * XG); RT_XLOAD(xs3, 3 * XG);
#pragma unroll 1
        for (int k0 = 0; k0 < 32; k0 += 4 * XG) {
            const int kn = k0 + 4 * XG < 32 ? k0 + 4 * XG : k0;
            RT_XMMA(xs0, k0);          RT_XLOAD(xs0, kn);
            RT_XMMA(xs1, k0 + XG);     RT_XLOAD(xs1, kn + XG);
            RT_XMMA(xs2, k0 + 2 * XG); RT_XLOAD(xs2, kn + 2 * XG);
            RT_XMMA(xs3, k0 + 3 * XG); RT_XLOAD(xs3, kn + 3 * XG);
        }
#undef RT_XLOAD
#undef RT_XMMA
        WG_BAR();
        if (tid < 64) lcnt[tid] = 0;
#pragma unroll
        for (int g = 0; g < 2; ++g) { float q = ssq[g]; q += __shfl_xor(q, 16); q += __shfl_xor(q, 32); const float rstd = rsqrtf(q * (1.0f / D) + EPS);
            if (fq == 0) *(LAS float*)(lds + RT_RS + (wave * 32 + 16 * g + fr) * 4) = rstd;
#pragma unroll
            for (int n = 0; n < 4; ++n) { const f32x4 rb = *(const f32x4*)((const float*)(args.ws + WS_RB) + b * 64 + 16 * n + 4 * fq);
                *(LAS f32x4*)(lds + RT_LOG + ((wave * 32 + 16 * g + fr) * 64 + 16 * n + 4 * fq) * 4) = acc[g][n] * rstd + rb; } }
        WG_BAR();
        f32x4 hsc[4], hsh[4];
#pragma unroll
        for (int j = 0; j < 4; ++j) { const int col = 16 * lane + 4 * j; const float* mod = (const float*)(args.ws + WS_MOD) + b * 6144;
            hsc[j] = *(const f32x4*)((args.in[14]) + col) * (*(const f32x4*)(mod + 4096 + col) + 1.0f); hsh[j] = *(const f32x4*)(mod + 3072 + col); }
        const bf16* xrow = (const bf16*)(args.ws + WS_X1) + (size_t)(tile * 256 + wave * 32) * D + 16 * lane;
        unsigned char* hrow = (unsigned char*)(args.ws + WS_H8) + (size_t)(tile * 256 + wave * 32) * D + 16 * lane;
        u32x4 xn0 = *(const u32x4*)(xrow), xn1 = *(const u32x4*)(xrow + 8);
#pragma unroll 2
        for (int i = 0; i < 32; ++i) {
            const int tl = wave * 32 + i;
            const u32x4 xc0 = xn0, xc1 = xn1;
            if (i + 1 < 32) { xn0 = *(const u32x4*)(xrow + (size_t)(i + 1) * D); xn1 = *(const u32x4*)(xrow + (size_t)(i + 1) * D + 8); }
            { const float rs = *(const LAS float*)(lds + RT_RS + tl * 4); float f[16]; { float t8[8]; unpack8(xc0, t8);
#pragma unroll
                for (int j = 0; j < 8; ++j) f[j] = t8[j]; unpack8(xc1, t8);
#pragma unroll
                for (int j = 0; j < 8; ++j) f[8 + j] = t8[j]; }
                u32x4 hw; unsigned hv[4];
#pragma unroll
                for (int j = 0; j < 4; ++j) { const f32x4 h = (f32x4){f[4 * j], f[4 * j + 1], f[4 * j + 2], f[4 * j + 3]} * rs * hsc[j] + hsh[j];
                    int q8 = __builtin_amdgcn_cvt_pk_fp8_f32(h.x, h.y, 0, false); q8 = __builtin_amdgcn_cvt_pk_fp8_f32(h.z, h.w, q8, true); hv[j] = (unsigned)q8; }
                hw.x = hv[0]; hw.y = hv[1]; hw.z = hv[2]; hw.w = hv[3];
                *(u32x4*)(hrow + (size_t)i * D) = hw; }
            const float logit = *(const LAS float*)(lds + RT_LOG + (tl * 64 + lane) * 4);
            const float score = __builtin_amdgcn_rcpf(1.0f + __expf(-logit)), sel = score + bias;
            const float m1 = max8(sel);
            const unsigned long long eq = __ballot(sel == m1);
            const unsigned gm = (unsigned)(eq >> (lane & 56)) & 0xffu;
            const int first = gm ? __builtin_ctz(gm) : 0;
            const float m2 = max8(((lane & 7) == first) ? -INFINITY : sel);
            const float gs = m1 + m2; const int g = lane >> 3; int grank = 0;
            const unsigned ghi = f32_key(gs); const unsigned long long gme = ((unsigned long long)ghi << 32) | (unsigned)(7 - g);
#pragma unroll
            for (int j = 0; j < 8; ++j) { const unsigned long long go = ((unsigned long long)(unsigned)__builtin_amdgcn_readlane((int)ghi, 8 * j) << 32) | (unsigned)(7 - j); grank += (go > gme) ? 1 : 0; }
            const bool gsel = grank < 4; const unsigned long long gmask = __ballot(gsel);
            int rank = 0;
            const unsigned khi = f32_key(sel); const unsigned long long kme = ((unsigned long long)khi << 32) | (unsigned)(63 - lane);
#pragma unroll
            for (int j = 0; j < 8; ++j) if ((gmask >> (8 * j)) & 1ull) {
#pragma unroll
                for (int i = 0; i < 8; ++i) { const unsigned long long ko = ((unsigned long long)(unsigned)__builtin_amdgcn_readlane((int)khi, 8 * j + i) << 32) | (unsigned)(63 - (8 * j + i)); rank += (ko > kme) ? 1 : 0; } }
            const bool chosen = gsel && rank < TOPK;
            const float wsum = wave_sum(chosen ? score : 0.f);
            if (chosen) { const int pos = __hip_atomic_fetch_add(lcnt + lane, 1, __ATOMIC_RELAXED, __HIP_MEMORY_SCOPE_WORKGROUP);
                le[tl * 8 + rank] = (unsigned)lane | ((unsigned)pos << 8); lw[tl * 8 + rank] = score / wsum * 2.5f; }
        }
        WG_BAR();
        if (tid < 64) lbase[tid] = (int)__hip_atomic_fetch_add(((unsigned*)(args.ws + WS_CTL) + CW_CNT) + s * 80 + tid, (unsigned)lcnt[tid], RLX_AGENT);
        WG_BAR();
        for (int idx = tid; idx < 2048; idx += 512) { const unsigned v = le[idx]; const int e = v & 0xffu; const size_t o = (size_t)tile * 2048 + idx;
            const int pos = (int)(v >> 8) + lbase[e]; ((int*)(args.ws + WS_IDX))[o] = e; ((int*)(args.ws + WS_APOS))[o] = pos; ((float*)(args.ws + WS_WGT))[o] = lw[idx];
            ((int*)(args.ws + WS_LIST))[(size_t)e * T + pos] = tile * 256 + (idx >> 3); }
        WG_BAR();
    }
}
__device__ __forceinline__ void load_eoff(const Frame& F_, CArgs& args_) {
    Frame F = F_; F.lane = lane_id_asm(); F.tid = F.wave * 64 + F.lane;
    ARGS_LAUNDER(args_);
    LAS int* eoff = (LAS int*)(F.lds + EO_OFF); LAS int* ecnt = (LAS int*)(F.lds + EC_OFF);
    if (F.tid < S_SB) { const int s = F.tid; int acc = 0;
        for (int e = 0; e < NEX; ++e) { const int cnt = e < NE ? (int)((unsigned*)(args.ws + WS_CTL) + CW_CNT)[s * 80 + e] : TS; eoff[s * 72 + e] = acc; ecnt[s * 72 + e] = cnt; acc += (cnt + 255) & ~255; }
        eoff[s * 72 + NEX] = acc; }
    WG_BAR();
}
__device__ __forceinline__ int moe_tables(const Frame& F_, CArgs& args_, int s, bool gather) {
    Frame F = F_; F.lane = lane_id_asm(); F.tid = F.wave * 64 + F.lane;
    ARGS_LAUNDER(args_);
    asm volatile("" : "+s"(s));
    const LAS int* eoff = (const LAS int*)(F.lds + EO_OFF) + s * 72;
    LAS unsigned char* te = F.lds + TE_OFF;
    const int NT = eoff[NEX] >> 8;
    for (int e = F.wave; e < NEX; e += 8) { const int t0 = eoff[e] >> 8, t1 = eoff[e + 1] >> 8; for (int t = t0 + F.lane; t < t1; t += 64) te[t] = (unsigned char)e; }
    WG_BAR();
    if (gather) { LAS unsigned* tab = (LAS unsigned*)(F.lds + TAB_OFF);
        int nsl = (2 * NT - F.vcu + F.G - 1) / F.G; nsl = nsl < 0 ? 0 : (nsl > TAB_SLOTS ? TAB_SLOTS : nsl);
        const int nent = nsl * 256; const int* LISTp = (const int*)(args.ws + WS_LIST);
#pragma unroll 1
        for (int base = 0; base < nent; base += 2048) {
            int tokv[4], dflt[4]; bool fromlist[4];
#pragma unroll
            for (int j = 0; j < 4; ++j) { int idx = base + j * 512 + F.tid; idx = idx < nent ? idx : nent - 1; const int i = idx >> 8, r = idx & 255, rt = (i * F.G + F.vcu) >> 1;
                const int e = te[rt], pos = rt * 256 - eoff[e] + r;
                fromlist[j] = e < NE && pos < ((const LAS int*)(F.lds + EC_OFF))[s * 72 + e]; dflt[j] = e < NE ? 0 : s * TS + pos;
                tokv[j] = LISTp[fromlist[j] ? (size_t)e * T + pos : (size_t)0]; }
#pragma unroll
            for (int j = 0; j < 4; ++j) { const int idx = base + j * 512 + F.tid; if (idx < nent) tab[idx] = (unsigned)(fromlist[j] ? tokv[j] : dflt[j]) * 1024u; }
        } }
    WG_BAR();
    return NT;
}
__device__ __forceinline__ void pc_combine(const Frame& F_, CArgs& args_, int s) {
    Frame F = F_; F.lane = lane_id_asm(); F.tid = F.wave * 64 + F.lane;
    ARGS_LAUNDER(args_);
    asm volatile("" : "+s"(s));
    const LAS int* eoff = (const LAS int*)(F.lds + EO_OFF) + s * 72;
    const int shoff = eoff[NE];
    const int gw = F.vcu * 8 + F.wave, NGW = F.G * 8, lane = F.lane;
    constexpr int PER = 16;
    const unsigned char* Y8 = (const unsigned char*)(args.ws + WS_A); const bf16* x1b = (const bf16*)(args.ws + WS_X1);
    for (int blk = gw; blk < TS / PER; blk += NGW) {
        const int tl0 = blk * PER, b = (s * TS + tl0) / SEQ;
        f32x4 g2[4], nf[4];
#pragma unroll
        for (int i = 0; i < 4; ++i) { const int col = 256 * i + 4 * lane; g2[i] = *(const f32x4*)(((float*)(args.ws + WS_MOD)) + b * 6144 + 5120 + col); nf[i] = *(const f32x4*)((args.in[23]) + col); }
#pragma unroll 2
        for (int r = 0; r < PER; ++r) {
            const int tl = tl0 + r, t = s * TS + tl;
            f32x4 acc[4];
#pragma unroll
            for (int i = 0; i < 4; ++i) acc[i] = (f32x4){0.f, 0.f, 0.f, 0.f};
#pragma unroll
            for (int k = 0; k < 9; ++k) {
                const int row = k < 8 ? eoff[((int*)(args.ws + WS_IDX))[(size_t)t * 8 + k]] + ((int*)(args.ws + WS_APOS))[(size_t)t * 8 + k] : shoff + tl; const float w = (k < 8 ? ((float*)(args.ws + WS_WGT))[(size_t)t * 8 + k] : 1.0f) * (1.0f / 16.0f);
                unsigned yw[4];
#pragma unroll
                for (int i = 0; i < 4; ++i) yw[i] = *(const unsigned*)(Y8 + (size_t)row * D + 256 * i + 4 * lane);
#pragma unroll
                for (int i = 0; i < 4; ++i) { const f32x2 lo = __builtin_amdgcn_cvt_pk_f32_fp8((int)yw[i], false), hi = __builtin_amdgcn_cvt_pk_f32_fp8((int)yw[i], true);
                    acc[i] = acc[i] + (f32x4){lo.x, lo.y, hi.x, hi.y} * w; }
            }
            float* orow = (args.out) + (size_t)t * D + 4 * lane; float ss = 0.f; f32x4 xf[4];
#pragma unroll
            for (int i = 0; i < 4; ++i) { const u32x2 xw = *(const u32x2*)(x1b + (size_t)t * D + 256 * i + 4 * lane); const f32x4 x1 = (f32x4){bflo(xw.x), bfhi(xw.x), bflo(xw.y), bfhi(xw.y)}; const f32x4 v = x1 + g2[i] * acc[i]; xf[i] = v; ss += (v.x * v.x + v.y * v.y) + (v.z * v.z + v.w * v.w); }
            const float rstd = rsqrtf(wave_sum(ss) * (1.0f / D) + EPS);
#pragma unroll
            for (int i = 0; i < 4; ++i) *(f32x4*)(orow + 256 * i) = xf[i] * rstd * nf[i];
        }
    }
}

__device__ __forceinline__ void stagger(int quanta) { const int j = ((int)blockIdx.x >> 3) & 7; for (int i = 0; i < j * quanta; ++i) __builtin_amdgcn_s_sleep(16); }

constexpr int NPH = 10 + 3 * S_SB;
__global__ void __launch_bounds__(512, 2) fwd_kernel(Args args_k) {
    CArgs& kargs = *(CArgs*)__builtin_amdgcn_kernarg_segment_ptr();
    extern __shared__ __attribute__((aligned(16))) unsigned char lds_raw[];
    Frame F;
    F.lds = (LAS unsigned char*)lds_raw; F.MISC = (volatile LAS unsigned*)(F.lds + MISC_OFF);
    F.wave = __builtin_amdgcn_readfirstlane((int)threadIdx.x >> 6); F.lane = 0; F.tid = 0;
    F.G = gridDim.x; { const int bx = blockIdx.x; F.vcu = (F.G % 8 == 0) ? (bx % 8) * (F.G / 8) + bx / 8 : bx; }
    F.ctl = (unsigned*)(kargs.ws + WS_CTL);
    if (threadIdx.x < 64) ((LAS unsigned*)(F.lds + MISC_OFF))[threadIdx.x] = 0u;
    __syncthreads();
    XcdBarrier bar; bar.bar = F.ctl + CW_BAR; bar.x = 0; bar.st = nullptr;
    if (!MK_PER_PHASE) bar = xcd_barrier_post(F.ctl + CW_BAR, F.MISC);
    const int lo = MK_PER_PHASE ? kargs.ph_lo : 0, hi = MK_PER_PHASE ? kargs.ph_hi : NPH;
#ifndef PH_ENABLE
#define PH_ENABLE 0xffffffffu
#endif
#define IN(k) (((PH_ENABLE >> ((k) > 9 ? 10 + ((k) - 10) % 3 : (k))) & 1u) && lo <= (k) && (k) < hi)
#ifndef DUP_MASK
#define DUP_MASK 0u
#endif
#define REPEAT(k) _Pragma("unroll 1") for (int rep_ = 0; rep_ < 1 + (int)((DUP_MASK >> (k)) & 1u); ++rep_)
#define SEAM(k) do { if (!MK_PER_PHASE && IN(k) && IN((k) + 1)) xcd_barrier(bar, F.wave); } while (0)

    if (IN(0)) { REPEAT(0) { p0_prologue(F, kargs); } SEAM(0); }
    if (IN(1)) { ARGS_LAUNDER(kargs); p1_router_weights(F, kargs); REPEAT(1) { p_norm_mod<true, false>(F, kargs, (args.in[0]), (args.in[4]), 0, 1024, ((bf16*)(args.ws + WS_HB)), nullptr); } SEAM(1); }
    if (IN(2)) { ARGS_LAUNDER(kargs);
        pg8::PlainOrder S; S.init(((bf16*)(args.ws + WS_HB)), ((bf16*)(args.ws + WS_WIN)), T, NPROJ, D, F.G, (int)blockIdx.x); pg8::EpiBf16T E{((bf16*)(args.ws + WS_A)), NPJ / 256};
        stagger(STG_P2); REPEAT(2) { pg8::gemm_phase<pg8::EpiBf16T, pg8::PlainOrder, true>(F.lds, F.wave, D, S, E); } SEAM(2); }
    if (IN(3)) { REPEAT(3) { p3_conv(F, kargs); } SEAM(3); }
    if (IN(4)) { REPEAT(4) { p4_ssd(F, kargs); } SEAM(4); }
    if (IN(5)) { ARGS_LAUNDER(kargs);
        pg8::PlainOrder S; S.init(((bf16*)(args.ws + WS_HB)), ((bf16*)(args.ws + WS_WOUT)), T, D, D, F.G, (int)blockIdx.x);
        {
            const int lane = lane_id_asm(), tid = F.wave * 64 + lane, r = tid & 255, hf = tid >> 8;
            LAS float* rstab = (LAS float*)(F.lds + TAB_OFF); LAS float* tmp = (LAS float*)(F.lds);
            pg8::Unit u;
            for (int i0 = 0; i0 < 16; i0 += 4) {
                float sv[4]; bool ok[4]; float pv[4][16];
#pragma unroll
                for (int j = 0; j < 4; ++j) { ok[j] = S.next(i0 + j, u); const int pm = ok[j] ? u.pm : 0;
                    const float* sp = ((const float*)(args.ws + WS_SSQ)) + (size_t)(16 * hf) * T + pm * 256 + r;
#pragma unroll
                    for (int q = 0; q < 16; ++q) pv[j][q] = sp[(size_t)q * T]; }
#pragma unroll
                for (int j = 0; j < 4; ++j) { float s = 0.f;
#pragma unroll
                    for (int q = 0; q < 16; ++q) s += pv[j][q];
                    sv[j] = s; if (hf) tmp[j * 256 + r] = s; }
                WG_BAR();
#pragma unroll
                for (int j = 0; j < 4; ++j) if (!hf && ok[j]) rstab[(i0 + j) * 256 + r] = rsqrtf((sv[j] + tmp[j * 256 + r]) * (1.0f / 512.0f) + EPS);
                WG_BAR();
                if (!ok[3]) break;
            }
        }
        pg8::EpiX1 E{(args.in[0]), (bf16*)(args.ws + WS_X1), ((float*)(args.ws + WS_MOD)) + 2048, (const LAS float*)(F.lds + TAB_OFF)};
        stagger(STG_P5); REPEAT(5) { pg8::gemm_phase<pg8::EpiX1, pg8::PlainOrder, false>(F.lds, F.wave, D, S, E); } SEAM(5); }
    if (IN(6)) { p7_router(F, kargs); SEAM(9); }
    load_eoff(F, kargs);
    for (int s = 0; s < S_SB; ++s) {
        const int k0 = 10 + 3 * s;
        if (IN(k0)) { ARGS_LAUNDER(kargs);
            const int NT = moe_tables(F, kargs, s, true);
            pg8::MoeOrder<1, true> S; S.NT = NT; S.G = F.G; S.c = F.vcu; S.A = (const char*)(args.ws + WS_H8); S.W = (const char*)(args.ws + WS_WGU); S.rowb = 0; S.w_exp = (size_t)512 * 1024; S.w_tile = (size_t)256 * 1024;
            S.te = F.lds + TE_OFF; S.tab = (const LAS unsigned*)(F.lds + TAB_OFF);
            pg8::EpiGU E{(unsigned char*)(args.ws + WS_HID)};
            stagger(STG_G); REPEAT(10) { pg8::gemm_phase<pg8::EpiGU, pg8::MoeOrder<1, true>, true, true>(F.lds, F.wave, D, S, E); } SEAM(k0); }
        if (IN(k0 + 1)) { ARGS_LAUNDER(kargs);
            const int NT = moe_tables(F, kargs, s, false);
            pg8::MoeOrderD S; S.NT = NT; S.G = F.G; S.c = F.vcu; S.A = (const char*)(args.ws + WS_HID); S.W = (const char*)(args.ws + WS_WD); S.rowb = 256u; S.w_exp = (size_t)1024 * 256; S.w_tile = (size_t)256 * 256;
            S.te = F.lds + TE_OFF;
            pg8::EpiFp8 E{(unsigned char*)(args.ws + WS_A), D, 1.0f, (unsigned char*)(args.ws + WS_LIST)};
            int Kd = 256; asm volatile("" : "+s"(Kd));
            stagger(STG_D); REPEAT(11) { pg8::gemm_phase<pg8::EpiFp8, pg8::MoeOrderD, true, true>(F.lds, F.wave, Kd, S, E); } SEAM(k0 + 1); }
        if (IN(k0 + 2)) { pc_combine(F, kargs, s); if (MK_PER_PHASE == 0 && s + 1 < S_SB) { asm volatile("s_waitcnt vmcnt(0)" ::: "memory"); __syncthreads(); } }
    }
#undef IN
#undef SEAM
}

extern "C" void kernel_launch(void* const* d_in, const int* in_sizes, int n_in, void* d_out, int out_size, void* d_ws, size_t ws_size, hipStream_t stream) {
    static int grid = 0;
    if (grid == 0) {
        if (n_in != 24 || in_sizes[0] != T * D || out_size != T * D || ws_size < WS_END) { fprintf(stderr, "kernel_launch: unexpected shapes / workspace (n_in %d, ws %zu, need %zu)\n", n_in, ws_size, (size_t)WS_END); grid = -1; return; }
        int dev = 0, cus = 0, per_cu = 0;
        if (hipGetDevice(&dev) != hipSuccess || hipDeviceGetAttribute(&cus, hipDeviceAttributeMultiprocessorCount, dev) != hipSuccess) { grid = -1; return; }
        if (hipFuncSetAttribute((const void*)fwd_kernel, hipFuncAttributeMaxDynamicSharedMemorySize, LDS_BYTES) != hipSuccess) { fprintf(stderr, "kernel_launch: hipFuncSetAttribute failed\n"); grid = -1; return; }
        if (hipOccupancyMaxActiveBlocksPerMultiprocessor(&per_cu, (const void*)fwd_kernel, 512, LDS_BYTES) != hipSuccess || per_cu < 1) fprintf(stderr, "kernel_launch: occupancy query says %d\n", per_cu);
        (void)hipGetLastError();
        grid = cus;
    }
    if (grid < 0) return;
    if (hipMemsetAsync((char*)d_ws + WS_CTL, 0, CTL_ZERO_BYTES, stream) != hipSuccess) return;
    Args a{};
    for (int i = 0; i < 24; ++i) a.in[i] = (const float*)d_in[i];
    a.out = (float*)d_out; a.ws = (unsigned char*)d_ws;
#if MK_PER_PHASE
    for (int p = 0; p < NPH; ++p) { a.ph_lo = p; a.ph_hi = p + 1; hipLaunchKernelGGL(fwd_kernel, dim3(grid), dim3(512), LDS_BYTES, stream, a); }
#else
    a.ph_lo = 0; a.ph_hi = NPH;
    hipLaunchKernelGGL(fwd_kernel, dim3(grid), dim3(512), LDS_BYTES, stream, a);
#endif
}
```

```cpp
#include <hip/hip_runtime.h>
#include <cstdio>
#include <cstdint>
#include <type_traits>

#define LAS __attribute__((address_space(3)))
#define GAS __attribute__((address_space(1)))
typedef unsigned short bf16;
typedef short bf16x8 __attribute__((ext_vector_type(8)));
typedef float f32x4 __attribute__((ext_vector_type(4)));
typedef float f32x2 __attribute__((ext_vector_type(2)));
typedef unsigned u32x4 __attribute__((ext_vector_type(4)));
typedef unsigned u32x2 __attribute__((ext_vector_type(2)));

#define STG_P2 0
#define STG_P5 0
#define STG_G 0
#define STG_D 0
#ifndef MK_PER_PHASE
#define MK_PER_PHASE 0
#endif

constexpr int T = 65536, D = 1024, SEQ = 4096, NB = 16;
constexpr int NPROJ = 3072, LDWIN = 3080;
constexpr int NPJ = 2560;
constexpr int C_CB = 0, C_P = 512, C_Z = 1024, C_XBC = 1536;
constexpr int NE = 64, NEX = 65, TOPK = 8;
constexpr int S_SB = 1, TS = T / S_SB;
constexpr int MAXT = (TS * 9) / 256 + 64;
constexpr int MAXROWS = MAXT * 256;
constexpr float EPS = 1e-6f;

constexpr size_t MiB = 1u << 20;
constexpr size_t WS_CTL = 0, CTL_ZERO_BYTES = 1 * MiB;
constexpr size_t WS_MOD = 128 * 1024;
constexpr size_t WS_WDT = 1 * MiB;
constexpr size_t WS_WIN = 2 * MiB, WS_WOUT = 8 * MiB, WS_WR = 10 * MiB;
constexpr size_t WS_RB = 1 * MiB + 64 * 1024;
constexpr size_t WS_WGU = 12 * MiB;
constexpr size_t WS_WD = 45 * MiB;
constexpr size_t WS_DT = 62 * MiB;
constexpr size_t WS_IDX = 64 * MiB, WS_WGT = 66 * MiB, WS_APOS = 68 * MiB, WS_ROWOF = 70 * MiB;
constexpr size_t WS_R2T = 72 * MiB;
constexpr size_t WS_HB = 76 * MiB;
constexpr size_t WS_HID = 76 * MiB;
constexpr size_t WS_A = 232 * MiB;
constexpr size_t WS_XC = 616 * MiB;
constexpr size_t WS_SSQ = 744 * MiB;
constexpr size_t WS_LOG = 752 * MiB;
constexpr size_t WS_H8 = 768 * MiB;
constexpr size_t WS_X1 = 832 * MiB;
constexpr size_t WS_LIST = 960 * MiB;
constexpr size_t WS_END = 976 * MiB;
static_assert(WS_WGU + (size_t)NEX * 512 * 1024 <= WS_WD && WS_WD + (size_t)NEX * 1024 * 256 <= WS_DT && WS_R2T + (size_t)S_SB * MAXROWS * 4 <= WS_HB && WS_HID + (size_t)MAXROWS * 256 <= WS_A && WS_HB + (size_t)T * D * 2 <= WS_A
              && WS_A + (size_t)T * NPROJ * 2 <= WS_XC && WS_A + (size_t)MAXROWS * 1024 <= WS_X1 && WS_XC + (size_t)T * D * 2 <= WS_SSQ && WS_SSQ + (size_t)32 * T * 4 <= WS_LOG && WS_LOG + (size_t)T * 64 * 4 <= WS_H8
              && WS_H8 + (size_t)T * D <= WS_X1 && WS_X1 + (size_t)T * D * 2 <= WS_LIST && WS_LIST + (size_t)NE * T * 4 <= WS_END, "ws map");
constexpr int CW_BAR = 4096;
constexpr int CW_CNT = 8192;

constexpr int RING_BYTES = 131072;
constexpr int TAB_SLOTS = 20;
constexpr int TAB_OFF = RING_BYTES, TAB_BYTES = TAB_SLOTS * 1024;
constexpr int TE_OFF = TAB_OFF + TAB_BYTES;
constexpr int EO_OFF = TE_OFF + ((MAXT + 63) / 64) * 64;
constexpr int EC_OFF = EO_OFF + S_SB * 72 * 4;
constexpr int MISC_OFF = EC_OFF + S_SB * 72 * 4;
constexpr int LDS_BYTES = ((MISC_OFF + 256 + 1023) / 1024) * 1024;
static_assert(LDS_BYTES <= 160 * 1024 && (2 * MAXT + 255) / 256 <= TAB_SLOTS, "LDS");

#define RLX_AGENT __ATOMIC_RELAXED, __HIP_MEMORY_SCOPE_AGENT
#define LDS_WAIT() asm volatile("s_waitcnt lgkmcnt(0)" ::: "memory")
#define WG_BAR() do { asm volatile("s_waitcnt lgkmcnt(0)" ::: "memory"); __builtin_amdgcn_s_barrier(); asm volatile("" ::: "memory"); } while (0)
__device__ __forceinline__ unsigned cvt_pk_bf16(float lo, float hi) { unsigned r; asm volatile("v_cvt_pk_bf16_f32 %0, %1, %2" : "=v"(r) : "v"(lo), "v"(hi)); return r; }
__device__ __forceinline__ float bflo(unsigned w) { return __uint_as_float(w << 16); }
__device__ __forceinline__ float bfhi(unsigned w) { return __uint_as_float(w & 0xffff0000u); }
__device__ __forceinline__ float bf2f(unsigned short h) { return __uint_as_float(((unsigned)h) << 16); }
__device__ __forceinline__ unsigned short f2bf(float f) { return (unsigned short)(cvt_pk_bf16(f, 0.f) & 0xffffu); }
__device__ __forceinline__ float silu_f(float x) { return x * __builtin_amdgcn_rcpf(1.0f + __expf(-x)); }
#define DPP_F(v, ctrl) __int_as_float(__builtin_amdgcn_update_dpp(0, __float_as_int(v), (ctrl), 0xf, 0xf, false))
__device__ __forceinline__ float wave_sum(float v) {
    v += DPP_F(v, 0xB1); v += DPP_F(v, 0x4E); v += DPP_F(v, 0x141); v += DPP_F(v, 0x140);
    const float r0 = __int_as_float(__builtin_amdgcn_readlane(__float_as_int(v), 0)), r1 = __int_as_float(__builtin_amdgcn_readlane(__float_as_int(v), 16)),
                r2 = __int_as_float(__builtin_amdgcn_readlane(__float_as_int(v), 32)), r3 = __int_as_float(__builtin_amdgcn_readlane(__float_as_int(v), 48));
    return (r0 + r1) + (r2 + r3);
}
__device__ __forceinline__ float max8(float v) {
    v = fmaxf(v, DPP_F(v, 0xB1)); v = fmaxf(v, DPP_F(v, 0x4E)); v = fmaxf(v, DPP_F(v, 0x141)); return v;
}
__device__ __forceinline__ unsigned f32_key(float f) { const unsigned b = __float_as_uint(f); return b ^ ((b >> 31) ? 0xffffffffu : 0x80000000u); }
__device__ __forceinline__ void unpack8(const u32x4 w, float (&f)[8]) {
    f[0] = bflo(w.x); f[1] = bfhi(w.x); f[2] = bflo(w.y); f[3] = bfhi(w.y); f[4] = bflo(w.z); f[5] = bfhi(w.z); f[6] = bflo(w.w); f[7] = bfhi(w.w);
}
__device__ __forceinline__ u32x4 pack8(const float (&f)[8]) {
    u32x4 w; w.x = cvt_pk_bf16(f[0], f[1]); w.y = cvt_pk_bf16(f[2], f[3]); w.z = cvt_pk_bf16(f[4], f[5]); w.w = cvt_pk_bf16(f[6], f[7]); return w;
}

__device__ __forceinline__ int lane_id_asm() { int l; asm volatile("v_mbcnt_lo_u32_b32 %0, -1, 0\n\tv_mbcnt_hi_u32_b32 %0, -1, %0" : "=v"(l)); return l; }

__device__ __forceinline__ size_t pj(size_t row, int col) { return ((row >> 8) * (NPJ / 256) + (size_t)(col >> 8)) * 65536 + (row & 255) * 256 + (size_t)(col & 255); }

#define XB_TMO      128
#define XB_XCNT(j)  (256  + 64 * (j))
#define XB_XSUB(j)  (1280 + 64 * (j))
#define XB_XGEN(j)  (2304 + 64 * (j))
#define XB_TOP      3328
#define XB_TOPGEN   3392
#define XCD_BAR_WORDS 3456
#define XB_SPIN_CAP (1u << 18)
__device__ __forceinline__ unsigned xb_ld(unsigned* p)              { return __hip_atomic_load(p, __ATOMIC_RELAXED, __HIP_MEMORY_SCOPE_AGENT); }
__device__ __forceinline__ unsigned xb_add(unsigned* p, unsigned v) { return __hip_atomic_fetch_add(p, v, __ATOMIC_RELAXED, __HIP_MEMORY_SCOPE_AGENT); }
__device__ __forceinline__ unsigned xb_xcc_id() { return (unsigned)__builtin_amdgcn_s_getreg((3 << 11) | 20) & 0xFu; }
#define XB_SPIN(cond, bar) do { unsigned _sp = 0; while (cond) { __builtin_amdgcn_s_sleep(1); \
    if ((++_sp & 255u) == 0u) { if (xb_ld(&(bar)[XB_TMO])) break; if (_sp > XB_SPIN_CAP) { atomicAdd(&(bar)[XB_TMO], 1u); break; } } } } while (0)
struct XcdBarrier { unsigned* bar; unsigned x; volatile LAS unsigned* st; };
__device__ __forceinline__ XcdBarrier xcd_barrier_post(unsigned* bar, volatile LAS unsigned* st) {
    XcdBarrier b; b.bar = bar; b.x = xb_xcc_id(); b.st = st;
    if (threadIdx.x == 0) (void)xb_add(&bar[XB_XCNT(b.x)], 1u);
    return b;
}
__device__ __forceinline__ void xcd_barrier_complete(unsigned* bar, unsigned x, unsigned& nloc, unsigned& nx) {
    const unsigned G = gridDim.x * gridDim.y * gridDim.z;
    unsigned sum, cnt, mine, sp = 0u;
    for (;;) {
        sum = 0u; cnt = 0u; mine = 0u;
#pragma unroll
        for (unsigned j = 0; j < 16; ++j) { const unsigned c = xb_ld(&bar[XB_XCNT(j)]); sum += c; cnt += (c > 0u) ? 1u : 0u; mine = (j == x) ? c : mine; }
        if (sum == G) break;
        __builtin_amdgcn_s_sleep(1);
        if ((++sp & 255u) == 0u) { if (xb_ld(&bar[XB_TMO])) break; if (sp > XB_SPIN_CAP) { atomicAdd(&bar[XB_TMO], 1u); break; } }
    }
    nloc = mine > 0u ? mine : 1u; nx = cnt > 0u ? cnt : 1u;
}
__device__ __forceinline__ void xcd_barrier(const XcdBarrier& b, const int wave) {
    asm volatile("s_waitcnt vmcnt(0)" ::: "memory");
    __syncthreads();
    if (wave == 0 && lane_id_asm() == 0) {
        unsigned* bar = b.bar;
        __builtin_amdgcn_s_waitcnt(0);
        unsigned nloc = b.st[0], nx = b.st[1];
        if (nloc == 0u) { xcd_barrier_complete(bar, b.x, nloc, nx); b.st[0] = nloc; b.st[1] = nx; }
        const unsigned old = xb_add(&bar[XB_XSUB(b.x)], 1u);
        const unsigned gen = old / nloc;
        if (old + 1u == (gen + 1u) * nloc) {
            __builtin_amdgcn_fence(__ATOMIC_RELEASE, "agent");
            asm volatile("s_waitcnt vmcnt(0)" ::: "memory");
            const unsigned og = xb_add(&bar[XB_TOP], 1u);
            const unsigned tg = og / nx;
            if (og + 1u == (tg + 1u) * nx) xb_add(&bar[XB_TOPGEN], 1u);
            else XB_SPIN(xb_ld(&bar[XB_TOPGEN]) == tg, bar);
            __builtin_amdgcn_fence(__ATOMIC_ACQUIRE, "agent");
            xb_add(&bar[XB_XGEN(b.x)], 1u);
            asm volatile("s_waitcnt vmcnt(0)" ::: "memory");
        } else {
            XB_SPIN(xb_ld(&bar[XB_XGEN(b.x)]) == gen, bar);
            __builtin_amdgcn_fence(__ATOMIC_ACQUIRE, "agent");
            asm volatile("s_waitcnt vmcnt(0)" ::: "memory");
        }
    }
    __syncthreads();
}

namespace pg8 {
constexpr int BM = 256, BK = 64, HALF = 128, HTB = HALF * BK * 2, STAGE_BYTES = 8 * HTB, NXCD = 8, WGM = 8;
__host__ __device__ __forceinline__ int lds_byte(int r, int c) { const int st = (r >> 4) * 2 + (c >> 5), rr = r & 15, cc = c & 31, ob = rr * 64 + cc * 2; return st * 1024 + (ob ^ (((ob >> 9) & 1) << 5)); }
__host__ __device__ __forceinline__ void stage_rc(int b, int& R, int& C) { const int st = b / 1024, sb = b % 1024, swz = sb ^ (((sb >> 9) & 1) << 5); R = (st >> 1) * 16 + swz / 64; C = (st & 1) * 32 + (swz % 64) / 2; }
__host__ __device__ __forceinline__ int perm32(int rho) { const int n = rho >> 4, i = rho & 15; return 8 * (i >> 2) + 4 * n + (i & 3); }

struct Unit { int pm, pn, ord; const char* a; const char* b; };

struct PlainOrder {
    static constexpr bool GATHER = false, ARES = false;
    int nM, nN, nwg, G, c; const char* A; const char* Bt; size_t tstep;
    __device__ void init(const void* A_, const void* Bt_, int M, int N, int K, int G_, int c_) { nM = M / BM; nN = N / BM; nwg = nM * nN; G = G_; c = c_; A = (const char*)A_; Bt = (const char*)Bt_; tstep = (size_t)BM * K * 2; }
    __device__ bool next(int i, Unit& u) const {
#if defined(PROBE_PK)
        const long L = (long)(i >> 1) * G + c; if (L >= nwg) return false;
#else
        const long L = (long)i * G + c; if (L >= nwg) return false;
#endif
        int wgid = (int)L; { const int q = nwg / NXCD, r = nwg % NXCD, xcd = wgid % NXCD, off = wgid / NXCD; wgid = (xcd < r ? xcd * (q + 1) : r * (q + 1) + (xcd - r) * q) + off; }
        const int nig = WGM * nN, gid = wgid / nig, fm = gid * WGM, gsz = (nM - fm) < WGM ? (nM - fm) : WGM;
        u.pm = fm + ((wgid % nig) % gsz); u.pn = (wgid % nig) / gsz; u.ord = i; u.a = A + (size_t)u.pm * tstep; u.b = Bt + (size_t)u.pn * tstep; return true;
    }
    __device__ __forceinline__ unsigned aoff(int, int) const { return 0u; }
};
template <int SH, bool TAB> struct MoeOrder {
    static constexpr bool GATHER = true, ARES = false;
    int NT, G, c; const char* A; const char* W; unsigned rowb; size_t w_exp, w_tile; const LAS unsigned char* te; const LAS unsigned* tab;
    __device__ bool next(int i, Unit& u) const {
#if defined(PROBE_GK)
        const int L = (SH == 1 ? (i >> 1) : i) * G + c; const int rt = L >> SH; if (rt >= NT) return false;
#elif defined(PROBE_DK)
        const int L = (SH == 2 ? (i >> 1) : i) * G + c; const int rt = L >> SH; if (rt >= NT) return false;
#else
        const int L = i * G + c; const int rt = L >> SH; if (rt >= NT) return false;
#endif
        u.pm = rt; u.pn = L & ((1 << SH) - 1); u.ord = i; const int e = te[rt];
        u.a = A; u.b = W + (size_t)e * w_exp + (size_t)u.pn * w_tile; return true;
    }
    __device__ __forceinline__ unsigned aoff(int ord, int r) const { if constexpr (TAB) {
#if defined(PROBE_GK)
            return tab[(ord >> 1) * 256 + r];
#else
            return tab[ord * 256 + r];
#endif
        } else return (unsigned)((((ord * G + c) >> SH) << 8) + r) * rowb; }
};

struct MoeOrderD {
    static constexpr bool GATHER = false, ARES = true;
    int NT, G, c; const char* A; const char* W; unsigned rowb; size_t w_exp, w_tile; const LAS unsigned char* te;
    __device__ bool next(int i, Unit& u) const {
        const int Lp = (i >> 1) * G + c; const int rt = Lp >> 1; if (rt >= NT) return false;
        u.pm = rt; u.pn = (Lp & 1) * 2 + (i & 1); u.ord = i; const int e = te[rt];
        u.a = A + (size_t)rt * 256 * rowb; u.b = W + (size_t)e * w_exp + (size_t)u.pn * w_tile; return true;
    }
    __device__ __forceinline__ unsigned aoff(int, int) const { return 0u; }
};
__device__ __forceinline__ const GAS char* uni_ptr(const char* p) { const unsigned long long v = (unsigned long long)p; const unsigned lo = (unsigned)__builtin_amdgcn_readfirstlane((int)(unsigned)v), hi = (unsigned)__builtin_amdgcn_readfirstlane((int)(unsigned)(v >> 32)); return (const GAS char*)(((unsigned long long)hi << 32) | lo); }
template <class Epi, class Sched, bool ALIGN_EPI, bool F8 = false>
__device__ __forceinline__ void gemm_phase(LAS unsigned char* lds, const int wid, const int K, const Sched& S, const Epi& E) {
    const int lane = lane_id_asm(), tid = wid * 64 + lane,
        wr = wid >> 2, wc = wid & 3, fr = lane & 15, fq = lane >> 4;
    const int nt = F8 ? K / 128 : K / BK; const int RB = F8 ? K : 2 * K;
    unsigned voffA[2], voffB[2];
#pragma unroll
    for (int i = 0; i < 2; ++i) { int R, C; stage_rc(tid * 16 + i * 8192, R, C); const int Rb = (int)Epi::PERM == 2 ? (64 * (R >> 5) + 16 * ((R >> 2) & 3) + 4 * ((R >> 4) & 1) + (R & 3)) : (Epi::PERM ? ((R & ~31) + perm32(R & 31)) : R);
        voffA[i] = (unsigned)(R * RB + C * 2); voffB[i] = (unsigned)(Rb * RB + C * 2); }
    const size_t kstep = (size_t)(BK * 2);
    const size_t hstep = (size_t)HALF * RB;
    const size_t hstepB = (int)Epi::PERM == 2 ? (size_t)8 * RB : hstep;
    const unsigned ldsw = (unsigned)wid * 1024u;
    const int aoff = lds_byte(wr * 64 + fr, fq * 8), boff = lds_byte(wc * 32 + fr, fq * 8);
#define PG8_SA(b, h) (((b) * 2 + (h)) * HTB)
#define PG8_SB(b, h) ((4 + (b) * 2 + (h)) * HTB)
    const unsigned ldsbase = (unsigned)(unsigned long long)(const LAS void*)lds;
#define PG8_STAGE(bufoff, gbase, voff) do { _Pragma("unroll") for (int _i = 0; _i < 2; ++_i) { const unsigned m0v_ = ldsbase + (unsigned)(bufoff) + ldsw + (unsigned)_i * 8192u; \
        asm volatile("s_mov_b32 m0, %2\n\ts_nop 0\n\tglobal_load_lds_dwordx4 %0, %1" :: "v"((voff)[_i]), "s"(gbase), "s"(m0v_) : "memory", "m0"); } } while (0)
#define PG8_STAGE_A(bufoff, kb, h, GO) do { if constexpr (Sched::GATHER) { PG8_STAGE(bufoff, kb, GO[h]); } else { PG8_STAGE(bufoff, (kb) + (h) * hstep, voffA); } } while (0)
#define PG8_STAGE_A2(bufoff, kb, h) do { if constexpr (Sched::GATHER) { const unsigned gs_[2] = {last ? gN[h][0] : gC[h][0], last ? gN[h][1] : gC[h][1]}; PG8_STAGE(bufoff, kb, gs_); }     \
        else { PG8_STAGE(bufoff, (kb) + (h) * hstep, voffA); } } while (0)
#define PG8_FR(p) (*(const LAS v4i_*)(p))
#define PG8_LDA(dst, b, h) do { _Pragma("unroll") for (int m = 0; m < 4; ++m) { if constexpr (F8) { dst##8[m] = __builtin_shufflevector(PG8_FR(lds + PG8_SA(b, h) + aoff + m * 2048), PG8_FR(lds + PG8_SA(b, h) + aoff + m * 2048 + 1024), 0, 1, 2, 3, 4, 5, 6, 7); } \
        else { _Pragma("unroll") for (int k = 0; k < 2; ++k) dst[m][k] = *(const LAS bf16x8*)(lds + PG8_SA(b, h) + aoff + m * 2048 + k * 1024); } } } while (0)
#define PG8_LDB(dst, b, h) do { _Pragma("unroll") for (int n = 0; n < 2; ++n) { if constexpr (F8) { dst##8[n] = __builtin_shufflevector(PG8_FR(lds + PG8_SB(b, h) + boff + n * 2048), PG8_FR(lds + PG8_SB(b, h) + boff + n * 2048 + 1024), 0, 1, 2, 3, 4, 5, 6, 7); } \
        else { _Pragma("unroll") for (int k = 0; k < 2; ++k) dst[n][k] = *(const LAS bf16x8*)(lds + PG8_SB(b, h) + boff + n * 2048 + k * 1024); } } } while (0)
#define PG8_MMA(ai, bj, At, Bt) do { __builtin_amdgcn_s_setprio(1); _Pragma("unroll") for (int m = 0; m < 4; ++m) _Pragma("unroll") for (int n = 0; n < 2; ++n) { \
        if constexpr (F8) { acc[ai][bj][m][n] = __builtin_amdgcn_mfma_scale_f32_16x16x128_f8f6f4(Bt##8[n], At##8[m], acc[ai][bj][m][n], 0, 0, 0, 0x7f7f7f7f, 0, Epi::MXSCALE); } \
        else { _Pragma("unroll") for (int k = 0; k < 2; ++k) acc[ai][bj][m][n] = __builtin_amdgcn_mfma_f32_16x16x32_bf16(Bt[n][k], At[m][k], acc[ai][bj][m][n], 0, 0, 0); } } \
        if constexpr (F8) { _Pragma("unroll") for (int m = 0; m < 4; ++m) asm volatile("" : "+v"(acc[ai][bj][m][0]), "+v"(acc[ai][bj][m][1])); }     \
        __builtin_amdgcn_s_setprio(0); } while (0)
#define PG8_MMA0(ai, bj, At, Bt) do { __builtin_amdgcn_s_setprio(1); _Pragma("unroll") for (int m = 0; m < 4; ++m) _Pragma("unroll") for (int n = 0; n < 2; ++n) { \
        if constexpr (F8) { acc[ai][bj][m][n] = __builtin_amdgcn_mfma_scale_f32_16x16x128_f8f6f4(Bt##8[n], At##8[m], (f32x4){0.f, 0.f, 0.f, 0.f}, 0, 0, 0, 0x7f7f7f7f, 0, Epi::MXSCALE); } \
        else { acc[ai][bj][m][n] = __builtin_amdgcn_mfma_f32_16x16x32_bf16(Bt[n][0], At[m][0], (f32x4){0.f, 0.f, 0.f, 0.f}, 0, 0, 0); acc[ai][bj][m][n] = __builtin_amdgcn_mfma_f32_16x16x32_bf16(Bt[n][1], At[m][1], acc[ai][bj][m][n], 0, 0, 0); } } \
        if constexpr (F8) { _Pragma("unroll") for (int m = 0; m < 4; ++m) asm volatile("" : "+v"(acc[ai][bj][m][0]), "+v"(acc[ai][bj][m][1])); } \
        __builtin_amdgcn_s_setprio(0); } while (0)
#define PG8_MMAX(ai, bj, At, Bt) do { if constexpr (ZF) { PG8_MMA0(ai, bj, At, Bt); } else { PG8_MMA(ai, bj, At, Bt); } } while (0)
#define PG8_WAIT_V(n) asm volatile("s_waitcnt vmcnt(" #n ")" ::: "memory")
#define PG8_WAIT_L(n) asm volatile("s_waitcnt lgkmcnt(" #n ")" ::: "memory")
#define PG8_WAIT_VR(relax) do { if (relax) asm volatile("s_waitcnt vmcnt(%0)" :: "n"(8 + Epi::NSTORE) : "memory"); else asm volatile("s_waitcnt vmcnt(8)" ::: "memory"); } while (0)
#define PG8_BAR do { __builtin_amdgcn_s_barrier(); if constexpr (F8) asm volatile("" ::: "memory"); } while (0)
#define PG8_SCHED __builtin_amdgcn_sched_barrier(0)
#define PG8_GLOAD(G_, u_) do { if constexpr (Sched::GATHER) { _Pragma("unroll") for (int _i = 0; _i < 2; ++_i) { int R_, C_; stage_rc(tid * 16 + _i * 8192, R_, C_); _Pragma("unroll") for (int _h = 0; _h < 2; ++_h) G_[_h][_i] = S.aoff((u_).ord, _h * HALF + R_) + (unsigned)C_ * 2u; } } } while (0)
    Unit cur, nxt;
    if (!S.next(0, cur)) return;
    f32x4 acc[2][2][4][2];
#pragma unroll
    for (int a = 0; a < 2; ++a)
#pragma unroll
        for (int b = 0; b < 2; ++b)
#pragma unroll
            for (int m = 0; m < 4; ++m)
#pragma unroll
                for (int n = 0; n < 2; ++n) acc[a][b][m][n] = (f32x4){0.f, 0.f, 0.f, 0.f};
    typedef int v4i_ __attribute__((ext_vector_type(4))); typedef int v8i_ __attribute__((ext_vector_type(8)));
    bf16x8 At[4][2], B0[2][2], B1[2][2];
    v8i_ At8[4], B08[2], B18[2];
    unsigned gC[2][2] = {{0u, 0u}, {0u, 0u}}, gN[2][2] = {{0u, 0u}, {0u, 0u}};
    u32x4 pw[8]; unsigned char* pdst = nullptr;
    if constexpr (Epi::DEFER) { pdst = E.addr0(wid);
#pragma unroll
        for (int j = 0; j < 8; ++j) pw[j] = (u32x4){0u, 0u, 0u, 0u}; }
    PG8_GLOAD(gC, cur);
    const GAS char* cA = uni_ptr(cur.a); const GAS char* cB = uni_ptr(cur.b);
    PG8_STAGE(PG8_SB(0, 0), cB, voffB); PG8_STAGE(PG8_SB(0, 1), cB + hstepB, voffB); PG8_STAGE_A(PG8_SA(0, 0), cA, 0, gC); PG8_STAGE_A(PG8_SA(0, 1), cA, 1, gC);
    if (wr == 1) PG8_BAR;
    PG8_WAIT_V(2); PG8_BAR;
    PG8_STAGE(PG8_SB(1, 0), cB + kstep, voffB); PG8_STAGE_A(PG8_SA(1, 0), cA + kstep, 0, gC); PG8_STAGE(PG8_SB(1, 1), cB + hstepB + kstep, voffB);
    PG8_WAIT_V(6); PG8_BAR;
    int ui = 0;
    for (;;) {
        const bool has_next = S.next(ui + 1, nxt);
        const GAS char* nA = has_next ? uni_ptr(nxt.a) : cA; const GAS char* nB = has_next ? uni_ptr(nxt.b) : cB;
        if constexpr (Sched::GATHER) { if (has_next) { PG8_GLOAD(gN, nxt); } else {
#pragma unroll
            for (int _h = 0; _h < 2; ++_h)
#pragma unroll
                for (int _i = 0; _i < 2; ++_i) gN[_h][_i] = gC[_h][_i]; } }
        const bool stA = !Sched::ARES || (ui & 1);
        auto kbody = [&](auto zflag_, const int t) __attribute__((always_inline)) { constexpr bool ZF = decltype(zflag_)::value;
            const bool last = (t == nt - 2);
            const GAS char* a1 = cA + (size_t)(t + 1) * kstep;
            const GAS char* a2 = last ? nA : cA + (size_t)(t + 2) * kstep; const GAS char* b2 = last ? nB : cB + (size_t)(t + 2) * kstep;
            const GAS char* a3 = a2 + kstep; const GAS char* b3 = b2 + kstep;
            if constexpr (Epi::HAS_MID) { if (t == nt / 2) E.mid(acc, cur, wr, fr); }
            const bool relax = Epi::NSTORE > 0 && t == 0 && ui > 0;
#define PG8_DEF(j0) do { if constexpr (Epi::DEFER) E.st2(pdst, pw, j0); } while (0)
#define PG8_WAIT_D(wn, wy, alt) do { if constexpr (Epi::DEFER) { if (ui > 0) { if constexpr (Sched::ARES) { if (stA) asm volatile("s_waitcnt vmcnt(" #wy ")" ::: "memory"); else asm volatile("s_waitcnt vmcnt(" #wn ")" ::: "memory"); } \
                else asm volatile("s_waitcnt vmcnt(14)" ::: "memory"); } else asm volatile("s_waitcnt vmcnt(8)" ::: "memory"); } else { alt; } } while (0)
            PG8_LDB(B0, 0, 0); PG8_LDB(B1, 0, 1); PG8_SCHED; PG8_LDA(At, 0, 0); if (!relax) PG8_STAGE_A(PG8_SA(1, 1), a1, 1, gC);
            PG8_DEF(0); PG8_WAIT_D(14, 10, PG8_WAIT_VR(relax)); PG8_WAIT_L(0); PG8_BAR; PG8_MMAX(0, 0, At, B0); PG8_MMAX(0, 1, At, B1); PG8_BAR; PG8_SCHED;
            PG8_LDA(At, 0, 1); PG8_STAGE(PG8_SB(0, 0), b2, voffB); PG8_STAGE(PG8_SB(0, 1), b2 + hstepB, voffB); if (stA) PG8_STAGE_A2(PG8_SA(0, 0), a2, 0);
            PG8_DEF(2); PG8_WAIT_D(12, 12, PG8_WAIT_VR(relax)); PG8_WAIT_L(0); PG8_BAR; PG8_MMAX(1, 0, At, B0); PG8_MMAX(1, 1, At, B1); PG8_BAR; PG8_SCHED;
            PG8_LDB(B0, 1, 0); PG8_LDB(B1, 1, 1); PG8_SCHED; PG8_LDA(At, 1, 0); if (stA) PG8_STAGE_A2(PG8_SA(0, 1), a2, 1);
            PG8_DEF(4); PG8_WAIT_D(10, 14, PG8_WAIT_VR(relax)); PG8_WAIT_L(0); PG8_BAR; PG8_MMA(0, 0, At, B0); PG8_MMA(0, 1, At, B1); PG8_BAR; PG8_SCHED;
            PG8_LDA(At, 1, 1); PG8_STAGE(PG8_SB(1, 0), b3, voffB); PG8_STAGE(PG8_SB(1, 1), b3 + hstepB, voffB); if (stA) PG8_STAGE_A2(PG8_SA(1, 0), a3, 0);
            PG8_DEF(6); PG8_WAIT_D(10, 14, PG8_WAIT_V(8)); PG8_WAIT_L(0); PG8_BAR; PG8_MMA(1, 0, At, B0); PG8_MMA(1, 1, At, B1);
            if constexpr (Epi::DEFER) { if (last) E.pack_half(acc, pw, 0); }
            PG8_BAR; PG8_SCHED;
#undef PG8_DEF
#undef PG8_WAIT_D
        };
        if constexpr (Epi::PEEL) { kbody(std::true_type{}, 0);
#pragma unroll 1
            for (int t = 2; t < nt; t += 2) kbody(std::false_type{}, t); }
        else {
#pragma unroll 1
            for (int t = 0; t < nt; t += 2) kbody(std::false_type{}, t); }
        if constexpr (Epi::NSTORE > 0) { if (has_next && stA) PG8_STAGE_A(PG8_SA(1, 1), nA + kstep, 1, gN); }
        if constexpr (ALIGN_EPI) { if (wr == 0) PG8_BAR; }
        if constexpr (Epi::DEFER) { E.pack_half(acc, pw, 1); pdst = E.addr(cur, wr, wc);
            if (!has_next) { E.st2(pdst, pw, 0); E.st2(pdst, pw, 2); E.st2(pdst, pw, 4); E.st2(pdst, pw, 6); } }
        else E(acc, cur, wr, wc, fr, fq);
        if (!has_next) break;
        if constexpr (!Epi::PEEL) {
            typedef double f64x2_ __attribute__((ext_vector_type(2)));
#pragma unroll
            for (int a = 0; a < 2; ++a)
#pragma unroll
                for (int b = 0; b < 2; ++b)
#pragma unroll
                    for (int m = 0; m < 4; ++m)
#pragma unroll
                        for (int n = 0; n < 2; ++n) { double z0, z1; asm volatile("v_mov_b64 %0, 0\n\tv_mov_b64 %1, 0" : "=v"(z0), "=v"(z1)); acc[a][b][m][n] = __builtin_bit_cast(f32x4, (f64x2_){z0, z1}); }
        }
        cur = nxt; cA = nA; cB = nB; ++ui;
#pragma unroll
        for (int _h = 0; _h < 2; ++_h)
#pragma unroll
            for (int _i = 0; _i < 2; ++_i) gC[_h][_i] = gN[_h][_i];
        if constexpr (ALIGN_EPI) { if (wr == 1) PG8_BAR; }
    }
    PG8_WAIT_V(0);
    if constexpr (!ALIGN_EPI) { if (wr == 0) PG8_BAR; }
    PG8_BAR;
#undef PG8_SA
#undef PG8_SB
#undef PG8_STAGE
#undef PG8_STAGE_A
#undef PG8_STAGE_A2
#undef PG8_LDA
#undef PG8_FR
#undef PG8_LDB
#undef PG8_MMA
#undef PG8_MMA0
#undef PG8_MMAX
#undef PG8_WAIT_V
#undef PG8_WAIT_L
#undef PG8_WAIT_VR
#undef PG8_BAR
#undef PG8_SCHED
#undef PG8_GLOAD
}

struct EpiBf16 {
    static constexpr bool PERM = true, HAS_MID = false; static constexpr int NSTORE = 16;
    static constexpr bool PEEL = true;
    static constexpr bool DEFER = false;
    static constexpr int MXSCALE = 0x7f7f7f7f;
    bf16* O; int ldc;
    __device__ __forceinline__ void operator()(const f32x4 (&acc)[2][2][4][2], const Unit& u, int wr, int wc, int fr, int fq) const {
#if defined(PROBE_PK)
        if ((u.ord & 1) == 0) return;
#endif
        const int row0 = u.pm * BM + wr * 64 + fr, col0 = u.pn * BM + wc * 32 + 8 * fq;
#pragma unroll
        for (int ai = 0; ai < 2; ++ai)
#pragma unroll
            for (int m = 0; m < 4; ++m) { bf16* rowp = O + (size_t)(row0 + ai * HALF + m * 16) * ldc + col0;
#pragma unroll
                for (int bj = 0; bj < 2; ++bj) { const f32x4 v0 = acc[ai][bj][m][0], v1 = acc[ai][bj][m][1];
                    u32x4 w; w.x = cvt_pk_bf16(v0[0], v0[1]); w.y = cvt_pk_bf16(v0[2], v0[3]); w.z = cvt_pk_bf16(v1[0], v1[1]); w.w = cvt_pk_bf16(v1[2], v1[3]);
                    *(u32x4*)(rowp + bj * HALF) = w; } }
    }
};
struct EpiBf16T {
    static constexpr bool PERM = true, HAS_MID = false; static constexpr int NSTORE = 16;
    static constexpr bool PEEL = true;
    static constexpr bool DEFER = false;
    static constexpr int MXSCALE = 0x7f7f7f7f;
    bf16* O; int ntn;
    __device__ __forceinline__ void operator()(const f32x4 (&acc)[2][2][4][2], const Unit& u, int wr, int wc, int fr, int fq) const {
        if (u.pn >= 2 && u.pn < 6) {
            bf16* tile = O + ((size_t)u.pm * ntn + 2 + ((u.pn - 2) >> 1)) * 65536 + (wr * 64 + fr) * 256 + ((u.pn - 2) & 1) * HALF + wc * 16 + 4 * fq;
#pragma unroll
            for (int ai = 0; ai < 2; ++ai)
#pragma unroll
                for (int m = 0; m < 4; ++m) { bf16* rowp = tile + (ai * HALF + m * 16) * 256;
#pragma unroll
                    for (int bj = 0; bj < 2; ++bj) { const f32x4 v0 = acc[ai][bj][m][0], v1 = acc[ai][bj][m][1];
                        u32x2 w; w.x = cvt_pk_bf16(v0[0] * v0[1], v0[2] * v0[3]); w.y = cvt_pk_bf16(v1[0] * v1[1], v1[2] * v1[3]);
                        *(u32x2*)(rowp + bj * 64) = w; } }
            return; }
        const int l_ = lane_id_asm(), fr_ = l_ & 15, fq_ = l_ >> 4;
        bf16* tile = O + ((size_t)u.pm * ntn + (u.pn < 2 ? u.pn : u.pn - 2)) * 65536 + (wr * 64 + fr_) * 256 + wc * 32 + 8 * fq_;
#pragma unroll
        for (int ai = 0; ai < 2; ++ai)
#pragma unroll
            for (int m = 0; m < 4; ++m) { bf16* rowp = tile + (ai * HALF + m * 16) * 256;
#pragma unroll
                for (int bj = 0; bj < 2; ++bj) { const f32x4 v0 = acc[ai][bj][m][0], v1 = acc[ai][bj][m][1];
                    u32x4 w; w.x = cvt_pk_bf16(v0[0], v0[1]); w.y = cvt_pk_bf16(v0[2], v0[3]); w.z = cvt_pk_bf16(v1[0], v1[1]); w.w = cvt_pk_bf16(v1[2], v1[3]);
                    *(u32x4*)(rowp + bj * HALF) = w; } }
    }
};
struct EpiGU {
    static constexpr bool PERM = true, HAS_MID = false; static constexpr int NSTORE = 8;
    static constexpr bool PEEL = false;
    static constexpr bool DEFER = false;
    static constexpr int MXSCALE = 0x7f7f7f7f;
    unsigned char* H;
    __device__ __forceinline__ void operator()(const f32x4 (&acc)[2][2][4][2], const Unit& u, int wr, int wc, int fr, int fq) const {
#if defined(PROBE_GK)
        if ((u.ord & 1) == 0) return;
#endif
        const int row0 = u.pm * BM + wr * 64 + fr, col0 = u.pn * HALF + wc * 32 + 8 * fq;
#pragma unroll
        for (int ai = 0; ai < 2; ++ai)
#pragma unroll
            for (int m = 0; m < 4; ++m) { unsigned char* rowp = H + (size_t)(row0 + ai * HALF + m * 16) * 256 + col0;
                float h[8];
#pragma unroll
                for (int n = 0; n < 2; ++n)
#pragma unroll
                    for (int i = 0; i < 4; i += 2) {
                        const f32x2 g = (f32x2){acc[ai][0][m][n][i], acc[ai][0][m][n][i + 1]}, u = (f32x2){acc[ai][1][m][n][i], acc[ai][1][m][n][i + 1]};
                        const f32x2 t = g * (-1.4426950408889634f / 64.0f); const f32x2 e = (f32x2){__builtin_amdgcn_exp2f(t.x), __builtin_amdgcn_exp2f(t.y)};
                        const f32x2 d = e * 1024.0f + 1024.0f;
                        const f32x2 r = (f32x2){__builtin_amdgcn_rcpf(d.x), __builtin_amdgcn_rcpf(d.y)}; const f32x2 hh = (g * u) * r;
                        h[4 * n + i] = hh.x; h[4 * n + i + 1] = hh.y; }
                int lo = __builtin_amdgcn_cvt_pk_fp8_f32(h[0], h[1], 0, false); lo = __builtin_amdgcn_cvt_pk_fp8_f32(h[2], h[3], lo, true);
                int hi = __builtin_amdgcn_cvt_pk_fp8_f32(h[4], h[5], 0, false); hi = __builtin_amdgcn_cvt_pk_fp8_f32(h[6], h[7], hi, true);
                *(u32x2*)rowp = (u32x2){(unsigned)lo, (unsigned)hi}; }
    }
};
struct EpiFp8 {
    static constexpr int PERM = 2; static constexpr bool HAS_MID = false; static constexpr int NSTORE = 8;
    static constexpr bool PEEL = false;
    static constexpr bool DEFER = true;
    static constexpr int MXSCALE = 0x7b7b7b7b;
    unsigned char* O; int ldc; float sc; unsigned char* dump;
    __device__ __forceinline__ void pack_half(const f32x4 (&acc)[2][2][4][2], u32x4 (&pw)[8], const int ai) const {
        {
#pragma unroll
            for (int m = 0; m < 4; ++m) { u32x4 w;
#pragma unroll
                for (int bj = 0; bj < 2; ++bj) { const f32x4 v0 = acc[ai][bj][m][0], v1 = acc[ai][bj][m][1];
                    int lo = __builtin_amdgcn_cvt_pk_fp8_f32(v0[0], v0[1], 0, false); lo = __builtin_amdgcn_cvt_pk_fp8_f32(v0[2], v0[3], lo, true);
                    int hi = __builtin_amdgcn_cvt_pk_fp8_f32(v1[0], v1[1], 0, false); hi = __builtin_amdgcn_cvt_pk_fp8_f32(v1[2], v1[3], hi, true);
                    if (bj == 0) { w.x = (unsigned)lo; w.y = (unsigned)hi; } else { w.z = (unsigned)lo; w.w = (unsigned)hi; } }
                pw[ai * 4 + m] = w; }
        }
    }
    __device__ __forceinline__ unsigned char* addr(const Unit& u, int wr, int wc) const { const int l_ = lane_id_asm(), fr = l_ & 15, fq = l_ >> 4;
        return O + (size_t)(u.pm * BM + wr * 64 + fr) * ldc + u.pn * BM + wc * 64 + 16 * fq; }
    __device__ __forceinline__ unsigned char* addr0(int wid) const { return dump + ((size_t)blockIdx.x * 512 + (size_t)(wid * 64 + lane_id_asm())) * 16; }
    __device__ __forceinline__ void st2(unsigned char* p, const u32x4 (&pw)[8], int j0) const {
#pragma unroll
        for (int j = j0; j < j0 + 2; ++j) *(u32x4*)(p + (size_t)((j >> 2) * HALF + (j & 3) * 16) * ldc) = pw[j]; }
    __device__ __forceinline__ void operator()(const f32x4 (&acc)[2][2][4][2], const Unit& u, int wr, int wc, int fr, int fq) const {
        const int row0 = u.pm * BM + wr * 64 + fr, col0 = u.pn * BM + wc * 64 + 16 * fq;
#pragma unroll
        for (int ai = 0; ai < 2; ++ai)
#pragma unroll
            for (int m = 0; m < 4; ++m) { u32x4 w;
#pragma unroll
                for (int bj = 0; bj < 2; ++bj) { const f32x4 v0 = acc[ai][bj][m][0], v1 = acc[ai][bj][m][1];
                    int lo = __builtin_amdgcn_cvt_pk_fp8_f32(v0[0], v0[1], 0, false); lo = __builtin_amdgcn_cvt_pk_fp8_f32(v0[2], v0[3], lo, true);
                    int hi = __builtin_amdgcn_cvt_pk_fp8_f32(v1[0], v1[1], 0, false); hi = __builtin_amdgcn_cvt_pk_fp8_f32(v1[2], v1[3], hi, true);
                    if (bj == 0) { w.x = (unsigned)lo; w.y = (unsigned)hi; } else { w.z = (unsigned)lo; w.w = (unsigned)hi; } }
                *(u32x4*)(O + (size_t)(row0 + ai * HALF + m * 16) * ldc + col0) = w; }
    }
};
struct EpiX1 {
    static constexpr bool PERM = true, HAS_MID = true; static constexpr int NSTORE = 0;
    static constexpr bool PEEL = true;
    static constexpr bool DEFER = false;
    static constexpr int MXSCALE = 0x7f7f7f7f;
    const float* x; bf16* o; const float* g1; const LAS float* rstab;
    __device__ __forceinline__ void mid(f32x4 (&acc)[2][2][4][2], const Unit& u, int wr, int fr) const {
#pragma unroll
        for (int ai = 0; ai < 2; ++ai)
#pragma unroll
            for (int m = 0; m < 4; ++m) { const float rs = rstab[u.ord * 256 + ai * HALF + wr * 64 + m * 16 + fr];
#pragma unroll
                for (int bj = 0; bj < 2; ++bj)
#pragma unroll
                    for (int n = 0; n < 2; ++n) acc[ai][bj][m][n] = acc[ai][bj][m][n] * rs; }
    }
    __device__ __forceinline__ void operator()(const f32x4 (&acc)[2][2][4][2], const Unit& u, int wr, int wc, int fr, int fq) const {
        const int row0 = u.pm * BM + wr * 64 + fr, col0 = u.pn * BM + wc * 32 + 8 * fq; const int b = (u.pm * BM) / SEQ;
        f32x4 gv[2][2];
#pragma unroll
        for (int bj = 0; bj < 2; ++bj)
#pragma unroll
            for (int n = 0; n < 2; ++n) gv[bj][n] = *(const f32x4*)(g1 + (size_t)b * 6144 + col0 + bj * HALF + 4 * n);
#pragma unroll
        for (int ai = 0; ai < 2; ++ai) {
            f32x4 xv[4][2][2];
#pragma unroll
            for (int m = 0; m < 4; ++m)
#pragma unroll
                for (int bj = 0; bj < 2; ++bj)
#pragma unroll
                    for (int n = 0; n < 2; ++n) xv[m][bj][n] = __builtin_nontemporal_load((const f32x4*)(x + (size_t)(row0 + ai * HALF + m * 16) * D + col0 + bj * HALF + 4 * n));
#pragma unroll
            for (int m = 0; m < 4; ++m)
#pragma unroll
                for (int bj = 0; bj < 2; ++bj) { const f32x4 v0 = xv[m][bj][0] + gv[bj][0] * acc[ai][bj][m][0], v1 = xv[m][bj][1] + gv[bj][1] * acc[ai][bj][m][1];
                    u32x4 w; w.x = cvt_pk_bf16(v0[0], v0[1]); w.y = cvt_pk_bf16(v0[2], v0[3]); w.z = cvt_pk_bf16(v1[0], v1[1]); w.w = cvt_pk_bf16(v1[2], v1[3]);
                    *(u32x4*)(o + (size_t)(row0 + ai * HALF + m * 16) * D + col0 + bj * HALF) = w; }
            asm volatile("" ::: "memory"); }
    }
};
struct EpiLogits {
    static constexpr bool PERM = false, HAS_MID = false; static constexpr int NSTORE = 0;
    static constexpr bool PEEL = false;
    static constexpr bool DEFER = false;
    static constexpr int MXSCALE = 0x7f7f7f7f;
    float* L;
    __device__ __forceinline__ void operator()(const f32x4 (&acc)[2][2][4][2], const Unit& u, int wr, int wc, int fr, int fq) const {
        if (wc < 2 && u.pn == 0) {
            const int row0 = u.pm * BM + wr * 64 + fr, col0 = wc * 32 + 4 * fq;
#pragma unroll
            for (int ai = 0; ai < 2; ++ai)
#pragma unroll
                for (int m = 0; m < 4; ++m)
#pragma unroll
                    for (int n = 0; n < 2; ++n) *(f32x4*)(L + (size_t)(row0 + ai * HALF + m * 16) * 64 + col0 + n * 16) = acc[ai][0][m][n];
        }
    }
};
}

struct Args { const float* in[24]; float* out; unsigned char* ws; int ph_lo, ph_hi; };
typedef const Args __attribute__((address_space(4))) CArgs;
#define ARGS_LAUNDER(src_) CArgs* ap_ = &(src_); asm volatile("" : "+s"(ap_)); CArgs& args = *ap_
struct Frame {
    LAS unsigned char* lds; volatile LAS unsigned* MISC; unsigned* ctl;
    int tid, lane, wave, vcu, G;
};

struct TrIt { const float* src; unsigned char* dst; const float* ks; int ldw, ldk, useks, f8; };
__device__ __forceinline__ void tr_load(const TrIt& t, f32x4 (&tv)[8], float (&tk)[8], int lane) {
#pragma unroll
    for (int i = 0; i < 8; ++i) { const int kk = 8 * i + (lane >> 3), n4 = 4 * (lane & 7); tv[i] = __builtin_nontemporal_load((const f32x4*)(t.src + (size_t)kk * t.ldw + n4)); tk[i] = t.ks[kk]; }
}
__device__ __forceinline__ void tr_store(const TrIt& t, const f32x4 (&tv)[8], const float (&tk)[8], LAS float* scr, int lane) {
#pragma unroll
    for (int i = 0; i < 8; ++i) { const int kk = 8 * i + (lane >> 3), n4 = 4 * (lane & 7); const f32x4 v = tv[i] * (t.useks ? tk[i] : 1.0f);
        LAS float* d = scr + kk * 33 + n4; d[0] = v.x; d[1] = v.y; d[2] = v.z; d[3] = v.w; }
    LDS_WAIT(); asm volatile("" ::: "memory");
    const int c = lane & 7;
#pragma unroll
    for (int j = 0; j < 4; ++j) { const int n = (lane >> 3) + 8 * j; const LAS float* s = scr + (8 * c) * 33 + n;
        if (t.f8) {
            int lo = __builtin_amdgcn_cvt_pk_fp8_f32(s[0 * 33] * 64.f, s[1 * 33] * 64.f, 0, false); lo = __builtin_amdgcn_cvt_pk_fp8_f32(s[2 * 33] * 64.f, s[3 * 33] * 64.f, lo, true);
            int hi = __builtin_amdgcn_cvt_pk_fp8_f32(s[4 * 33] * 64.f, s[5 * 33] * 64.f, 0, false); hi = __builtin_amdgcn_cvt_pk_fp8_f32(s[6 * 33] * 64.f, s[7 * 33] * 64.f, hi, true);
            *(u32x2*)(t.dst + (size_t)n * t.ldk + 8 * c) = (u32x2){(unsigned)lo, (unsigned)hi};
        } else {
            u32x4 o; o.x = cvt_pk_bf16(s[0 * 33], s[1 * 33]); o.y = cvt_pk_bf16(s[2 * 33], s[3 * 33]); o.z = cvt_pk_bf16(s[4 * 33], s[5 * 33]); o.w = cvt_pk_bf16(s[6 * 33], s[7 * 33]);
            *(u32x4*)(t.dst + ((size_t)n * t.ldk + 8 * c) * 2) = o; } }
    LDS_WAIT(); asm volatile("" ::: "memory");
}
__device__ __forceinline__ void p0_prologue(const Frame& F_, CArgs& args_) {
    Frame F = F_; F.lane = lane_id_asm(); F.tid = F.wave * 64 + F.lane;
    ARGS_LAUNDER(args_);
    const int gw = F.vcu * 8 + F.wave, NGW = F.G * 8, lane = F.lane;
    for (int cg = F.vcu; cg < 96; cg += F.G) {
        const int j = cg * 64 + lane, k0 = F.wave * 128;
        float acc[16];
#pragma unroll
        for (int b = 0; b < 16; ++b) acc[b] = 0.f;
        LAS float* cl = (LAS float*)(F.lds + 32768 + F.wave * 8192);
        float cq[32], wA[32], wB[32];
#pragma unroll
        for (int b = 0; b < 16; ++b)
#pragma unroll
            for (int h = 0; h < 2; ++h) cq[2 * b + h] = (args.in[1])[b * 1024 + k0 + 64 * h + lane];
        const float* wp = (args.in[2]) + (size_t)k0 * 6144 + j;
#define P0_WLOAD(dst, kb_) do { _Pragma("unroll") for (int kk = 0; kk < 32; ++kk) dst[kk] = __builtin_nontemporal_load(wp + (size_t)((kb_) + kk) * 6144); } while (0)
#define P0_WFMA(src, kb_) do { _Pragma("unroll") for (int kk = 0; kk < 32; ++kk) { _Pragma("unroll") for (int q4 = 0; q4 < 4; ++q4) { const f32x4 c4 = *(const LAS f32x4*)(cl + ((kb_) + kk) * 16 + 4 * q4); \
            acc[4 * q4] += c4.x * src[kk]; acc[4 * q4 + 1] += c4.y * src[kk]; acc[4 * q4 + 2] += c4.z * src[kk]; acc[4 * q4 + 3] += c4.w * src[kk]; } } } while (0)
        P0_WLOAD(wA, 0); P0_WLOAD(wB, 32);
#pragma unroll
        for (int b = 0; b < 16; ++b)
#pragma unroll
            for (int h = 0; h < 2; ++h) cl[(64 * h + lane) * 16 + b] = cq[2 * b + h];
        LDS_WAIT(); asm volatile("" ::: "memory");
        P0_WFMA(wA, 0);  P0_WLOAD(wA, 64);
        P0_WFMA(wB, 32); P0_WLOAD(wB, 96);
        P0_WFMA(wA, 64); P0_WFMA(wB, 96);
#undef P0_WLOAD
#undef P0_WFMA
        LDS_WAIT(); asm volatile("" ::: "memory");
        LAS float* part = (LAS float*)F.lds;
#pragma unroll
        for (int b = 0; b < 16; ++b) part[(F.wave * 16 + b) * 64 + lane] = acc[b];
        WG_BAR();
        for (int o = F.tid; o < 1024; o += 512) { const int b = o >> 6, jj = o & 63; float s = (args.in[3])[cg * 64 + jj];
#pragma unroll
            for (int w = 0; w < 8; ++w) s += part[(w * 16 + b) * 64 + jj];
            ((float*)(args.ws + WS_MOD))[b * 6144 + cg * 64 + jj] = s; }
        WG_BAR();
    }
    LAS float* scr = (LAS float*)(F.lds + F.wave * 16384);
    constexpr int I_IN = 16 * 96, I_OUT = 16 * 32, I_E = NEX * 128;
    constexpr int NITEMS = I_IN + I_OUT + 3 * I_E;
    auto decode = [&](int it) -> TrIt { TrIt t; t.useks = 0; t.ks = (args.in[12]); t.f8 = 0; int r = it;
        if (r < I_IN) { const int kb = r / 96, nb = r % 96; t.src = (args.in[5]) + (size_t)(kb * 64) * LDWIN + nb * 32; t.ldw = LDWIN; { const int n0 = nb * 32; int drow = n0, dstr = 1;
              if (n0 >= 512 && n0 < 1024) { drow = 512 + 2 * (n0 - 512); dstr = 2; } else if (n0 >= 1024 && n0 < 1536) { drow = 513 + 2 * (n0 - 1024); dstr = 2; }
              t.dst = (unsigned char*)(((bf16*)(args.ws + WS_WIN)) + (size_t)drow * 1024 + kb * 64); t.ldk = 1024 * dstr; } return t; } r -= I_IN;
        if (r < I_OUT) { const int kb = r / 32, nb = r % 32, k0 = kb * 64; const int dc = k0 < 512 ? k0 + 512 : k0 - 512;
            t.src = (args.in[13]) + (size_t)k0 * 1024 + nb * 32; t.ldw = 1024; t.dst = (unsigned char*)(((bf16*)(args.ws + WS_WOUT)) + (size_t)(nb * 32) * 1024 + dc); t.ldk = 1024; if (k0 >= 512) { t.useks = 1; t.ks = (args.in[12]) + (k0 - 512); } return t; } r -= I_OUT;
        t.f8 = 1;
        if (r < 2 * I_E) { const int up = r >= I_E; if (up) r -= I_E; const int e = r / 128, q = r % 128, kb = q / 8, nb = q % 8, n0 = nb * 32;
            const float* W = up ? (e < NE ? (args.in[18]) + (size_t)e * 262144 : (args.in[21])) : (e < NE ? (args.in[17]) + (size_t)e * 262144 : (args.in[20]));
            const int drow = (n0 / 128) * 256 + up * 128 + (n0 % 128);
            t.src = W + (size_t)(kb * 64) * 256 + n0; t.ldw = 256; t.dst = (unsigned char*)(args.ws + WS_WGU) + ((size_t)e * 512 + drow) * 1024 + kb * 64; t.ldk = 1024; return t; } r -= 2 * I_E;
        { const int e = r / 128, q = r % 128, kb = q / 32, nb = q % 32; const float* W = e < NE ? (args.in[19]) + (size_t)e * 262144 : (args.in[22]);
            t.src = W + (size_t)(kb * 64) * 1024 + nb * 32; t.ldw = 1024; t.dst = (unsigned char*)(args.ws + WS_WD) + ((size_t)e * 1024 + nb * 32) * 256 + kb * 64; t.ldk = 256; return t; } };
    if (gw < NITEMS) {
        TrIt nA = decode(gw), nB = decode(gw + NGW < NITEMS ? gw + NGW : gw); f32x4 vA[8], vB[8]; float kA[8], kB[8];
        tr_load(nA, vA, kA, lane); tr_load(nB, vB, kB, lane);
#pragma unroll 1
        for (int it = gw; it < NITEMS; it += 2 * NGW) {
            { const TrIt cur = nA; f32x4 cv[8]; float ck[8];
#pragma unroll
              for (int i = 0; i < 8; ++i) { cv[i] = vA[i]; ck[i] = kA[i]; }
              nA = decode(it + 2 * NGW < NITEMS ? it + 2 * NGW : it);
              tr_load(nA, vA, kA, lane);
              tr_store(cur, cv, ck, scr, lane); }
            if (it + NGW < NITEMS) { const TrIt cur = nB; f32x4 cv[8]; float ck[8];
#pragma unroll
              for (int i = 0; i < 8; ++i) { cv[i] = vB[i]; ck[i] = kB[i]; }
              nB = decode(it + 3 * NGW < NITEMS ? it + 3 * NGW : it);
              tr_load(nB, vB, kB, lane);
              tr_store(cur, cv, ck, scr, lane); }
        }
    }
    for (int e = blockIdx.x * 512 + F.tid; e < 4096; e += F.G * 512) { const int p = e >> 3, hh = e & 7;
        ((unsigned*)(args.ws + WS_WDT))[e] = cvt_pk_bf16((args.in[5])[(size_t)(2 * p) * LDWIN + NPROJ + hh], (args.in[5])[(size_t)(2 * p + 1) * LDWIN + NPROJ + hh]); }
}

template <bool WITH_DT, bool XBF>
__device__ __forceinline__ void p_norm_mod(const Frame& F_, CArgs& args_, const void* xin_, const float* gain, int shift_off, int scale_off, bf16* hout, unsigned char* h8out) {
    Frame F = F_; F.lane = lane_id_asm(); F.tid = F.wave * 64 + F.lane;
    ARGS_LAUNDER(args_);
    const int gw = F.vcu * 8 + F.wave, NGW = F.G * 8, lane = F.lane;
    for (int blk = gw; blk < T / 32; blk += NGW) {
        const int row0 = blk * 32, b = row0 / SEQ;
        f32x4 sc[4], sh[4];
#pragma unroll
        for (int j = 0; j < 4; ++j) { const int col = 4 * lane + 256 * j; const f32x4 g = *(const f32x4*)(gain + col); const f32x4 s1 = *(const f32x4*)(((float*)(args.ws + WS_MOD)) + b * 6144 + scale_off + col);
            sc[j] = g * (s1 + 1.0f); sh[j] = *(const f32x4*)(((float*)(args.ws + WS_MOD)) + b * 6144 + shift_off + col); }
        unsigned wdt[WITH_DT ? 4 : 1][2][WITH_DT ? 8 : 1];
        if constexpr (WITH_DT) {
#pragma unroll
            for (int j = 0; j < 4; ++j)
#pragma unroll
                for (int pr = 0; pr < 2; ++pr) { const u32x4* wp = (const u32x4*)(args.ws + WS_WDT) + (size_t)(2 * lane + 128 * j + pr) * 2; const u32x4 a = wp[0], c = wp[1];
                    wdt[j][pr][0] = a.x; wdt[j][pr][1] = a.y; wdt[j][pr][2] = a.z; wdt[j][pr][3] = a.w; wdt[j][pr][4] = c.x; wdt[j][pr][5] = c.y; wdt[j][pr][6] = c.z; wdt[j][pr][7] = c.w; }
        }
        float dtb = 0.f; if constexpr (WITH_DT) dtb = (args.in[9])[lane & 7];
        f32x4 nx[2][4];
#pragma unroll
        for (int p = 0; p < 2; ++p)
#pragma unroll
            for (int j = 0; j < 4; ++j) {
                if constexpr (XBF) { const u32x2 w = ((const u32x2*)((const bf16*)xin_ + (size_t)(row0 + p) * D) + lane)[64 * j]; nx[p][j] = (f32x4){bflo(w.x), bfhi(w.x), bflo(w.y), bfhi(w.y)}; }
                else nx[p][j] = __builtin_nontemporal_load(((const f32x4*)((const float*)xin_ + (size_t)(row0 + p) * D) + lane) + 64 * j); }
#pragma unroll 2
        for (int r = 0; r < 32; ++r) {
            const int row = row0 + r;
            f32x4 v[4]; float s = 0.f;
#pragma unroll
            for (int j = 0; j < 4; ++j) v[j] = nx[r & 1][j];
            { const int rn = row0 + (r + 2 < 32 ? r + 2 : 31);
#pragma unroll
                for (int j = 0; j < 4; ++j) {
                    if constexpr (XBF) { const u32x2 w = ((const u32x2*)((const bf16*)xin_ + (size_t)rn * D) + lane)[64 * j]; nx[r & 1][j] = (f32x4){bflo(w.x), bfhi(w.x), bflo(w.y), bfhi(w.y)}; }
                    else nx[r & 1][j] = __builtin_nontemporal_load(((const f32x4*)((const float*)xin_ + (size_t)rn * D) + lane) + 64 * j); } }
#pragma unroll
            for (int j = 0; j < 4; ++j) s += (v[j].x * v[j].x + v[j].y * v[j].y) + (v[j].z * v[j].z + v[j].w * v[j].w);
            const float rstd = rsqrtf(wave_sum(s) * (1.0f / D) + EPS);
            u32x2* o8 = (u32x2*)(hout + (size_t)row * D) + lane;
            float dv[8] = {0.f, 0.f, 0.f, 0.f, 0.f, 0.f, 0.f, 0.f};
#pragma unroll
            for (int j = 0; j < 4; ++j) { const f32x4 h = v[j] * rstd * sc[j] + sh[j];
                if constexpr (!WITH_DT) { int q8 = __builtin_amdgcn_cvt_pk_fp8_f32(h.x, h.y, 0, false); q8 = __builtin_amdgcn_cvt_pk_fp8_f32(h.z, h.w, q8, true); ((unsigned*)(h8out + (size_t)row * D))[lane + 64 * j] = (unsigned)q8; }
                const unsigned wx = cvt_pk_bf16(h.x, h.y), wy = cvt_pk_bf16(h.z, h.w); if (WITH_DT) o8[64 * j] = (u32x2){wx, wy};
                if constexpr (WITH_DT) {
                    typedef __bf16 bf2 __attribute__((ext_vector_type(2)));
#pragma unroll
                    for (int hh = 0; hh < 8; ++hh) { dv[hh] = __builtin_amdgcn_fdot2_f32_bf16(__builtin_bit_cast(bf2, wx), __builtin_bit_cast(bf2, wdt[j][0][hh]), dv[hh], false);
                        dv[hh] = __builtin_amdgcn_fdot2_f32_bf16(__builtin_bit_cast(bf2, wy), __builtin_bit_cast(bf2, wdt[j][1][hh]), dv[hh], false); } } }
            if constexpr (WITH_DT) {
#pragma unroll
                for (int hh = 0; hh < 8; ++hh) dv[hh] = wave_sum(dv[hh]);
                float mine = dv[0];
#pragma unroll
                for (int hh = 1; hh < 8; ++hh) mine = (lane == hh) ? dv[hh] : mine;
                if (lane < 8) { const float a = mine + dtb; ((float*)(args.ws + WS_DT))[(size_t)row * 8 + lane] = a > 20.f ? a : log1pf(__expf(a)); }
            }
        }
    }
}

__device__ __forceinline__ void p3_conv(const Frame& F_, CArgs& args_) {
    Frame F = F_; F.lane = lane_id_asm(); F.tid = F.wave * 64 + F.lane;
    ARGS_LAUNDER(args_);
    const int q = F.tid & 63, seg = F.tid >> 6;
    for (int tile = F.vcu; tile < T / 256; tile += F.G) {
        const int r0 = tile * 256 + seg * 32; const bool head = (r0 % SEQ) == 0;
        {
            float w0[8], w1[8], w2[8], pm2[8], pm1[8];
#pragma unroll
            for (int i = 0; i < 8; ++i) { w0[i] = (args.in[6])[0 * 512 + 8 * q + i]; w1[i] = (args.in[6])[1 * 512 + 8 * q + i]; w2[i] = (args.in[6])[2 * 512 + 8 * q + i]; pm2[i] = 0.f; pm1[i] = 0.f; }
            if (!head) {
                unpack8(*(const u32x4*)(((bf16*)(args.ws + WS_A)) + pj((size_t)(r0 - 2), C_P + 8 * q)), pm2);
                unpack8(*(const u32x4*)(((bf16*)(args.ws + WS_A)) + pj((size_t)(r0 - 1), C_P + 8 * q)), pm1);
            }
            const bf16* pj0 = ((bf16*)(args.ws + WS_A));
            constexpr int YB = 4; u32x4 nb[YB][2];
#pragma unroll
            for (int j = 0; j < YB; ++j) { nb[j][0] = __builtin_nontemporal_load((const u32x4*)(pj0 + pj((size_t)(r0 + j), C_CB + 8 * q))); nb[j][1] = __builtin_nontemporal_load((const u32x4*)(pj0 + pj((size_t)(r0 + j), C_P + 8 * q))); }
#pragma unroll 1
            for (int r = 0; r < 32; r += YB) {
                u32x4 cur[YB][2];
#pragma unroll
                for (int j = 0; j < YB; ++j) { cur[j][0] = nb[j][0]; cur[j][1] = nb[j][1]; }
                {
#pragma unroll
                    for (int j = 0; j < YB; ++j) { const size_t rn = (size_t)(r0 + (r + YB + j < 32 ? r + YB + j : 31));
                        nb[j][0] = __builtin_nontemporal_load((const u32x4*)(pj0 + pj(rn, C_CB + 8 * q))); nb[j][1] = __builtin_nontemporal_load((const u32x4*)(pj0 + pj(rn, C_P + 8 * q))); } }
#pragma unroll
                for (int j = 0; j < YB; ++j) {
                    float cb[8], pp[8], y[8];
                    unpack8(cur[j][0], cb); unpack8(cur[j][1], pp);
#pragma unroll
                    for (int i = 0; i < 8; ++i) { const float p = pp[i]; y[i] = cb[i] * (w0[i] * pm2[i] + w1[i] * pm1[i] + w2[i] * p); pm2[i] = pm1[i]; pm1[i] = p; }
                    *(u32x4*)(((bf16*)(args.ws + WS_HB)) + (size_t)(r0 + r + j) * D + 512 + 8 * q) = pack8(y);
                }
            }
        }
#pragma unroll 1
        for (int jj = 0; jj < 2; ++jj) {
            const int ch0 = 8 * (q + 64 * jj);
            float w0[8], w1[8], w2[8], w3[8], bs[8], u3[8], u2[8], u1[8];
#pragma unroll
            for (int i = 0; i < 8; ++i) { w0[i] = (args.in[7])[0 * 1024 + ch0 + i]; w1[i] = (args.in[7])[1 * 1024 + ch0 + i]; w2[i] = (args.in[7])[2 * 1024 + ch0 + i]; w3[i] = (args.in[7])[3 * 1024 + ch0 + i];
                bs[i] = (args.in[8])[ch0 + i]; u3[i] = 0.f; u2[i] = 0.f; u1[i] = 0.f; }
            if (!head) { unpack8(*(const u32x4*)(((bf16*)(args.ws + WS_A)) + pj((size_t)(r0 - 3), C_XBC + ch0)), u3); unpack8(*(const u32x4*)(((bf16*)(args.ws + WS_A)) + pj((size_t)(r0 - 2), C_XBC + ch0)), u2);
                unpack8(*(const u32x4*)(((bf16*)(args.ws + WS_A)) + pj((size_t)(r0 - 1), C_XBC + ch0)), u1); }
            const bf16* pjx = ((bf16*)(args.ws + WS_A));
            constexpr int XB = 8; u32x4 nb[XB];
#pragma unroll
            for (int j = 0; j < XB; ++j) nb[j] = __builtin_nontemporal_load((const u32x4*)(pjx + pj((size_t)(r0 + j), C_XBC + ch0)));
#pragma unroll 1
            for (int r = 0; r < 32; r += XB) {
                u32x4 cur[XB];
#pragma unroll
                for (int j = 0; j < XB; ++j) cur[j] = nb[j];
#pragma unroll
                for (int j = 0; j < XB; ++j) nb[j] = __builtin_nontemporal_load((const u32x4*)(pjx + pj((size_t)(r0 + (r + XB + j < 32 ? r + XB + j : 31)), C_XBC + ch0)));
#pragma unroll
                for (int j = 0; j < XB; ++j) {
                    float u[8], y[8]; unpack8(cur[j], u);
#pragma unroll
                    for (int i = 0; i < 8; ++i) { y[i] = silu_f(bs[i] + w0[i] * u3[i] + w1[i] * u2[i] + w2[i] * u1[i] + w3[i] * u[i]); u3[i] = u2[i]; u2[i] = u1[i]; u1[i] = u[i]; }
                    *(u32x4*)(((bf16*)(args.ws + WS_XC)) + (size_t)(r0 + r + j) * D + ch0) = pack8(y);
                }
            }
        }
    }
}

constexpr int SD_SET = 55296, SD_BM = 0, SD_CM = 17408, SD_DX = 34816, SD_DXD = 39936, SD_XS = 45056, SD_ZR = 50176, SD_WM = 2 * SD_SET, SD_SB = SD_WM + 2 * 9216, SD_ACS = SD_SB + 8704, SD_DTS = SD_ACS + 768, SD_END = SD_DTS + 768;
static_assert(SD_END <= MISC_OFF, "SSD LDS map");
typedef short s16x4 __attribute__((ext_vector_type(4)));
__device__ __forceinline__ bf16x8 lds_tr8(const LAS unsigned char* p, int stride4) {
    const s16x4 a = __builtin_bit_cast(s16x4, __builtin_amdgcn_ds_read_tr16_b64_v4i16((LAS s16x4*)p));
    const s16x4 b = __builtin_bit_cast(s16x4, __builtin_amdgcn_ds_read_tr16_b64_v4i16((LAS s16x4*)(p + stride4)));
    return __builtin_shufflevector(a, b, 0, 1, 2, 3, 4, 5, 6, 7);
}
#define DPP_SHR_ADD(v, n) do { const int t_ = __builtin_amdgcn_update_dpp(0, __float_as_int(v), 0x110 + (n), 0xf, 0xf, true); (v) += __int_as_float(t_); } while (0)
__device__ __forceinline__ void p4_ssd(const Frame& F_, CArgs& args_) {
    Frame F = F_; F.lane = lane_id_asm(); F.tid = F.wave * 64 + F.lane;
    ARGS_LAUNDER(args_);
    LAS unsigned char* lds = F.lds; const int tid = F.tid, lane = F.lane, wave = F.wave, fr = lane & 15, fq = lane >> 4;
    const int tq = fr >> 2, tp = fr & 3;
    for (int uid = F.vcu; uid < 256; uid += F.G) {
        const int b = uid >> 4, h = (uid >> 1) & 7, ph = uid & 1, g = h >> 2;
        const float Ah = -__expf((args.in[10])[h]), Dh = (args.in[11])[h];
        const int xs_col = h * 64 + ph * 32, b_col = 512 + g * 128, c_col = 768 + g * 128, z_col = C_Z + h * 64 + ph * 32;
        f32x4 Sacc[2] = {(f32x4){0.f, 0.f, 0.f, 0.f}, (f32x4){0.f, 0.f, 0.f, 0.f}};
        for (int i = tid; i < 32 * 136 / 2; i += 512) ((LAS unsigned*)(lds + SD_SB))[i] = 0u;
        u32x4 pb[2][2], pc[2][2], px[2], pz[2]; float pdt[2] = {0.f, 0.f};
#pragma unroll
        for (int X = 0; X < 2; ++X) { px[X] = (u32x4){0u, 0u, 0u, 0u}; pz[X] = (u32x4){0u, 0u, 0u, 0u}; }
        const size_t trow0 = (size_t)b * SEQ;
        const bf16* XCp = ((const bf16*)(args.ws + WS_XC)); const bf16* PJ = ((const bf16*)(args.ws + WS_A)); const float* DTp = ((const float*)(args.ws + WS_DT));
        bf16* HBp = ((bf16*)(args.ws + WS_HB)); float* SQp = ((float*)(args.ws + WS_SSQ));
#define SSD_LOAD(cc, X) do { const size_t t0_ = trow0 + (size_t)(cc) * 64; \
            _Pragma("unroll") for (int k = 0; k < 2; ++k) { const int i_ = tid + 512 * k; pb[X][k] = *(const u32x4*)(XCp + (t0_ + (i_ >> 4)) * D + b_col + 8 * (i_ & 15)); pc[X][k] = *(const u32x4*)(XCp + (t0_ + (i_ >> 4)) * D + c_col + 8 * (i_ & 15)); } \
            if (wave < 4) { px[X] = __builtin_nontemporal_load((const u32x4*)(XCp + (t0_ + (tid >> 2)) * D + xs_col + 8 * (tid & 3))); pz[X] = __builtin_nontemporal_load((const u32x4*)(PJ + pj(t0_ + (tid >> 2), z_col + 8 * (tid & 3)))); } \
            if (wave == 7) pdt[X] = DTp[(t0_ + lane) * 8 + h]; } while (0)
#define SSD_AUX(slot, X) do { if (wave == 7) { float a_ = pdt[X] * Ah; DPP_SHR_ADD(a_, 1); DPP_SHR_ADD(a_, 2); DPP_SHR_ADD(a_, 4); DPP_SHR_ADD(a_, 8); \
                const float r0_ = __int_as_float(__builtin_amdgcn_readlane(__float_as_int(a_), 15)), r1_ = __int_as_float(__builtin_amdgcn_readlane(__float_as_int(a_), 31)), r2_ = __int_as_float(__builtin_amdgcn_readlane(__float_as_int(a_), 47)); \
                a_ += (fq == 1) ? r0_ : (fq == 2) ? (r0_ + r1_) : (fq == 3) ? ((r0_ + r1_) + r2_) : 0.f; \
                ((LAS float*)(lds + SD_ACS))[(slot) * 64 + lane] = a_; ((LAS float*)(lds + SD_DTS))[(slot) * 64 + lane] = pdt[X]; } } while (0)
#define SSD_TILES(ts, X, slot) do { LAS unsigned char* tb_ = lds + (ts) * SD_SET; \
            _Pragma("unroll") for (int k = 0; k < 2; ++k) { const int i_ = tid + 512 * k; *(LAS u32x4*)(tb_ + SD_BM + ((i_ >> 4) * 136 + 8 * (i_ & 15)) * 2) = pb[X][k]; *(LAS u32x4*)(tb_ + SD_CM + ((i_ >> 4) * 136 + 8 * (i_ & 15)) * 2) = pc[X][k]; } \
            if (wave < 4) { const int l_ = tid >> 2, q_ = tid & 3; const LAS float* A_ = (const LAS float*)(lds + SD_ACS) + (slot) * 64; \
                *(LAS u32x4*)(tb_ + SD_XS + (l_ * 40 + 8 * q_) * 2) = px[X]; *(LAS u32x4*)(tb_ + SD_ZR + (l_ * 40 + 8 * q_) * 2) = pz[X]; \
                float f_[8], fd_[8]; unpack8(px[X], f_); const float dt_ = ((const LAS float*)(lds + SD_DTS))[(slot) * 64 + l_], dd_ = dt_ * __expf(A_[63] - A_[l_]); \
                _Pragma("unroll") for (int e = 0; e < 8; ++e) { fd_[e] = f_[e] * dd_; f_[e] *= dt_; } \
                *(LAS u32x4*)(tb_ + SD_DX + (l_ * 40 + 8 * q_) * 2) = pack8(f_); *(LAS u32x4*)(tb_ + SD_DXD + (l_ * 40 + 8 * q_) * 2) = pack8(fd_); } } while (0)
#define SSD_W(ts, slot) do { const LAS unsigned char* tb_ = lds + (ts) * SD_SET; const LAS float* A_ = (const LAS float*)(lds + SD_ACS) + (slot) * 64; \
            _Pragma("unroll") for (int jt = 0; jt < 2; ++jt) { const int id_ = 2 * wave + jt, lt_ = id_ >> 2, st_ = id_ & 3; f32x4 acc_ = (f32x4){0.f, 0.f, 0.f, 0.f}; \
                if (st_ <= lt_) { _Pragma("unroll") for (int kk = 0; kk < 4; ++kk) { const bf16x8 a_ = *(const LAS bf16x8*)(tb_ + SD_BM + ((st_ * 16 + fr) * 136 + kk * 32 + fq * 8) * 2); const bf16x8 b_ = *(const LAS bf16x8*)(tb_ + SD_CM + ((lt_ * 16 + fr) * 136 + kk * 32 + fq * 8) * 2); \
                        acc_ = __builtin_amdgcn_mfma_f32_16x16x32_bf16(a_, b_, acc_, 0, 0, 0); } } \
                const int l_ = lt_ * 16 + fr, s0_ = st_ * 16 + 4 * fq; const float al_ = A_[l_]; float w_[4]; const f32x4 as_ = *(const LAS f32x4*)(A_ + s0_);     \
                _Pragma("unroll") for (int r = 0; r < 4; ++r) { const int s_ = s0_ + r; const float e_ = acc_[r] * __expf(fminf(al_ - as_[r], 0.f)); w_[r] = (s_ <= l_) ? e_ : 0.f; } \
                u32x2 o_; o_.x = cvt_pk_bf16(w_[0], w_[1]); o_.y = cvt_pk_bf16(w_[2], w_[3]); *(LAS u32x2*)(lds + SD_WM + (ts) * 9216 + (l_ * 72 + s0_) * 2) = o_; } } while (0)
        SSD_LOAD(0, 0); SSD_LOAD(1, 1);
        SSD_AUX(0, 0); SSD_AUX(1, 1);
        WG_BAR();
        SSD_TILES(0, 0, 0);
        SSD_LOAD(2, 0);
        WG_BAR();
        SSD_W(0, 0);
        WG_BAR();
        int a0 = 0, a1 = 1, a2 = 2;
        u32x2 ypk = (u32x2){0u, 0u}; float yq = 0.f;
        auto sstep = [&](auto fullc_, const int c2) __attribute__((always_inline)) { constexpr bool FULL = decltype(fullc_)::value;
#pragma unroll
        for (int par = 0; par < 2; ++par) {
            const int c = c2 + par; const size_t t0 = trow0 + (size_t)c * 64;
            const LAS unsigned char* tb = lds + par * SD_SET; const LAS float* ACS = (const LAS float*)(lds + SD_ACS) + a0 * 64;
            if (FULL || c + 1 < 64) SSD_TILES(par ^ 1, par ^ 1, a1);
            if (FULL || c + 2 < 64) SSD_AUX(a2, par);
            if (FULL || c > 0) { const int lt_ = wave >> 1, pt_ = wave & 1, l_ = lt_ * 16 + fr, p0_ = pt_ * 16 + 4 * fq; const size_t tp_ = t0 - 64;
                if (fq == 0) SQp[(size_t)((h * 2 + ph) * 2 + pt_) * T + tp_ + l_] = yq;
                *(u32x2*)(HBp + (tp_ + l_) * D + xs_col + p0_) = ypk; }
            if (FULL || c + 3 < 64) SSD_LOAD(c + 3, par ^ 1);
            const int lt = wave >> 1, pt = wave & 1, l = lt * 16 + fr, p0 = pt * 16 + 4 * fq;
            f32x4 yd = (f32x4){0.f, 0.f, 0.f, 0.f}, yo = (f32x4){0.f, 0.f, 0.f, 0.f};
#pragma unroll
            for (int kk = 0; kk < 2; ++kk) { const bf16x8 a = lds_tr8(tb + SD_DX + ((kk * 32 + 8 * fq + tq) * 40 + pt * 16 + 4 * tp) * 2, 4 * 80);
                const bf16x8 bb = *(const LAS bf16x8*)(lds + SD_WM + par * 9216 + ((lt * 16 + fr) * 72 + kk * 32 + fq * 8) * 2);
                yd = __builtin_amdgcn_mfma_f32_16x16x32_bf16(a, bb, yd, 0, 0, 0); }
#pragma unroll
            for (int kk = 0; kk < 4; ++kk) { const bf16x8 a = *(const LAS bf16x8*)(lds + SD_SB + ((pt * 16 + fr) * 136 + kk * 32 + fq * 8) * 2); const bf16x8 bb = *(const LAS bf16x8*)(tb + SD_CM + ((lt * 16 + fr) * 136 + kk * 32 + fq * 8) * 2);
                yo = __builtin_amdgcn_mfma_f32_16x16x32_bf16(a, bb, yo, 0, 0, 0); }
            const u32x2 xw = *(const LAS u32x2*)(tb + SD_XS + (l * 40 + p0) * 2), zw = *(const LAS u32x2*)(tb + SD_ZR + (l * 40 + p0) * 2);
            const float el = __expf(ACS[l]), cd = __expf(ACS[63]);
#pragma unroll
            for (int jt = 0; jt < 2; ++jt) { const int id = 2 * wave + jt, nt = id >> 1, pt2 = id & 1;
                Sacc[jt] = Sacc[jt] * cd;
#pragma unroll
                for (int kk = 0; kk < 2; ++kk) { const bf16x8 a = lds_tr8(tb + SD_BM + ((kk * 32 + 8 * fq + tq) * 136 + nt * 16 + 4 * tp) * 2, 4 * 272);
                    const bf16x8 bb = lds_tr8(tb + SD_DXD + ((kk * 32 + 8 * fq + tq) * 40 + pt2 * 16 + 4 * tp) * 2, 4 * 80);
                    Sacc[jt] = __builtin_amdgcn_mfma_f32_16x16x32_bf16(a, bb, Sacc[jt], 0, 0, 0); } }
            WG_BAR();
            {
                const float xs[4] = {bflo(xw.x), bfhi(xw.x), bflo(xw.y), bfhi(xw.y)}, zz[4] = {bflo(zw.x), bfhi(zw.x), bflo(zw.y), bfhi(zw.y)};
                float y[4], q2 = 0.f;
#pragma unroll
                for (int r = 0; r < 4; ++r) { y[r] = (yd[r] + el * yo[r] + Dh * xs[r]) * silu_f(zz[r]); q2 += y[r] * y[r]; }
                q2 += __shfl_xor(q2, 16); q2 += __shfl_xor(q2, 32);
                yq = q2; ypk.x = cvt_pk_bf16(y[0], y[1]); ypk.y = cvt_pk_bf16(y[2], y[3]);
            }
#pragma unroll
            for (int jt = 0; jt < 2; ++jt) { const int id = 2 * wave + jt, nt = id >> 1, pt2 = id & 1;
                u32x2 o; o.x = cvt_pk_bf16(Sacc[jt][0], Sacc[jt][1]); o.y = cvt_pk_bf16(Sacc[jt][2], Sacc[jt][3]);
                *(LAS u32x2*)(lds + SD_SB + ((pt2 * 16 + fr) * 136 + nt * 16 + 4 * fq) * 2) = o; }
            if (FULL || c + 1 < 64) SSD_W(par ^ 1, a1);
            WG_BAR();
            { const int t_ = a0; a0 = a1; a1 = a2; a2 = t_; }
        }
        };
        sstep(std::false_type{}, 0);
#pragma unroll 1
        for (int c2 = 2; c2 <= 58; c2 += 2) sstep(std::true_type{}, c2);
        sstep(std::false_type{}, 60); sstep(std::false_type{}, 62);
#undef SSD_LOAD
#undef SSD_AUX
#undef SSD_TILES
#undef SSD_W
        { const int ln_ = lane_id_asm(), fr_ = ln_ & 15, fq_ = ln_ >> 4;
          const int lt_ = wave >> 1, pt_ = wave & 1, l_ = lt_ * 16 + fr_, p0_ = pt_ * 16 + 4 * fq_; const size_t tp_ = trow0 + (size_t)63 * 64;
            if (fq_ == 0) SQp[(size_t)((h * 2 + ph) * 2 + pt_) * T + tp_ + l_] = yq;
            *(u32x2*)(HBp + (tp_ + l_) * D + xs_col + p0_) = ypk; }
        WG_BAR();
    }
}

__device__ __forceinline__ void p1_router_weights(const Frame& F_, CArgs& args_) {
    Frame F = F_; F.lane = lane_id_asm(); F.tid = F.wave * 64 + F.lane;
    ARGS_LAUNDER(args_);
    LAS float* red = (LAS float*)F.lds;
    for (int w = F.vcu; w < 256; w += F.G) {
        const int b = w >> 4, e0 = 4 * (w & 15); float bs[4] = {0.f, 0.f, 0.f, 0.f};
        const float* mod = (const float*)(args.ws + WS_MOD) + b * 6144;
#pragma unroll
        for (int kk = 0; kk < 2; ++kk) { const int k = F.tid + 512 * kk; const f32x4 wv = *(const f32x4*)((args.in[15]) + (size_t)k * 64 + e0);
            const float sc = (args.in[14])[k] * (1.0f + mod[4096 + k]), sh = mod[3072 + k];
#pragma unroll
            for (int j = 0; j < 4; ++j) { ((bf16*)(args.ws + WS_WR))[((size_t)b * 64 + e0 + j) * 1024 + k] = f2bf(wv[j] * sc); bs[j] += sh * wv[j]; } }
#pragma unroll
        for (int j = 0; j < 4; ++j) bs[j] = wave_sum(bs[j]);
        if (F.lane == 0) { red[F.wave * 4 + 0] = bs[0]; red[F.wave * 4 + 1] = bs[1]; red[F.wave * 4 + 2] = bs[2]; red[F.wave * 4 + 3] = bs[3]; }
        WG_BAR();
        if (F.tid < 4) { float s = 0.f;
#pragma unroll
            for (int q = 0; q < 8; ++q) s += red[q * 4 + F.tid];
            ((float*)(args.ws + WS_RB))[b * 64 + e0 + F.tid] = s; }
        WG_BAR();
    }
}
constexpr int RT_WST = 1032;
constexpr int RT_LOG = 0, RT_CNT = 65536, RT_BASE = 65536 + 256, RT_LE = 66560, RT_LW = 66560 + 8192;
constexpr int RT_RS = RT_LW + 8192;
static_assert(64 * RT_WST * 2 <= MISC_OFF && RT_RS + 1024 <= MISC_OFF, "router LDS map");
__device__ __forceinline__ void p7_router(const Frame& F_, CArgs& args_) {
    Frame F = F_; F.lane = lane_id_asm(); F.tid = F.wave * 64 + F.lane;
    ARGS_LAUNDER(args_);
    LAS unsigned char* lds = F.lds; const int tid = F.tid, lane = F.lane, wave = F.wave, fr = lane & 15, fq = lane >> 4;
    LAS int* lcnt = (LAS int*)(lds + RT_CNT); LAS int* lbase = (LAS int*)(lds + RT_BASE);
    LAS unsigned* le = (LAS unsigned*)(lds + RT_LE); LAS float* lw = (LAS float*)(lds + RT_LW);
    const float bias = (args.in[16])[lane];
    for (int tile = F.vcu; tile < T / 256; tile += F.G) {
        const int s = (tile * 256) / TS, b = (tile * 256) / SEQ;
        { const u32x4* wsrc = (const u32x4*)((const bf16*)(args.ws + WS_WR) + (size_t)b * 64 * 1024);
          u32x4 wt[16];
#pragma unroll
          for (int j = 0; j < 16; ++j) wt[j] = wsrc[tid + 512 * j];
#pragma unroll
          for (int j = 0; j < 16; ++j) { const int i = tid + 512 * j, e = i >> 7, c = i & 127; *(LAS u32x4*)(lds + (e * RT_WST + 8 * c) * 2) = wt[j]; } }
        WG_BAR();
        const bf16* xb = (const bf16*)(args.ws + WS_X1) + (size_t)(tile * 256 + wave * 32) * D;
        f32x4 acc[2][4]; float ssq[2] = {0.f, 0.f};
#pragma unroll
        for (int g = 0; g < 2; ++g)
#pragma unroll
            for (int n = 0; n < 4; ++n) acc[g][n] = (f32x4){0.f, 0.f, 0.f, 0.f};
        constexpr int XG = 2;
        u32x4 xs0[XG][2], xs1[XG][2], xs2[XG][2], xs3[XG][2];
#define RT_XLOAD(dst, k0_) do { _Pragma("unroll") for (int q = 0; q < XG; ++q) _Pragma("unroll") for (int g = 0; g < 2; ++g) dst[q][g] = *(const u32x4*)(xb + (size_t)(16 * g + fr) * D + 32 * ((k0_) + q) + 8 * fq); } while (0)
#define RT_XMMA(srcx, k0_) do { _Pragma("unroll") for (int q = 0; q < XG; ++q) { const int ks = (k0_) + q; bf16x8 bfr[2]; \
            _Pragma("unroll") for (int g = 0; g < 2; ++g) { const u32x4 xv = srcx[q][g]; bfr[g] = __builtin_bit_cast(bf16x8, xv); float f[8]; unpack8(xv, f); _Pragma("unroll") for (int j = 0; j < 8; ++j) ssq[g] += f[j] * f[j]; } \
            _Pragma("unroll") for (int n = 0; n < 4; ++n) { const bf16x8 afr = *(const LAS bf16x8*)(lds + ((16 * n + fr) * RT_WST + 32 * ks + 8 * fq) * 2); \
                _Pragma("unroll") for (int g = 0; g < 2; ++g) acc[g][n] = __builtin_amdgcn_mfma_f32_16x16x32_bf16(afr, bfr[g], acc[g][n], 0, 0, 0); } } } while (0)
        RT_XLOAD(xs0, 0); RT_XLOAD(xs1, XG); RT_XLOAD(xs2, 2 * XG); RT_XLOAD(xs3, 3 * XG);
#pragma unroll 1
        for (int k0 = 0; k0 < 32; k0 += 4 * XG) {
            const int kn = k0 + 4 * XG < 32 ? k0 + 4 * XG : k0;
            RT_XMMA(xs0, k0);          RT_XLOAD(xs0, kn);
            RT_XMMA(xs1, k0 + XG);     RT_XLOAD(xs1, kn + XG);
            RT_XMMA(xs2, k0 + 2 * XG); RT_XLOAD(xs2, kn + 2 * XG);
            RT_XMMA(xs3, k0 + 3 * XG); RT_XLOAD(xs3, kn + 3 * XG);
        }
#undef RT_XLOAD
#undef RT_XMMA
        WG_BAR();
        if (tid < 64) lcnt[tid] = 0;
#pragma unroll
        for (int g = 0; g < 2; ++g) { float q = ssq[g]; q += __shfl_xor(q, 16); q += __shfl_xor(q, 32); const float rstd = rsqrtf(q * (1.0f / D) + EPS);
            if (fq == 0) *(LAS float*)(lds + RT_RS + (wave * 32 + 16 * g + fr) * 4) = rstd;
#pragma unroll
            for (int n = 0; n < 4; ++n) { const f32x4 rb = *(const f32x4*)((const float*)(args.ws + WS_RB) + b * 64 + 16 * n + 4 * fq);
                *(LAS f32x4*)(lds + RT_LOG + ((wave * 32 + 16 * g + fr) * 64 + 16 * n + 4 * fq) * 4) = acc[g][n] * rstd + rb; } }
        WG_BAR();
        f32x4 hsc[4], hsh[4];
#pragma unroll
        for (int j = 0; j < 4; ++j) { const int col = 16 * lane + 4 * j; const float* mod = (const float*)(args.ws + WS_MOD) + b * 6144;
            hsc[j] = *(const f32x4*)((args.in[14]) + col) * (*(const f32x4*)(mod + 4096 + col) + 1.0f); hsh[j] = *(const f32x4*)(mod + 3072 + col); }
        const bf16* xrow = (const bf16*)(args.ws + WS_X1) + (size_t)(tile * 256 + wave * 32) * D + 16 * lane;
        unsigned char* hrow = (unsigned char*)(args.ws + WS_H8) + (size_t)(tile * 256 + wave * 32) * D + 16 * lane;
        u32x4 xn0 = __builtin_nontemporal_load((const u32x4*)(xrow)), xn1 = __builtin_nontemporal_load((const u32x4*)(xrow + 8));
#pragma unroll 2
        for (int i = 0; i < 32; ++i) {
            const int tl = wave * 32 + i;
            const u32x4 xc0 = xn0, xc1 = xn1;
            if (i + 1 < 32) { xn0 = __builtin_nontemporal_load((const u32x4*)(xrow + (size_t)(i + 1) * D)); xn1 = __builtin_nontemporal_load((const u32x4*)(xrow + (size_t)(i + 1) * D + 8)); }
            { const float rs = *(const LAS float*)(lds + RT_RS + tl * 4); float f[16]; { float t8[8]; unpack8(xc0, t8);
#pragma unroll
                for (int j = 0; j < 8; ++j) f[j] = t8[j]; unpack8(xc1, t8);
#pragma unroll
                for (int j = 0; j < 8; ++j) f[8 + j] = t8[j]; }
                u32x4 hw; unsigned hv[4];
#pragma unroll
                for (int j = 0; j < 4; ++j) { const f32x4 h = (f32x4){f[4 * j], f[4 * j + 1], f[4 * j + 2], f[4 * j + 3]} * rs * hsc[j] + hsh[j];
                    int q8 = __builtin_amdgcn_cvt_pk_fp8_f32(h.x, h.y, 0, false); q8 = __builtin_amdgcn_cvt_pk_fp8_f32(h.z, h.w, q8, true); hv[j] = (unsigned)q8; }
                hw.x = hv[0]; hw.y = hv[1]; hw.z = hv[2]; hw.w = hv[3];
                *(u32x4*)(hrow + (size_t)i * D) = hw; }
            const float logit = *(const LAS float*)(lds + RT_LOG + (tl * 64 + lane) * 4);
            const float score = __builtin_amdgcn_rcpf(1.0f + __expf(-logit)), sel = score + bias;
            const float m1 = max8(sel);
            const unsigned long long eq = __ballot(sel == m1);
            const unsigned gm = (unsigned)(eq >> (lane & 56)) & 0xffu;
            const int first = gm ? __builtin_ctz(gm) : 0;
            const float m2 = max8(((lane & 7) == first) ? -INFINITY : sel);
            const float gs = m1 + m2; const int g = lane >> 3; int grank = 0;
            const unsigned ghi = f32_key(gs); const unsigned long long gme = ((unsigned long long)ghi << 32) | (unsigned)(7 - g);
#pragma unroll
            for (int j = 0; j < 8; ++j) { const unsigned long long go = ((unsigned long long)(unsigned)__builtin_amdgcn_readlane((int)ghi, 8 * j) << 32) | (unsigned)(7 - j); grank += (go > gme) ? 1 : 0; }
            const bool gsel = grank < 4; const unsigned long long gmask = __ballot(gsel);
            int rank = 0;
            const unsigned khi = f32_key(sel); const unsigned long long kme = ((unsigned long long)khi << 32) | (unsigned)(63 - lane);
#pragma unroll
            for (int j = 0; j < 8; ++j) if ((gmask >> (8 * j)) & 1ull) {
#pragma unroll
                for (int i = 0; i < 8; ++i) { const unsigned long long ko = ((unsigned long long)(unsigned)__builtin_amdgcn_readlane((int)khi, 8 * j + i) << 32) | (unsigned)(63 - (8 * j + i)); rank += (ko > kme) ? 1 : 0; } }
            const bool chosen = gsel && rank < TOPK;
            const float wsum = wave_sum(chosen ? score : 0.f);
            if (chosen) { const int pos = __hip_atomic_fetch_add(lcnt + lane, 1, __ATOMIC_RELAXED, __HIP_MEMORY_SCOPE_WORKGROUP);
                le[tl * 8 + rank] = (unsigned)lane | ((unsigned)pos << 8); lw[tl * 8 + rank] = score / wsum * 2.5f; }
        }
        WG_BAR();
        if (tid < 64) lbase[tid] = (int)__hip_atomic_fetch_add(((unsigned*)(args.ws + WS_CTL) + CW_CNT) + s * 80 + tid, (unsigned)lcnt[tid], RLX_AGENT);
        WG_BAR();
        for (int idx = tid; idx < 2048; idx += 512) { const unsigned v = le[idx]; const int e = v & 0xffu; const size_t o = (size_t)tile * 2048 + idx;
            const int pos = (int)(v >> 8) + lbase[e]; ((int*)(args.ws + WS_IDX))[o] = e; ((int*)(args.ws + WS_APOS))[o] = pos; ((float*)(args.ws + WS_WGT))[o] = lw[idx];
            ((int*)(args.ws + WS_LIST))[(size_t)e * T + pos] = tile * 256 + (idx >> 3); }
        WG_BAR();
    }
}
__device__ __forceinline__ void load_eoff(const Frame& F_, CArgs& args_) {
    Frame F = F_; F.lane = lane_id_asm(); F.tid = F.wave * 64 + F.lane;
    ARGS_LAUNDER(args_);
    LAS int* eoff = (LAS int*)(F.lds + EO_OFF); LAS int* ecnt = (LAS int*)(F.lds + EC_OFF);
    if (F.tid < S_SB) { const int s = F.tid; int acc = 0;
        for (int e = 0; e < NEX; ++e) { const int cnt = e < NE ? (int)((unsigned*)(args.ws + WS_CTL) + CW_CNT)[s * 80 + e] : TS; eoff[s * 72 + e] = acc; ecnt[s * 72 + e] = cnt; acc += (cnt + 255) & ~255; }
        eoff[s * 72 + NEX] = acc; }
    WG_BAR();
}
__device__ __forceinline__ int moe_tables(const Frame& F_, CArgs& args_, int s, bool gather) {
    Frame F = F_; F.lane = lane_id_asm(); F.tid = F.wave * 64 + F.lane;
    ARGS_LAUNDER(args_);
    asm volatile("" : "+s"(s));
    const LAS int* eoff = (const LAS int*)(F.lds + EO_OFF) + s * 72;
    LAS unsigned char* te = F.lds + TE_OFF;
    const int NT = eoff[NEX] >> 8;
    for (int e = F.wave; e < NEX; e += 8) { const int t0 = eoff[e] >> 8, t1 = eoff[e + 1] >> 8; for (int t = t0 + F.lane; t < t1; t += 64) te[t] = (unsigned char)e; }
    WG_BAR();
    if (gather) { LAS unsigned* tab = (LAS unsigned*)(F.lds + TAB_OFF);
        int nsl = (2 * NT - F.vcu + F.G - 1) / F.G; nsl = nsl < 0 ? 0 : (nsl > TAB_SLOTS ? TAB_SLOTS : nsl);
        const int nent = nsl * 256; const int* LISTp = (const int*)(args.ws + WS_LIST);
#pragma unroll 1
        for (int base = 0; base < nent; base += 5120) {
            int tokv[10], dflt[10]; bool fromlist[10];
#pragma unroll
            for (int j = 0; j < 10; ++j) { int idx = base + j * 512 + F.tid; idx = idx < nent ? idx : nent - 1; const int i = idx >> 8, r = idx & 255, rt = (i * F.G + F.vcu) >> 1;
                const int e = te[rt], pos = rt * 256 - eoff[e] + r;
                fromlist[j] = e < NE && pos < ((const LAS int*)(F.lds + EC_OFF))[s * 72 + e]; dflt[j] = e < NE ? 0 : s * TS + pos;
                tokv[j] = LISTp[fromlist[j] ? (size_t)e * T + pos : (size_t)0]; }
#pragma unroll
            for (int j = 0; j < 10; ++j) { const int idx = base + j * 512 + F.tid; if (idx < nent) tab[idx] = (unsigned)(fromlist[j] ? tokv[j] : dflt[j]) * 1024u; }
        } }
    WG_BAR();
    return NT;
}
__device__ __forceinline__ void pc_combine(const Frame& F_, CArgs& args_, int s) {
    Frame F = F_; F.lane = lane_id_asm(); F.tid = F.wave * 64 + F.lane;
    ARGS_LAUNDER(args_);
    asm volatile("" : "+s"(s));
    const LAS int* eoff = (const LAS int*)(F.lds + EO_OFF) + s * 72;
    const int shoff = eoff[NE];
    const int gw = F.vcu * 8 + F.wave, NGW = F.G * 8, lane = F.lane;
    constexpr int PER = 16;
    const unsigned char* Y8 = (const unsigned char*)(args.ws + WS_A); const bf16* x1b = (const bf16*)(args.ws + WS_X1);
    for (int blk = gw; blk < TS / PER; blk += NGW) {
        const int tl0 = blk * PER, b = (s * TS + tl0) / SEQ;
        f32x4 g2[4], nf[4];
#pragma unroll
        for (int i = 0; i < 4; ++i) { const int col = 256 * i + 4 * lane; g2[i] = *(const f32x4*)(((float*)(args.ws + WS_MOD)) + b * 6144 + 5120 + col); nf[i] = *(const f32x4*)((args.in[23]) + col); }
#pragma unroll 2
        for (int r = 0; r < PER; ++r) {
            const int tl = tl0 + r, t = s * TS + tl;
            f32x4 acc[4];
#pragma unroll
            for (int i = 0; i < 4; ++i) acc[i] = (f32x4){0.f, 0.f, 0.f, 0.f};
            typedef int i32x4_ __attribute__((ext_vector_type(4)));
            int ridx[8], rpos[8]; float rwgt[8];
            { const i32x4_ i0 = *(const i32x4_*)(((int*)(args.ws + WS_IDX)) + (size_t)t * 8), i1 = *(const i32x4_*)(((int*)(args.ws + WS_IDX)) + (size_t)t * 8 + 4);
              const i32x4_ p0 = *(const i32x4_*)(((int*)(args.ws + WS_APOS)) + (size_t)t * 8), p1 = *(const i32x4_*)(((int*)(args.ws + WS_APOS)) + (size_t)t * 8 + 4);
              const f32x4 w0 = *(const f32x4*)(((float*)(args.ws + WS_WGT)) + (size_t)t * 8), w1 = *(const f32x4*)(((float*)(args.ws + WS_WGT)) + (size_t)t * 8 + 4);
#pragma unroll
              for (int k = 0; k < 4; ++k) { ridx[k] = i0[k]; ridx[4 + k] = i1[k]; rpos[k] = p0[k]; rpos[4 + k] = p1[k]; rwgt[k] = w0[k]; rwgt[4 + k] = w1[k]; } }
#pragma unroll
            for (int k = 0; k < 9; ++k) {
                const int row = k < 8 ? eoff[ridx[k < 8 ? k : 0]] + rpos[k < 8 ? k : 0] : shoff + tl; const float w = (k < 8 ? rwgt[k < 8 ? k : 0] : 1.0f) * (1.0f / 16.0f);
                unsigned yw[4];
#pragma unroll
                for (int i = 0; i < 4; ++i) yw[i] = __builtin_nontemporal_load((const unsigned*)(Y8 + (size_t)row * D + 256 * i + 4 * lane));
#pragma unroll
                for (int i = 0; i < 4; ++i) { const f32x2 lo = __builtin_amdgcn_cvt_pk_f32_fp8((int)yw[i], false), hi = __builtin_amdgcn_cvt_pk_f32_fp8((int)yw[i], true);
                    acc[i] = acc[i] + (f32x4){lo.x, lo.y, hi.x, hi.y} * w; }
            }
            float* orow = (args.out) + (size_t)t * D + 4 * lane; float ss = 0.f; f32x4 xf[4];
#pragma unroll
            for (int i = 0; i < 4; ++i) { const u32x2 xw = __builtin_nontemporal_load((const u32x2*)(x1b + (size_t)t * D + 256 * i + 4 * lane)); const f32x4 x1 = (f32x4){bflo(xw.x), bfhi(xw.x), bflo(xw.y), bfhi(xw.y)}; const f32x4 v = x1 + g2[i] * acc[i]; xf[i] = v; ss += (v.x * v.x + v.y * v.y) + (v.z * v.z + v.w * v.w); }
            const float rstd = rsqrtf(wave_sum(ss) * (1.0f / D) + EPS);
#pragma unroll
            for (int i = 0; i < 4; ++i) *(f32x4*)(orow + 256 * i) = xf[i] * rstd * nf[i];
        }
    }
}

__device__ __forceinline__ void stagger(int quanta) { const int j = ((int)blockIdx.x >> 3) & 7; for (int i = 0; i < j * quanta; ++i) __builtin_amdgcn_s_sleep(16); }

constexpr int NPH = 10 + 3 * S_SB;
__global__ void __launch_bounds__(512, 2) fwd_kernel(Args args_k) {
    CArgs& kargs = *(CArgs*)__builtin_amdgcn_kernarg_segment_ptr();
    extern __shared__ __attribute__((aligned(16))) unsigned char lds_raw[];
    Frame F;
    F.lds = (LAS unsigned char*)lds_raw; F.MISC = (volatile LAS unsigned*)(F.lds + MISC_OFF);
    F.wave = __builtin_amdgcn_readfirstlane((int)threadIdx.x >> 6); F.lane = 0; F.tid = 0;
    F.G = gridDim.x; { const int bx = blockIdx.x; F.vcu = (F.G % 8 == 0) ? (bx % 8) * (F.G / 8) + bx / 8 : bx; }
    F.ctl = (unsigned*)(kargs.ws + WS_CTL);
    if (threadIdx.x < 64) ((LAS unsigned*)(F.lds + MISC_OFF))[threadIdx.x] = 0u;
    __syncthreads();
    XcdBarrier bar; bar.bar = F.ctl + CW_BAR; bar.x = 0; bar.st = nullptr;
    if (!MK_PER_PHASE) bar = xcd_barrier_post(F.ctl + CW_BAR, F.MISC);
    const int lo = MK_PER_PHASE ? kargs.ph_lo : 0, hi = MK_PER_PHASE ? kargs.ph_hi : NPH;
#ifndef PH_ENABLE
#define PH_ENABLE 0xffffffffu
#endif
#define IN(k) (((PH_ENABLE >> ((k) > 9 ? 10 + ((k) - 10) % 3 : (k))) & 1u) && lo <= (k) && (k) < hi)
#ifndef DUP_MASK
#define DUP_MASK 0u
#endif
#define REPEAT(k) _Pragma("unroll 1") for (int rep_ = 0; rep_ < 1 + (int)((DUP_MASK >> (k)) & 1u); ++rep_)
#define SEAM(k) do { if (!MK_PER_PHASE && IN(k) && IN((k) + 1)) xcd_barrier(bar, F.wave); } while (0)

    if (IN(0)) { REPEAT(0) { p0_prologue(F, kargs); } SEAM(0); }
    if (IN(1)) { ARGS_LAUNDER(kargs); p1_router_weights(F, kargs); REPEAT(1) { p_norm_mod<true, false>(F, kargs, (args.in[0]), (args.in[4]), 0, 1024, ((bf16*)(args.ws + WS_HB)), nullptr); } SEAM(1); }
    if (IN(2)) { ARGS_LAUNDER(kargs);
        pg8::PlainOrder S; S.init(((bf16*)(args.ws + WS_HB)), ((bf16*)(args.ws + WS_WIN)), T, NPROJ, D, F.G, (int)blockIdx.x); pg8::EpiBf16T E{((bf16*)(args.ws + WS_A)), NPJ / 256};
        stagger(STG_P2); REPEAT(2) { pg8::gemm_phase<pg8::EpiBf16T, pg8::PlainOrder, true>(F.lds, F.wave, D, S, E); } SEAM(2); }
    if (IN(3)) { REPEAT(3) { p3_conv(F, kargs); } SEAM(3); }
    if (IN(4)) { REPEAT(4) { p4_ssd(F, kargs); } SEAM(4); }
    if (IN(5)) { ARGS_LAUNDER(kargs);
        pg8::PlainOrder S; S.init(((bf16*)(args.ws + WS_HB)), ((bf16*)(args.ws + WS_WOUT)), T, D, D, F.G, (int)blockIdx.x);
        {
            const int lane = lane_id_asm(), tid = F.wave * 64 + lane, r = tid & 255, hf = tid >> 8;
            LAS float* rstab = (LAS float*)(F.lds + TAB_OFF); LAS float* tmp = (LAS float*)(F.lds);
            pg8::Unit u;
            for (int i0 = 0; i0 < 16; i0 += 4) {
                float sv[4]; bool ok[4]; float pv[4][16];
#pragma unroll
                for (int j = 0; j < 4; ++j) { ok[j] = S.next(i0 + j, u); const int pm = ok[j] ? u.pm : 0;
                    const float* sp = ((const float*)(args.ws + WS_SSQ)) + (size_t)(16 * hf) * T + pm * 256 + r;
#pragma unroll
                    for (int q = 0; q < 16; ++q) pv[j][q] = sp[(size_t)q * T]; }
#pragma unroll
                for (int j = 0; j < 4; ++j) { float s = 0.f;
#pragma unroll
                    for (int q = 0; q < 16; ++q) s += pv[j][q];
                    sv[j] = s; if (hf) tmp[j * 256 + r] = s; }
                WG_BAR();
#pragma unroll
                for (int j = 0; j < 4; ++j) if (!hf && ok[j]) rstab[(i0 + j) * 256 + r] = rsqrtf((sv[j] + tmp[j * 256 + r]) * (1.0f / 512.0f) + EPS);
                WG_BAR();
                if (!ok[3]) break;
            }
        }
        pg8::EpiX1 E{(args.in[0]), (bf16*)(args.ws + WS_X1), ((float*)(args.ws + WS_MOD)) + 2048, (const LAS float*)(F.lds + TAB_OFF)};
        stagger(STG_P5); REPEAT(5) { pg8::gemm_phase<pg8::EpiX1, pg8::PlainOrder, false>(F.lds, F.wave, D, S, E); } SEAM(5); }
    if (IN(6)) { p7_router(F, kargs); SEAM(9); }
    load_eoff(F, kargs);
    for (int s = 0; s < S_SB; ++s) {
        const int k0 = 10 + 3 * s;
        if (IN(k0)) { ARGS_LAUNDER(kargs);
            const int NT = moe_tables(F, kargs, s, true);
            pg8::MoeOrder<1, true> S; S.NT = NT; S.G = F.G; S.c = F.vcu; S.A = (const char*)(args.ws + WS_H8); S.W = (const char*)(args.ws + WS_WGU); S.rowb = 0; S.w_exp = (size_t)512 * 1024; S.w_tile = (size_t)256 * 1024;
            S.te = F.lds + TE_OFF; S.tab = (const LAS unsigned*)(F.lds + TAB_OFF);
            pg8::EpiGU E{(unsigned char*)(args.ws + WS_HID)};
            stagger(STG_G); REPEAT(10) { pg8::gemm_phase<pg8::EpiGU, pg8::MoeOrder<1, true>, true, true>(F.lds, F.wave, D, S, E); } SEAM(k0); }
        if (IN(k0 + 1)) { ARGS_LAUNDER(kargs);
            const int NT = moe_tables(F, kargs, s, false);
            pg8::MoeOrderD S; S.NT = NT; S.G = F.G; S.c = F.vcu; S.A = (const char*)(args.ws + WS_HID); S.W = (const char*)(args.ws + WS_WD); S.rowb = 256u; S.w_exp = (size_t)1024 * 256; S.w_tile = (size_t)256 * 256;
            S.te = F.lds + TE_OFF;
            pg8::EpiFp8 E{(unsigned char*)(args.ws + WS_A), D, 1.0f, (unsigned char*)(args.ws + WS_LIST)};
            int Kd = 256; asm volatile("" : "+s"(Kd));
            stagger(STG_D); REPEAT(11) { pg8::gemm_phase<pg8::EpiFp8, pg8::MoeOrderD, true, true>(F.lds, F.wave, Kd, S, E); } SEAM(k0 + 1); }
        if (IN(k0 + 2)) { pc_combine(F, kargs, s); if (MK_PER_PHASE == 0 && s + 1 < S_SB) { asm volatile("s_waitcnt vmcnt(0)" ::: "memory"); __syncthreads(); } }
    }
#undef IN
#undef SEAM
}

extern "C" void kernel_launch(void* const* d_in, const int* in_sizes, int n_in, void* d_out, int out_size, void* d_ws, size_t ws_size, hipStream_t stream) {
    static int grid = 0;
    if (grid == 0) {
        if (n_in != 24 || in_sizes[0] != T * D || out_size != T * D || ws_size < WS_END) { fprintf(stderr, "kernel_launch: unexpected shapes / workspace (n_in %d, ws %zu, need %zu)\n", n_in, ws_size, (size_t)WS_END); grid = -1; return; }
        int dev = 0, cus = 0, per_cu = 0;
        if (hipGetDevice(&dev) != hipSuccess || hipDeviceGetAttribute(&cus, hipDeviceAttributeMultiprocessorCount, dev) != hipSuccess) { grid = -1; return; }
        if (hipFuncSetAttribute((const void*)fwd_kernel, hipFuncAttributeMaxDynamicSharedMemorySize, LDS_BYTES) != hipSuccess) { fprintf(stderr, "kernel_launch: hipFuncSetAttribute failed\n"); grid = -1; return; }
        if (hipOccupancyMaxActiveBlocksPerMultiprocessor(&per_cu, (const void*)fwd_kernel, 512, LDS_BYTES) != hipSuccess || per_cu < 1) fprintf(stderr, "kernel_launch: occupancy query says %d\n", per_cu);
        (void)hipGetLastError();
        grid = cus;
    }
    if (grid < 0) return;
    if (hipMemsetAsync((char*)d_ws + WS_CTL, 0, CTL_ZERO_BYTES, stream) != hipSuccess) return;
    Args a{};
    for (int i = 0; i < 24; ++i) a.in[i] = (const float*)d_in[i];
    a.out = (float*)d_out; a.ws = (unsigned char*)d_ws;
#if MK_PER_PHASE
    for (int p = 0; p < NPH; ++p) { a.ph_lo = p; a.ph_hi = p + 1; hipLaunchKernelGGL(fwd_kernel, dim3(grid), dim3(512), LDS_BYTES, stream, a); }
#else
    a.ph_lo = 0; a.ph_hi = NPH;
    hipLaunchKernelGGL(fwd_kernel, dim3(grid), dim3(512), LDS_BYTES, stream, a);
#endif
}
```
